# Optimizing an MI355X kernel written in HIP

```python
import math
import jax, jax.numpy as jnp
from jax import lax
import numpy as np

D_MODEL = 1024
BATCH = 8
SEQ = 4096
DEPTH = 1

MIX_WIDTH = D_MODEL
ATTN_WIDTH = MIX_WIDTH // 2
LRU_WIDTH = MIX_WIDTH - ATTN_WIDTH
DIFF_HEAD_DIM = 64
DIFF_V_DIM = 2 * DIFF_HEAD_DIM
N_DIFF_HEADS = ATTN_WIDTH // DIFF_V_DIM
ROPE_DIM = DIFF_HEAD_DIM // 4
ROPE_THETA = 500000.0
Q_BLOCK = 128
LRU_BLOCKS = 8
LRU_BLOCK_WIDTH = LRU_WIDTH // LRU_BLOCKS
CONV_WIDTH = 4
CONV_PAD = (2, 1)
LRU_C = 8.0
N_DIRS = 2
N_KEYS = 128
N_EXPERTS = N_KEYS * N_KEYS
PEER_HEADS = 8
PEER_TOPK = 16
DIM_KEY = 128
HALF_KEY = DIM_KEY // 2
PEER_BLOCK = 128
PLE_DIM = 256
POS_OFFSET_MAX = 1024
EPS = 1e-6

Q_COLS = N_DIFF_HEADS * 2 * DIFF_HEAD_DIM
K_COLS = N_DIFF_HEADS * 2 * DIFF_HEAD_DIM
V_COLS = N_DIFF_HEADS * DIFF_V_DIM
IN_COLS = Q_COLS + K_COLS + V_COLS + 2 * LRU_WIDTH

kernel_name = "hybrid_diffattn_rglru_peer_encoder"


def rms_norm(x, g):
    xf = x.astype(jnp.float32)
    y = xf * lax.rsqrt(jnp.mean(xf * xf, axis=-1, keepdims=True) + EPS)
    return (y * g.astype(jnp.float32)).astype(x.dtype)


def rope_cos_sin(positions):
    inv_freq = ROPE_THETA ** (-jnp.arange(0, ROPE_DIM, 2, dtype=jnp.float32) / ROPE_DIM)
    ang = positions.astype(jnp.float32)[..., None] * inv_freq
    return jnp.cos(ang), jnp.sin(ang)


def apply_partial_rope(t, cos, sin):
    half = ROPE_DIM // 2
    c = cos[:, :, None, None, :]
    s = sin[:, :, None, None, :]
    tf = t.astype(jnp.float32)
    x1 = tf[..., :half]
    x2 = tf[..., half:ROPE_DIM]
    rot = jnp.concatenate([x1 * c - x2 * s, x2 * c + x1 * s], axis=-1)
    return jnp.concatenate([rot, tf[..., ROPE_DIM:]], axis=-1).astype(t.dtype)


def diff_attention(q, k, v, lam, positions):
    B, S = q.shape[0], q.shape[1]
    cos, sin = rope_cos_sin(positions)
    q = apply_partial_rope(q, cos, sin) * (DIFF_HEAD_DIM ** -0.5)
    k = apply_partial_rope(k, cos, sin)
    kh = k.transpose(0, 2, 3, 1, 4)
    vh = v.transpose(0, 2, 1, 3)
    nb = S // Q_BLOCK
    q_blocks = q.transpose(0, 2, 3, 1, 4).reshape(
        B, N_DIFF_HEADS, 2, nb, Q_BLOCK, DIFF_HEAD_DIM).transpose(3, 0, 1, 2, 4, 5)

    def block(qb):
        s = jnp.einsum('bhmqd,bhmkd->bhmqk', qb, kh).astype(jnp.float32)
        pr = jax.nn.softmax(s, axis=-1)
        w = pr[:, :, 0] - lam * pr[:, :, 1]
        return jnp.einsum('bhqk,bhkd->bhqd', w.astype(vh.dtype), vh)

    o = lax.map(block, q_blocks)
    return o.transpose(1, 0, 3, 2, 4).reshape(B, S, N_DIFF_HEADS, DIFF_V_DIM)


def _lin_combine(left, right):
    a_l, b_l = left
    a_r, b_r = right
    return a_l * a_r, a_r * b_l + b_r


def block_diag_linear(u, w, b):
    B, S = u.shape[0], u.shape[1]
    ub = u.reshape(B, S, LRU_BLOCKS, LRU_BLOCK_WIDTH)
    y = jnp.einsum('bsnc,nce->bsne', ub, w).reshape(B, S, LRU_WIDTH)
    return y + b


def rg_lru_direction(u, wa, ba, wx, bx, lam, reverse):
    uf = u.astype(jnp.float32)
    r = jax.nn.sigmoid(block_diag_linear(u, wa, ba).astype(jnp.float32))
    i = jax.nn.sigmoid(block_diag_linear(u, wx, bx).astype(jnp.float32))
    log_a = -LRU_C * r * jax.nn.softplus(-lam.astype(jnp.float32))
    a = jnp.exp(log_a)
    mult = jnp.sqrt(-jnp.expm1(2.0 * log_a))
    bterm = mult * (i * uf)
    _, h = lax.associative_scan(_lin_combine, (a, bterm), reverse=reverse, axis=1)
    return h


def bi_rglru(u, gate, conv_w, conv_b, lru_wa, lru_ba, lru_wx, lru_bx, lru_lambda):
    C = u.shape[-1]
    uc = lax.conv_general_dilated(
        u, conv_w[:, None, :].astype(u.dtype), window_strides=(1,), padding=[CONV_PAD],
        dimension_numbers=('NWC', 'WIO', 'NWC'), feature_group_count=C) + conv_b
    h_f = rg_lru_direction(uc, lru_wa[0], lru_ba[0], lru_wx[0], lru_bx[0], lru_lambda[0], False)
    h_b = rg_lru_direction(uc, lru_wa[1], lru_ba[1], lru_wx[1], lru_bx[1], lru_lambda[1], True)
    y = (h_f + h_b) * jax.nn.gelu(gate.astype(jnp.float32))
    return y.astype(u.dtype)


def peer_layer(xn, wq, keys1, keys2, exp_u, exp_v):
    B, S, D = xn.shape
    q = (xn @ wq).reshape(B, S, PEER_HEADS, 2, HALF_KEY)
    s1 = jnp.einsum('bshd,kd->bshk', q[..., 0, :], keys1).astype(jnp.float32)
    s2 = jnp.einsum('bshd,kd->bshk', q[..., 1, :], keys2).astype(jnp.float32)
    v1, i1 = lax.top_k(s1, PEER_TOPK)
    v2, i2 = lax.top_k(s2, PEER_TOPK)
    cand = (v1[..., :, None] + v2[..., None, :]).reshape(B, S, PEER_HEADS, PEER_TOPK * PEER_TOPK)
    cand_idx = (i1[..., :, None] * N_KEYS + i2[..., None, :]).reshape(
        B, S, PEER_HEADS, PEER_TOPK * PEER_TOPK)
    sc, pos = lax.top_k(cand, PEER_TOPK)
    idx = jnp.take_along_axis(cand_idx, pos, axis=-1)
    g = jax.nn.softmax(sc, axis=-1)

    T = B * S
    nb = T // PEER_BLOCK
    NK = PEER_HEADS * PEER_TOPK
    xt = xn.reshape(nb, PEER_BLOCK, D)
    idx_t = idx.reshape(nb, PEER_BLOCK, NK)
    g_t = g.reshape(nb, PEER_BLOCK, NK)

    def block(args):
        xb, ib, gb = args
        ue = exp_u[ib]
        logits = jnp.einsum('td,tkd->tk', xb, ue).astype(jnp.float32)
        act = (jax.nn.gelu(logits) * gb).astype(xb.dtype)
        ve = exp_v[ib]
        return jnp.einsum('tk,tkd->td', act, ve)

    out = lax.map(block, (xt, idx_t, g_t))
    return out.reshape(B, S, D)


def setup_inputs(seed: int = 0) -> dict:
    key = jax.random.key(seed)
    ks = iter(jax.random.split(key, 40))

    def nrm(shape, scale):
        return jax.random.normal(next(ks), shape, jnp.float32) * scale

    def gain(shape):
        return 1.0 + nrm(shape, 0.01)

    x = nrm((BATCH, SEQ, D_MODEL), 1.0)
    p = nrm((DEPTH, BATCH, SEQ, PLE_DIM), 1.0)
    positions = (jnp.arange(SEQ, dtype=jnp.int32)[None, :]
                 + jax.random.randint(next(ks), (BATCH, 1), 0, POS_OFFSET_MAX, dtype=jnp.int32))
    u_a = jax.random.uniform(next(ks), (DEPTH, N_DIRS, LRU_WIDTH), jnp.float32, 0.9, 0.999)
    a0 = u_a ** (1.0 / LRU_C)
    lru_lambda = jnp.log(a0) - jnp.log1p(-a0)
    return {
        "x": x,
        "p": p,
        "positions": positions,
        "norm_mix_g": gain((DEPTH, D_MODEL)),
        "w_in": nrm((DEPTH, D_MODEL, IN_COLS), D_MODEL ** -0.5),
        "lambda_q1": nrm((DEPTH, DIFF_HEAD_DIM), 0.1),
        "lambda_k1": nrm((DEPTH, DIFF_HEAD_DIM), 0.1),
        "lambda_q2": nrm((DEPTH, DIFF_HEAD_DIM), 0.1),
        "lambda_k2": nrm((DEPTH, DIFF_HEAD_DIM), 0.1),
        "diff_norm_g": gain((DEPTH, DIFF_V_DIM)),
        "conv_w": nrm((DEPTH, CONV_WIDTH, LRU_WIDTH), CONV_WIDTH ** -0.5),
        "conv_b": nrm((DEPTH, LRU_WIDTH), 0.01),
        "lru_wa": nrm((DEPTH, N_DIRS, LRU_BLOCKS, LRU_BLOCK_WIDTH, LRU_BLOCK_WIDTH), LRU_BLOCK_WIDTH ** -0.5),
        "lru_ba": nrm((DEPTH, N_DIRS, LRU_WIDTH), 0.01),
        "lru_wx": nrm((DEPTH, N_DIRS, LRU_BLOCKS, LRU_BLOCK_WIDTH, LRU_BLOCK_WIDTH), LRU_BLOCK_WIDTH ** -0.5),
        "lru_bx": nrm((DEPTH, N_DIRS, LRU_WIDTH), 0.01),
        "lru_lambda": lru_lambda,
        "lru_norm_g": gain((DEPTH, LRU_WIDTH)),
        "w_out": nrm((DEPTH, MIX_WIDTH, D_MODEL), MIX_WIDTH ** -0.5),
        "norm_ffn_g": gain((DEPTH, D_MODEL)),
        "peer_wq": nrm((DEPTH, D_MODEL, PEER_HEADS * DIM_KEY), D_MODEL ** -0.5),
        "peer_keys1": nrm((DEPTH, N_KEYS, HALF_KEY), HALF_KEY ** -0.5),
        "peer_keys2": nrm((DEPTH, N_KEYS, HALF_KEY), HALF_KEY ** -0.5),
        "peer_u": nrm((DEPTH, N_EXPERTS, D_MODEL), D_MODEL ** -0.5),
        "peer_v": nrm((DEPTH, N_EXPERTS, D_MODEL), PEER_HEADS ** -0.5),
        "norm_ple_g": gain((DEPTH, D_MODEL)),
        "ple_w_gate": nrm((DEPTH, D_MODEL, D_MODEL), D_MODEL ** -0.5),
        "ple_w_proj": nrm((DEPTH, PLE_DIM, D_MODEL), PLE_DIM ** -0.5),
        "final_norm_g": gain((D_MODEL,)),
    }


def reference(x, p, positions, norm_mix_g, w_in, lambda_q1, lambda_k1, lambda_q2, lambda_k2,
              diff_norm_g, conv_w, conv_b, lru_wa, lru_ba, lru_wx, lru_bx, lru_lambda,
              lru_norm_g, w_out, norm_ffn_g, peer_wq, peer_keys1, peer_keys2, peer_u, peer_v,
              norm_ple_g, ple_w_gate, ple_w_proj, final_norm_g):
    B, S, _ = x.shape
    h = x
    for i in range(DEPTH):
        lambda_init = 0.8 - 0.6 * math.exp(-0.3 * i)
        xn = rms_norm(h, norm_mix_g[i])
        proj = xn @ w_in[i]
        q = proj[..., :Q_COLS].reshape(B, S, N_DIFF_HEADS, 2, DIFF_HEAD_DIM)
        k = proj[..., Q_COLS:Q_COLS + K_COLS].reshape(B, S, N_DIFF_HEADS, 2, DIFF_HEAD_DIM)
        o0 = Q_COLS + K_COLS
        v = proj[..., o0:o0 + V_COLS].reshape(B, S, N_DIFF_HEADS, DIFF_V_DIM)
        o1 = o0 + V_COLS
        lru_in = proj[..., o1:o1 + LRU_WIDTH]
        lru_gate = proj[..., o1 + LRU_WIDTH:o1 + 2 * LRU_WIDTH]

        lam = (jnp.exp(jnp.sum(lambda_q1[i].astype(jnp.float32) * lambda_k1[i].astype(jnp.float32)))
               - jnp.exp(jnp.sum(lambda_q2[i].astype(jnp.float32) * lambda_k2[i].astype(jnp.float32)))
               + lambda_init)
        attn = diff_attention(q, k, v, lam, positions)
        attn = (rms_norm(attn, diff_norm_g[i]) * (1.0 - lambda_init)).reshape(B, S, ATTN_WIDTH)

        rec = bi_rglru(lru_in, lru_gate, conv_w[i], conv_b[i], lru_wa[i], lru_ba[i],
                       lru_wx[i], lru_bx[i], lru_lambda[i])
        rec = rms_norm(rec, lru_norm_g[i])

        mixed = jnp.concatenate([attn.astype(h.dtype), rec.astype(h.dtype)], axis=-1)
        h = h + mixed @ w_out[i]

        xn2 = rms_norm(h, norm_ffn_g[i])
        h = h + peer_layer(xn2, peer_wq[i], peer_keys1[i], peer_keys2[i], peer_u[i], peer_v[i])

        xn3 = rms_norm(h, norm_ple_g[i])
        gate = jax.nn.sigmoid((xn3 @ ple_w_gate[i]).astype(jnp.float32)).astype(h.dtype)
        h = h + gate * (p[i] @ ple_w_proj[i])
    return rms_norm(h, final_norm_g)
```

```cpp
#include <hip/hip_runtime.h>
#include <hip/hip_cooperative_groups.h>
#include <cstdio>
#include <cstdint>
namespace cg = cooperative_groups;

constexpr int NB = 8, SEQ = 4096, T = NB * SEQ, DM = 1024, INC = 2560, PLE = 256;
constexpr float EPS = 1e-6f;
constexpr float LAMBDA_INIT = 0.2f;

__device__ __forceinline__ int fresh_tid() { int t = threadIdx.x; asm volatile("" : "+v"(t)); return t; }

namespace pg8 {
#define PG8_LAS __attribute__((address_space(3)))
typedef unsigned short bf16_t;
typedef short bf16x8 __attribute__((ext_vector_type(8)));
typedef float f32x4 __attribute__((ext_vector_type(4)));
typedef unsigned u32x4 __attribute__((ext_vector_type(4)));
constexpr int BM = 256, BK = 64, HALF = 128, HTB = HALF * BK * 2  , STAGE_BYTES = 8 * HTB, NXCD = 8, WGM = 8;

__host__ __device__ __forceinline__ int lds_byte(int r, int c) { const int st = (r >> 4) * 2 + (c >> 5), rr = r & 15, cc = c & 31, ob = rr * 64 + cc * 2; return st * 1024 + (ob ^ (((ob >> 9) & 1) << 5)); }
__host__ __device__ __forceinline__ void stage_rc(int b, int& R, int& C) { const int st = b / 1024, sb = b % 1024, swz = sb ^ (((sb >> 9) & 1) << 5); R = (st >> 1) * 16 + swz / 64; C = (st & 1) * 32 + (swz % 64) / 2; }
__host__ __device__ __forceinline__ int perm32(int rho) { const int n = rho >> 4, i = rho & 15; return 8 * (i >> 2) + 4 * n + (i & 3); }

struct Unit { int pm, pn; };
struct Gemm { const bf16_t* A; const bf16_t* Bt; int M, N, K; };

struct StaticOrder {
    int nM, nN, nwg, G, c;
    __host__ __device__ void init(int M, int N, int G_, int c_) { nM = M / BM; nN = N / BM; nwg = nM * nN; G = G_; c = c_; }
    __host__ __device__ bool next(int i, Unit& u) const {
        const long L = (long)i * G + c; if (L >= nwg) return false;
        int wgid = (int)L; { const int q = nwg / NXCD, r = nwg % NXCD, xcd = wgid % NXCD, off = wgid / NXCD; wgid = (xcd < r ? xcd * (q + 1) : r * (q + 1) + (xcd - r) * q) + off; }
        const int nig = WGM * nN, gid = wgid / nig, fm = gid * WGM, gsz = (nM - fm) < WGM ? (nM - fm) : WGM;
        u.pm = fm + ((wgid % nig) % gsz); u.pn = (wgid % nig) / gsz; return true;
    }
    __device__ __forceinline__ void a_ready(const Unit&) const {}
    __device__ __forceinline__ void done(const Unit&) const {}
};

__device__ __forceinline__ unsigned cvt_pk_bf16(float lo, float hi) { unsigned r; asm volatile("v_cvt_pk_bf16_f32 %0, %1, %2" : "=v"(r) : "v"(lo), "v"(hi)); return r; }
typedef float f32x2 __attribute__((ext_vector_type(2)));
typedef unsigned u32x2 __attribute__((ext_vector_type(2)));
__device__ __forceinline__ float fsigmoid(float z) { return __builtin_amdgcn_rcpf(1.0f + __expf(-z)); }
__device__ __forceinline__ float rowscale_n(const float* ss, int n) { float s = 0.f; for (int i = 0; i < n; ++i) s += ss[i]; return 1.0f / sqrtf(s * (1.0f / 1024.0f) + 1e-6f); }
__device__ __forceinline__ float rowscale16(const float* ss, int row) { const f32x4* p = (const f32x4*)(ss + (size_t)row * 16); const f32x4 a = p[0], b = p[1], c = p[2], d = p[3];
    const float s = ((a[0] + a[1]) + (a[2] + a[3])) + ((b[0] + b[1]) + (b[2] + b[3])) + ((c[0] + c[1]) + (c[2] + c[3])) + ((d[0] + d[1]) + (d[2] + d[3])); return 1.0f / sqrtf(s * (1.0f / 1024.0f) + 1e-6f); }
__device__ __forceinline__ float rowscale8(const float* ss, int row) { const f32x4* p = (const f32x4*)(ss + (size_t)row * 8); const f32x4 a = p[0], b = p[1];
    const float s = ((a[0] + a[1]) + (a[2] + a[3])) + ((b[0] + b[1]) + (b[2] + b[3])); return 1.0f / sqrtf(s * (1.0f / 1024.0f) + 1e-6f); }
__device__ __forceinline__ u32x4 pack8(f32x4 v0, f32x4 v1) { u32x4 w; w.x = cvt_pk_bf16(v0[0], v0[1]); w.y = cvt_pk_bf16(v0[2], v0[3]); w.z = cvt_pk_bf16(v1[0], v1[1]); w.w = cvt_pk_bf16(v1[2], v1[3]); return w; }
__device__ __forceinline__ float bf_lo(unsigned w) { return __uint_as_float(w << 16); }
__device__ __forceinline__ float bf_hi(unsigned w) { return __uint_as_float(w & 0xffff0000u); }

struct EpiProj {
    static constexpr bool PERM = true, AFTER_DRAIN = false;
    bf16_t* base; const float* rope;
    __device__ __forceinline__ void operator()(const f32x4 (&acc)[2][2][4][2], const Unit& u, int wr, int wc, int fr, int fq) const {
        const int region = u.pn >> 1;
        bf16_t* O = base + (size_t)region * ((size_t)32768 * 512);
        const int colb = (u.pn & 1) * 256 + wc * 32 + 8 * fq;
        const bool rot = (region < 2) && ((wc & 1) == 0);
        const float qs = (region == 0) ? 0.125f : 1.0f;
        const float sgn = (fq == 0) ? -1.0f : 1.0f;
#pragma unroll
        for (int ai = 0; ai < 2; ++ai)
#pragma unroll
            for (int m = 0; m < 4; ++m) {
                const int row = u.pm * BM + ai * HALF + wr * 64 + m * 16 + fr;
                f32x4 c0 = {1.f, 1.f, 1.f, 1.f}, c1 = c0, s0 = {0.f, 0.f, 0.f, 0.f}, s1 = s0;
                if (rot) { const f32x4* rp = (const f32x4*)(rope + (size_t)row * 16); c0 = rp[0]; c1 = rp[1]; s0 = rp[2]; s1 = rp[3]; }
#pragma unroll
                for (int bj = 0; bj < 2; ++bj) {
                    f32x4 v0 = acc[ai][bj][m][0], v1 = acc[ai][bj][m][1];
                    if (rot) {
                        f32x4 o0, o1;
#pragma unroll
                        for (int j = 0; j < 4; ++j) { o0[j] = __shfl_xor(v0[j], 16); o1[j] = __shfl_xor(v1[j], 16); }
                        if (fq < 2) { v0 = v0 * c0 + (o0 * s0) * sgn; v1 = v1 * c1 + (o1 * s1) * sgn; }
                    }
                    v0 = v0 * qs; v1 = v1 * qs;
                    *(u32x4*)(O + (size_t)row * 512 + colb + bj * HALF) = pack8(v0, v1);
                }
            }
    }
};
struct EpiResid {
    static constexpr bool PERM = true, AFTER_DRAIN = false;
    const float* X; float* H; bf16_t* HB; float* SS;
    __device__ __forceinline__ void operator()(const f32x4 (&acc)[2][2][4][2], const Unit& u, int wr, int wc, int fr, int fq) const {
        const int col0 = u.pn * BM + wc * 32 + 8 * fq;
#pragma unroll
        for (int ai = 0; ai < 2; ++ai)
#pragma unroll
            for (int m = 0; m < 4; ++m) {
                const int row = u.pm * BM + ai * HALF + wr * 64 + m * 16 + fr; float ssq = 0.f;
#pragma unroll
                for (int bj = 0; bj < 2; ++bj) {
                    const size_t off = (size_t)row * 1024 + col0 + bj * HALF;
                    const f32x4 h0 = *(const f32x4*)(X + off) + acc[ai][bj][m][0], h1 = *(const f32x4*)(X + off + 4) + acc[ai][bj][m][1];
                    *(f32x4*)(H + off) = h0; *(f32x4*)(H + off + 4) = h1; *(u32x4*)(HB + off) = pack8(h0, h1);
                    ssq += (h0[0] * h0[0] + h0[1] * h0[1]) + (h0[2] * h0[2] + h0[3] * h0[3]) + (h1[0] * h1[0] + h1[1] * h1[1]) + (h1[2] * h1[2] + h1[3] * h1[3]);
                }
                ssq += __shfl_xor(ssq, 16); ssq += __shfl_xor(ssq, 32);
                if (fq == 0) SS[(size_t)row * 16 + u.pn * 4 + wc] = ssq;
            }
    }
};
struct EpiScaleBf16 {
    static constexpr bool PERM = true, AFTER_DRAIN = false;
    bf16_t* O; const float* SS;
    __device__ __forceinline__ void operator()(const f32x4 (&acc)[2][2][4][2], const Unit& u, int wr, int wc, int fr, int fq) const {
        const int col0 = u.pn * BM + wc * 32 + 8 * fq;
#pragma unroll
        for (int ai = 0; ai < 2; ++ai)
#pragma unroll
            for (int m = 0; m < 4; ++m) {
                const int row = u.pm * BM + ai * HALF + wr * 64 + m * 16 + fr;
                const float rs = SS ? rowscale16(SS, row) : 1.0f;
#pragma unroll
                for (int bj = 0; bj < 2; ++bj) *(u32x4*)(O + (size_t)row * 1024 + col0 + bj * HALF) = pack8(acc[ai][bj][m][0] * rs, acc[ai][bj][m][1] * rs);
            }
    }
};
struct EpiPle {
    static constexpr bool PERM = true, AFTER_DRAIN = false;
    float* H; const bf16_t* PP; const float* SS2; float* SS3;
    __device__ __forceinline__ void operator()(const f32x4 (&acc)[2][2][4][2], const Unit& u, int wr, int wc, int fr, int fq) const {
        const int col0 = u.pn * BM + wc * 32 + 8 * fq;
#pragma unroll
        for (int ai = 0; ai < 2; ++ai)
#pragma unroll
            for (int m = 0; m < 4; ++m) {
                const int row = u.pm * BM + ai * HALF + wr * 64 + m * 16 + fr; float ssq = 0.f;
                const float rs = rowscale8(SS2, row);
#pragma unroll
                for (int bj = 0; bj < 2; ++bj) {
                    const size_t off = (size_t)row * 1024 + col0 + bj * HALF;
                    const u32x4 pw = *(const u32x4*)(PP + off);
                    const f32x4 p0 = {bf_lo(pw.x), bf_hi(pw.x), bf_lo(pw.y), bf_hi(pw.y)}, p1 = {bf_lo(pw.z), bf_hi(pw.z), bf_lo(pw.w), bf_hi(pw.w)};
                    f32x4 g0, g1;
#pragma unroll
                    for (int j = 0; j < 4; ++j) { g0[j] = fsigmoid(acc[ai][bj][m][0][j] * rs); g1[j] = fsigmoid(acc[ai][bj][m][1][j] * rs); }
                    const f32x4 h0 = *(const f32x4*)(H + off) + g0 * p0, h1 = *(const f32x4*)(H + off + 4) + g1 * p1;
                    *(f32x4*)(H + off) = h0; *(f32x4*)(H + off + 4) = h1;
                    ssq += (h0[0] * h0[0] + h0[1] * h0[1]) + (h0[2] * h0[2] + h0[3] * h0[3]) + (h1[0] * h1[0] + h1[1] * h1[1]) + (h1[2] * h1[2] + h1[3] * h1[3]);
                }
                ssq += __shfl_xor(ssq, 16); ssq += __shfl_xor(ssq, 32);
                if (fq == 0) SS3[(size_t)row * 16 + u.pn * 4 + wc] = ssq;
            }
    }
};

template <class Epi, class Sched, bool ALIGN_EPI = false, bool SP2 = false>
__device__ __forceinline__ void gemm_phase(PG8_LAS unsigned char* lds, const Gemm g, const Sched& S, const Epi& E) {
    const int tid = fresh_tid(), wid = __builtin_amdgcn_readfirstlane(tid >> 6), lane = tid & 63, wr = wid >> 2, wc = wid & 3, fr = lane & 15, fq = lane >> 4;
    const int K = g.K, nt = K / BK;
    unsigned voffA[2], voffB[2];
#pragma unroll
    for (int i = 0; i < 2; ++i) { int R, C; stage_rc(tid * 16 + i * 8192, R, C); const int Rb = Epi::PERM ? ((R & ~31) + perm32(R & 31)) : R;
        voffA[i] = (unsigned)(R * K + C) * 2u; voffB[i] = (unsigned)(Rb * K + C) * 2u; }
    const size_t kstep = (size_t)(BK * 2);
    const size_t hstep = (size_t)HALF * K * 2;
    const size_t tstep = 2 * hstep;
    const unsigned ldsw = (unsigned)wid * 1024u;
    const int aoff = lds_byte(wr * 64 + fr, fq * 8), boff = lds_byte(wc * 32 + fr, fq * 8);
#define PG8_SA(b, h) (((b) * 2 + (h)) * HTB)
#define PG8_SB(b, h) ((4 + (b) * 2 + (h)) * HTB)
#define PG8_STAGE(bufoff, gbase, voff) do { _Pragma("unroll") for (int _i = 0; _i < 2; ++_i) \
        __builtin_amdgcn_global_load_lds((const unsigned*)((const char*)(gbase) + (voff)[_i]), (PG8_LAS unsigned*)(lds + (bufoff) + ldsw + _i * 8192), 16, 0, 0); } while (0)
#define PG8_LDA(dst, b, h) do { _Pragma("unroll") for (int m = 0; m < 4; ++m) _Pragma("unroll") for (int k = 0; k < 2; ++k) dst[m][k] = *(const PG8_LAS bf16x8*)(lds + PG8_SA(b, h) + aoff + m * 2048 + k * 1024); } while (0)
#define PG8_LDB(dst, b, h) do { _Pragma("unroll") for (int n = 0; n < 2; ++n) _Pragma("unroll") for (int k = 0; k < 2; ++k) dst[n][k] = *(const PG8_LAS bf16x8*)(lds + PG8_SB(b, h) + boff + n * 2048 + k * 1024); } while (0)
#define PG8_MMA(ai, bj, At, Bt) do { __builtin_amdgcn_s_setprio(1); _Pragma("unroll") for (int m = 0; m < 4; ++m) _Pragma("unroll") for (int n = 0; n < 2; ++n) _Pragma("unroll") for (int k = 0; k < 2; ++k) \
        acc[ai][bj][m][n] = __builtin_amdgcn_mfma_f32_16x16x32_bf16(Bt[n][k], At[m][k], acc[ai][bj][m][n], 0, 0, 0); __builtin_amdgcn_s_setprio(0); } while (0)
#define PG8_WAIT_V(n) asm volatile("s_waitcnt vmcnt(" #n ")" ::: "memory")
#define PG8_WAIT_L(n) asm volatile("s_waitcnt lgkmcnt(" #n ")" ::: "memory")
#define PG8_BAR __builtin_amdgcn_s_barrier()
#define PG8_SCHED __builtin_amdgcn_sched_barrier(0)
    Unit cur, nxt; int ui = 0;
    if (!S.next(0, cur)) return;
    f32x4 acc[2][2][4][2];
#pragma unroll
    for (int a = 0; a < 2; ++a)
#pragma unroll
        for (int b = 0; b < 2; ++b)
#pragma unroll
            for (int m = 0; m < 4; ++m)
#pragma unroll
                for (int n = 0; n < 2; ++n) acc[a][b][m][n] = (f32x4){0.f, 0.f, 0.f, 0.f};
    bf16x8 At[4][2], B0[2][2], B1[2][2];
    const char* cA = (const char*)g.A + (size_t)cur.pm * tstep; const char* cB = (const char*)g.Bt + (size_t)cur.pn * tstep;
    S.a_ready(cur);
    if constexpr (SP2) {
        PG8_STAGE(PG8_SB(0, 0), cB, voffB); PG8_STAGE(PG8_SB(0, 1), cB + hstep, voffB); PG8_STAGE(PG8_SA(0, 0), cA, voffA); PG8_STAGE(PG8_SA(0, 1), cA + hstep, voffA);
        if (wr == 1) PG8_BAR;
        PG8_WAIT_V(2); PG8_BAR;
        PG8_STAGE(PG8_SB(1, 0), cB + kstep, voffB); PG8_STAGE(PG8_SA(1, 0), cA + kstep, voffA); PG8_STAGE(PG8_SB(1, 1), cB + hstep + kstep, voffB);
        PG8_WAIT_V(6); PG8_BAR;
    } else {
        PG8_STAGE(PG8_SB(0, 0), cB, voffB); PG8_STAGE(PG8_SA(0, 0), cA, voffA); PG8_STAGE(PG8_SB(0, 1), cB + hstep, voffB); PG8_STAGE(PG8_SA(0, 1), cA + hstep, voffA);
        if (wr == 1) PG8_BAR;
        PG8_WAIT_V(4); PG8_BAR;
        PG8_STAGE(PG8_SB(1, 0), cB + kstep, voffB); PG8_STAGE(PG8_SA(1, 0), cA + kstep, voffA); PG8_STAGE(PG8_SB(1, 1), cB + hstep + kstep, voffB);
        PG8_WAIT_V(6); PG8_BAR;
    }
    for (;;) {
        const bool has_next = S.next(ui + 1, nxt);
        const char* nA = has_next ? (const char*)g.A + (size_t)nxt.pm * tstep : cA; const char* nB = has_next ? (const char*)g.Bt + (size_t)nxt.pn * tstep : cB;
        for (int t = 0; t < nt; t += 2) {
            const bool last = (t == nt - 2);
            const char* a1 = cA + (size_t)(t + 1) * kstep;
            const char* a2 = last ? nA : cA + (size_t)(t + 2) * kstep; const char* b2 = last ? nB : cB + (size_t)(t + 2) * kstep;
            const char* a3 = a2 + kstep; const char* b3 = b2 + kstep;
            if (last && has_next) S.a_ready(nxt);
            if constexpr (SP2) {
            PG8_LDB(B0, 0, 0); PG8_LDB(B1, 0, 1); PG8_SCHED; PG8_LDA(At, 0, 0); PG8_STAGE(PG8_SA(1, 1), a1 + hstep, voffA);
            PG8_WAIT_V(8); PG8_WAIT_L(0); PG8_BAR; PG8_MMA(0, 0, At, B0); PG8_MMA(0, 1, At, B1); PG8_BAR; PG8_SCHED;
            PG8_LDA(At, 0, 1); PG8_STAGE(PG8_SB(0, 0), b2, voffB); PG8_STAGE(PG8_SB(0, 1), b2 + hstep, voffB); PG8_STAGE(PG8_SA(0, 0), a2, voffA);
            PG8_WAIT_V(8); PG8_WAIT_L(0); PG8_BAR; PG8_MMA(1, 0, At, B0); PG8_MMA(1, 1, At, B1); PG8_BAR; PG8_SCHED;
            PG8_LDB(B0, 1, 0); PG8_LDB(B1, 1, 1); PG8_SCHED; PG8_LDA(At, 1, 0); PG8_STAGE(PG8_SA(0, 1), a2 + hstep, voffA);
            PG8_WAIT_V(8); PG8_WAIT_L(0); PG8_BAR; PG8_MMA(0, 0, At, B0); PG8_MMA(0, 1, At, B1); PG8_BAR; PG8_SCHED;
            PG8_LDA(At, 1, 1); PG8_STAGE(PG8_SB(1, 0), b3, voffB); PG8_STAGE(PG8_SB(1, 1), b3 + hstep, voffB); PG8_STAGE(PG8_SA(1, 0), a3, voffA);
            PG8_WAIT_V(8); PG8_WAIT_L(0); PG8_BAR; PG8_MMA(1, 0, At, B0); PG8_MMA(1, 1, At, B1); PG8_BAR; PG8_SCHED;
            } else {
            PG8_LDB(B0, 0, 0); PG8_SCHED; PG8_LDA(At, 0, 0); PG8_STAGE(PG8_SA(1, 1), a1 + hstep, voffA);
            PG8_WAIT_L(8); PG8_BAR; PG8_WAIT_L(0); PG8_MMA(0, 0, At, B0); PG8_BAR; PG8_SCHED;
            PG8_LDB(B1, 0, 1); PG8_STAGE(PG8_SB(0, 0), b2, voffB);
            PG8_BAR; PG8_WAIT_L(0); PG8_MMA(0, 1, At, B1); PG8_BAR;
            PG8_LDA(At, 0, 1); PG8_STAGE(PG8_SA(0, 0), a2, voffA);
            PG8_BAR; PG8_WAIT_L(0); PG8_MMA(1, 0, At, B0); PG8_BAR; PG8_SCHED;
            PG8_STAGE(PG8_SB(0, 1), b2 + hstep, voffB);
            PG8_WAIT_V(6); PG8_BAR; PG8_MMA(1, 1, At, B1); PG8_BAR;
            PG8_LDB(B0, 1, 0); PG8_SCHED; PG8_LDA(At, 1, 0); PG8_STAGE(PG8_SA(0, 1), a2 + hstep, voffA);
            PG8_WAIT_L(8); PG8_BAR; PG8_WAIT_L(0); PG8_MMA(0, 0, At, B0); PG8_BAR; PG8_SCHED;
            PG8_LDB(B1, 1, 1); PG8_STAGE(PG8_SB(1, 0), b3, voffB);
            PG8_BAR; PG8_WAIT_L(0); PG8_MMA(0, 1, At, B1); PG8_BAR;
            PG8_LDA(At, 1, 1); PG8_STAGE(PG8_SA(1, 0), a3, voffA);
            PG8_BAR; PG8_WAIT_L(0); PG8_MMA(1, 0, At, B0); PG8_BAR; PG8_SCHED;
            PG8_STAGE(PG8_SB(1, 1), b3 + hstep, voffB);
            PG8_WAIT_V(6); PG8_BAR; PG8_MMA(1, 1, At, B1); PG8_BAR;
            }
        }
        if constexpr (ALIGN_EPI) { if (wr == 0) PG8_BAR; }
        if constexpr (!Epi::AFTER_DRAIN) { E(acc, cur, wr, wc, fr, fq); S.done(cur); }
        if (!has_next) break;
#pragma unroll
        for (int a = 0; a < 2; ++a)
#pragma unroll
            for (int b = 0; b < 2; ++b)
#pragma unroll
                for (int m = 0; m < 4; ++m)
#pragma unroll
                    for (int n = 0; n < 2; ++n) acc[a][b][m][n] = (f32x4){0.f, 0.f, 0.f, 0.f};
        cur = nxt; cA = nA; cB = nB; ++ui;
        if constexpr (ALIGN_EPI) { if (wr == 1) PG8_BAR; }
    }
    PG8_WAIT_V(0);
    if constexpr (!ALIGN_EPI) { if (wr == 0) PG8_BAR; }
    PG8_BAR;
    if constexpr (Epi::AFTER_DRAIN) { E.fused(acc, cur, wr, wc, fr, fq, lds, wid, lane); S.done(cur); }
#undef PG8_SA
#undef PG8_SB
#undef PG8_STAGE
#undef PG8_LDA
#undef PG8_LDB
#undef PG8_MMA
#undef PG8_WAIT_V
#undef PG8_WAIT_L
#undef PG8_BAR
#undef PG8_SCHED
}
}
namespace att {
using bf16x8 = __attribute__((ext_vector_type(8))) short;
using s16x4  = __attribute__((ext_vector_type(4))) short;
using f32x16 = __attribute__((ext_vector_type(16))) float;
using f32x4  = __attribute__((ext_vector_type(4))) float;
using u32x4  = __attribute__((ext_vector_type(4))) unsigned;
constexpr int NW = 8, QBLK = 32, KVBLK = 64, LDK = 512;
constexpr float THR = 8.f;
constexpr size_t SHM_V = KVBLK * 128 * 2, SHM_K = KVBLK * 128 * 2;
constexpr int OST_OFF = 69632, OST_LD = 132;
#define KSWZ(row, colB) ((row) * 256 + ((colB) ^ (((row) & 7) << 4)))
#define SBAR() __builtin_amdgcn_sched_barrier(0)
__device__ __forceinline__ int crow(int r, int hi) { return (r & 3) + 8 * (r >> 2) + 4 * hi; }
__device__ __forceinline__ unsigned cvtpk(float lo, float hi) { unsigned r; asm volatile("v_cvt_pk_bf16_f32 %0, %1, %2" : "=v"(r) : "v"(lo), "v"(hi)); return r; }

__device__ __forceinline__ void partialSM(f32x16& p0, f32x16& p1, float& m_reg, float& mn, float& alpha) {
  constexpr float C = 1.4426950408889634f;
  float pmax = p0[0];
#pragma unroll
  for (int r = 1; r < 16; ++r) pmax = fmaxf(pmax, p0[r]);
#pragma unroll
  for (int r = 0; r < 16; ++r) pmax = fmaxf(pmax, p1[r]);
  { auto rr = __builtin_amdgcn_permlane32_swap(__float_as_uint(pmax), __float_as_uint(pmax), false, false);
    pmax = fmaxf(__uint_as_float(rr[0]), __uint_as_float(rr[1])); }
  if (__builtin_expect(__all(pmax - m_reg <= THR), 1)) { mn = m_reg; alpha = 1.f; }
  else { mn = fmaxf(m_reg, pmax); alpha = __builtin_amdgcn_exp2f((m_reg - mn) * C); m_reg = mn; }
  float mnC = -mn * C;
#pragma unroll
  for (int r = 0; r < 16; ++r) p0[r] = fmaf(p0[r], C, mnC);
#pragma unroll
  for (int r = 0; r < 16; ++r) p1[r] = fmaf(p1[r], C, mnC);
#pragma unroll
  for (int r = 0; r < 16; ++r) p0[r] = __builtin_amdgcn_exp2f(p0[r]);
}
__device__ __forceinline__ void finishSM(f32x16& p0, f32x16& p1, float alpha, float& l_reg, bf16x8& pa0, bf16x8& pa1, bf16x8& pa2, bf16x8& pa3) {
#pragma unroll
  for (int r = 0; r < 16; ++r) p1[r] = __builtin_amdgcn_exp2f(p1[r]);
  float ps = 0;
#pragma unroll
  for (int r = 0; r < 16; ++r) ps += p0[r];
#pragma unroll
  for (int r = 0; r < 16; ++r) ps += p1[r];
  { auto rr = __builtin_amdgcn_permlane32_swap(__float_as_uint(ps), __float_as_uint(ps), false, false);
    ps = __uint_as_float(rr[0]) + __uint_as_float(rr[1]); }
  l_reg = l_reg * alpha + ps;
#define PK4(P, BASE, OUT) do { unsigned a0 = cvtpk(P[BASE + 0], P[BASE + 1]), a1 = cvtpk(P[BASE + 2], P[BASE + 3]);   \
    unsigned b0 = cvtpk(P[BASE + 4], P[BASE + 5]), b1 = cvtpk(P[BASE + 6], P[BASE + 7]);                              \
    auto r0 = __builtin_amdgcn_permlane32_swap(a0, b0, false, false); auto r1 = __builtin_amdgcn_permlane32_swap(a1, b1, false, false); \
    u32x4 w = {r0[0], r1[0], r0[1], r1[1]}; OUT = *reinterpret_cast<bf16x8*>(&w); } while (0)
  PK4(p0, 0, pa0); PK4(p0, 8, pa1); PK4(p1, 0, pa2); PK4(p1, 8, pa3);
#undef PK4
}
__device__ __forceinline__ void qkt(f32x16& p0, f32x16& p1, const char* Ks, const bf16x8* qr, int r32, int hi, int mcolB) {
  p0 = f32x16{}; p1 = f32x16{};
#pragma unroll
  for (int d0 = 0; d0 < 4; ++d0) { int cb = mcolB + (d0 * 16 + hi * 8) * 2;
    bf16x8 b0 = *reinterpret_cast<const bf16x8*>(Ks + KSWZ(r32, cb));
    bf16x8 b1 = *reinterpret_cast<const bf16x8*>(Ks + KSWZ(32 + r32, cb));
    p0 = __builtin_amdgcn_mfma_f32_32x32x16_bf16(b0, qr[d0], p0, 0, 0, 0);
    p1 = __builtin_amdgcn_mfma_f32_32x32x16_bf16(b1, qr[d0], p1, 0, 0, 0); }
}
__device__ __forceinline__ int v_st(int k, int c) { const int kk = (k & ~0xC) | ((k & 4) << 1) | ((k & 8) >> 1); return ((kk >> 3) * 4 + (c >> 5)) * 512 + ((kk & 7) * 32 + (c & 31)) * 2; }
__device__ __forceinline__ int v_rd_base(int lane) { return ((lane & 3) << 3) | (((lane >> 2) & 3) << 6) | (((lane >> 4) & 1) << 5) | (((lane >> 5) & 1) << 8); }
constexpr int v_rd_off(int d0, int ks, int half) { return d0 * 512 + ks * 4096 + half * 2048; }
template <int OFF> __device__ __forceinline__ s16x4 tr_read(int vb) {
  s16x4 r; asm volatile("ds_read_b64_tr_b16 %0, %1 offset:%2" : "=&v"(r) : "v"(vb), "i"(OFF) : "memory"); return r;
}
template <int D0> __device__ __forceinline__ void pv_one(f32x16& od, int vb, bf16x8 pa0, bf16x8 pa1, bf16x8 pa2, bf16x8 pa3) {
  const s16x4 l0 = tr_read<v_rd_off(D0, 0, 0)>(vb), h0 = tr_read<v_rd_off(D0, 0, 1)>(vb), l1 = tr_read<v_rd_off(D0, 1, 0)>(vb), h1 = tr_read<v_rd_off(D0, 1, 1)>(vb);
  const s16x4 l2 = tr_read<v_rd_off(D0, 2, 0)>(vb), h2 = tr_read<v_rd_off(D0, 2, 1)>(vb), l3 = tr_read<v_rd_off(D0, 3, 0)>(vb), h3 = tr_read<v_rd_off(D0, 3, 1)>(vb);
  asm volatile("s_waitcnt lgkmcnt(0)" ::: "memory"); SBAR();
#define PK(L, H) (bf16x8){L[0], L[1], L[2], L[3], H[0], H[1], H[2], H[3]}
  od = __builtin_amdgcn_mfma_f32_32x32x16_bf16(pa0, PK(l0, h0), od, 0, 0, 0);
  od = __builtin_amdgcn_mfma_f32_32x32x16_bf16(pa1, PK(l1, h1), od, 0, 0, 0);
  od = __builtin_amdgcn_mfma_f32_32x32x16_bf16(pa2, PK(l2, h2), od, 0, 0, 0);
  od = __builtin_amdgcn_mfma_f32_32x32x16_bf16(pa3, PK(l3, h3), od, 0, 0, 0);
#undef PK
}
__device__ __forceinline__ void pv_d0(f32x16* o, int vb, bf16x8 pa0, bf16x8 pa1, bf16x8 pa2, bf16x8 pa3) {
  pv_one<0>(o[0], vb, pa0, pa1, pa2, pa3); pv_one<1>(o[1], vb, pa0, pa1, pa2, pa3); pv_one<2>(o[2], vb, pa0, pa1, pa2, pa3); pv_one<3>(o[3], vb, pa0, pa1, pa2, pa3);
}

__device__ __forceinline__ void attn_unit(int b, int h, int qb, const unsigned short* __restrict__ Qb, const unsigned short* __restrict__ Kb, const unsigned short* __restrict__ Vb,
                                          unsigned short* __restrict__ MX, const float* __restrict__ gdn, float lam, char* lds) {
  constexpr int SDEPTH = 1;
  const int tid = fresh_tid(), wid = tid >> 6, lane = tid & 63, r32 = lane & 31, hi = lane >> 5;
  const int mp = wid >> 2, qg = wid & 3;
  char* V_lds = lds; char* K_lds = lds + 2 * SHM_V;
  float* ws = (float*)(lds + 2 * SHM_V + 2 * SHM_K) + wid * 64; float* li_l = ws; float* al_l = ws + 32;
  float m_reg = -1e30f, l_reg = 0; f32x16 o[4] = {}; bf16x8 qr[4];
  const long tok0 = (long)b * 4096;
  const unsigned short* Qw = Qb + (tok0 + qb * 128 + qg * QBLK + r32) * LDK + h * 128 + mp * 64 + hi * 8;
#pragma unroll
  for (int d0 = 0; d0 < 4; ++d0) qr[d0] = *reinterpret_cast<const bf16x8*>(Qw + d0 * 16);
  const unsigned short* Kh = Kb + tok0 * LDK + h * 128; const unsigned short* Vh = Vb + tok0 * LDK + h * 128;
  const int sr = tid >> 4, sc = (tid & 15) * 8, vst0 = v_st(sr, sc), vst1 = v_st(32 + sr, sc);
  const int vb0 = (int)(uintptr_t)V_lds + v_rd_base(lane);
  const int mcolB = mp * 128;
  struct { bf16x8 vs0, vs1, ks0, ks1; } sr_[SDEPTH];
#define SLOAD(i, k0) do { sr_[i].vs0 = *reinterpret_cast<const bf16x8*>(&Vh[(long)((k0) + sr) * LDK + sc]); sr_[i].vs1 = *reinterpret_cast<const bf16x8*>(&Vh[(long)((k0) + 32 + sr) * LDK + sc]); \
    sr_[i].ks0 = *reinterpret_cast<const bf16x8*>(&Kh[(long)((k0) + sr) * LDK + sc]); sr_[i].ks1 = *reinterpret_cast<const bf16x8*>(&Kh[(long)((k0) + 32 + sr) * LDK + sc]); } while (0)
#define SWRITE(bb, i) do { *(bf16x8*)(V_lds + (bb) * SHM_V + vst0) = sr_[i].vs0;          \
    *(bf16x8*)(V_lds + (bb) * SHM_V + vst1) = sr_[i].vs1; int kc = sc * 2;               \
    *(bf16x8*)(K_lds + (bb) * SHM_K + KSWZ(sr, kc)) = sr_[i].ks0;                       \
    *(bf16x8*)(K_lds + (bb) * SHM_K + KSWZ(32 + sr, kc)) = sr_[i].ks1; } while (0)
#define SWAIT() do { if constexpr (SDEPTH == 2) asm volatile("s_waitcnt vmcnt(4)" ::: "memory"); else asm volatile("s_waitcnt vmcnt(0)" ::: "memory"); } while (0)
#define RESC(a) do { if (__any((a) < 1.f)) { if (hi == 0) al_l[r32] = (a); asm volatile("s_waitcnt lgkmcnt(0)" ::: "memory"); \
    _Pragma("unroll") for (int d = 0; d < 4; ++d) _Pragma("unroll") for (int r = 0; r < 16; ++r) o[d][r] *= al_l[crow(r, hi)]; } } while (0)
  f32x16 pA0, pA1, pB0, pB1; float mnA, mnB, alA, alB; bf16x8 pa0, pa1, pa2, pa3; const int NT = 4096 / KVBLK;
  constexpr int SE = 0, SO = SDEPTH - 1;
  SLOAD(SE, 0); asm volatile("s_waitcnt vmcnt(0)" ::: "memory"); SWRITE(0, SE); __syncthreads();
  qkt(pA0, pA1, K_lds, qr, r32, hi, mcolB); partialSM(pA0, pA1, m_reg, mnA, alA);
  SLOAD(SO, KVBLK); if constexpr (SDEPTH == 2) SLOAD(SE, 2 * KVBLK);
  SWAIT(); SWRITE(1, SO); __syncthreads();
  for (int j = 1; j + 1 < NT; j += 2) {
    SBAR(); qkt(pB0, pB1, K_lds + SHM_K, qr, r32, hi, mcolB);
    finishSM(pA0, pA1, alA, l_reg, pa0, pa1, pa2, pa3); SBAR();
    SLOAD(SO, (j + SDEPTH) * KVBLK); SBAR();
    pv_d0(o, vb0, pa0, pa1, pa2, pa3); partialSM(pB0, pB1, m_reg, mnB, alB);
    __syncthreads(); SWAIT(); SWRITE(0, SE);
    RESC(alB); __syncthreads();
    SBAR(); qkt(pA0, pA1, K_lds, qr, r32, hi, mcolB);
    finishSM(pB0, pB1, alB, l_reg, pa0, pa1, pa2, pa3); SBAR();
    if (SDEPTH == 1 || j + 3 < NT) SLOAD(SE, (j + 1 + SDEPTH) * KVBLK); SBAR();
    pv_d0(o, vb0 + (int)SHM_V, pa0, pa1, pa2, pa3); partialSM(pA0, pA1, m_reg, mnA, alA);
    __syncthreads(); SWAIT(); SWRITE(1, SO);
    RESC(alA); __syncthreads();
  }
  SBAR(); qkt(pB0, pB1, K_lds + SHM_K, qr, r32, hi, mcolB);
  finishSM(pA0, pA1, alA, l_reg, pa0, pa1, pa2, pa3); SBAR();
  pv_d0(o, vb0, pa0, pa1, pa2, pa3); partialSM(pB0, pB1, m_reg, mnB, alB);
  __syncthreads(); RESC(alB);
  finishSM(pB0, pB1, alB, l_reg, pa0, pa1, pa2, pa3); SBAR();
  pv_d0(o, vb0 + (int)SHM_V, pa0, pa1, pa2, pa3);
  if (hi == 0) li_l[r32] = l_reg; asm volatile("s_waitcnt lgkmcnt(0)" ::: "memory");
  float rli[16];
#pragma unroll
  for (int r = 0; r < 16; ++r) rli[r] = __builtin_amdgcn_rcpf(li_l[crow(r, hi)]);
  float* Ost = (float*)(lds + OST_OFF);
  const int rowb = 32 * qg;
  if (mp == 1) {
#pragma unroll
    for (int r = 0; r < 16; ++r)
#pragma unroll
      for (int d0 = 0; d0 < 4; ++d0) Ost[(rowb + crow(r, hi)) * OST_LD + d0 * 32 + r32] = lam * (o[d0][r] * rli[r]);
  }
  __syncthreads();
  if (mp == 0) {
#pragma unroll
    for (int r = 0; r < 16; ++r)
#pragma unroll
      for (int d0 = 0; d0 < 4; ++d0) { const int ix = (rowb + crow(r, hi)) * OST_LD + d0 * 32 + r32; Ost[ix] = o[d0][r] * rli[r] - Ost[ix]; }
  }
  __syncthreads();
  {
    const int row = 16 * wid + (lane >> 2), cb = (lane & 3) * 32;
    f32x4 v[8]; float ss = 0.f;
#pragma unroll
    for (int i = 0; i < 8; ++i) { v[i] = *(const f32x4*)&Ost[row * OST_LD + cb + 4 * i]; ss += (v[i][0] * v[i][0] + v[i][1] * v[i][1]) + (v[i][2] * v[i][2] + v[i][3] * v[i][3]); }
    ss += __shfl_xor(ss, 1); ss += __shfl_xor(ss, 2);
    const float scl = (1.0f - 0.2f) / sqrtf(ss * (1.0f / 128.0f) + 1e-6f);
    unsigned short* op = MX + (tok0 + qb * 128 + row) * 1024 + h * 128 + cb;
#pragma unroll
    for (int i = 0; i < 4; ++i) {
      const f32x4 g0 = *(const f32x4*)(gdn + cb + 8 * i), g1 = *(const f32x4*)(gdn + cb + 8 * i + 4);
      const f32x4 a = v[2 * i] * g0 * scl, c = v[2 * i + 1] * g1 * scl;
      u32x4 w = {cvtpk(a[0], a[1]), cvtpk(a[2], a[3]), cvtpk(c[0], c[1]), cvtpk(c[2], c[3])};
      *(u32x4*)(op + 8 * i) = w;
    }
  }
  __syncthreads();
#undef SLOAD
#undef SWRITE
#undef SWAIT
#undef RESC
}
#undef KSWZ
#undef SBAR
}

#define LAS __attribute__((address_space(3)))
typedef unsigned short bf16;
typedef float f32x4 __attribute__((ext_vector_type(4)));
typedef float f32x16 __attribute__((ext_vector_type(16)));
typedef short bf16x8 __attribute__((ext_vector_type(8)));
typedef unsigned u32x4 __attribute__((ext_vector_type(4)));
typedef unsigned u32x2 __attribute__((ext_vector_type(2)));
__device__ __forceinline__ unsigned f2bf(float f) { unsigned u = __builtin_bit_cast(unsigned, f); return (u + 0x7fffu + ((u >> 16) & 1u)) >> 16; }
__device__ __forceinline__ unsigned pk2(float lo, float hi) { return f2bf(lo) | (f2bf(hi) << 16); }
__device__ __forceinline__ float bflo(unsigned w) { return __uint_as_float(w << 16); }
__device__ __forceinline__ float bfhi(unsigned w) { return __uint_as_float(w & 0xffff0000u); }
__device__ __forceinline__ float bf1(unsigned short h) { return __uint_as_float(((unsigned)h) << 16); }
__device__ __forceinline__ float sigm(float z) { return __builtin_amdgcn_rcpf(1.0f + __expf(-z)); }
__device__ __forceinline__ float gelu_tanh(float x) { return x * sigm(1.5957691216057308f * (x + 0.044715f * x * x * x)); }
__device__ __forceinline__ float wave_sum(float v) {
#pragma unroll
    for (int o = 1; o < 64; o <<= 1) v += __shfl_xor(v, o);
    return v;
}
__device__ __forceinline__ int crow16(int r, int hi) { return (r & 3) + 8 * (r >> 2) + 4 * hi; }

struct LruArgs { const bf16* LIN; const float* conv_w; const float* conv_b; const bf16* LWT; const float* ba; const float* bx; const float* lam; bf16* HOUT; };
__device__ __forceinline__ void lru_item(int b, int n, int dir, const LruArgs& A, char* lds) {
    const int tid = fresh_tid(), wid = tid >> 6, lane = tid & 63, r32 = lane & 31, hi = lane >> 5;
    bf16* ucs = (bf16*)lds; float* als = (float*)(lds + 18432); float* bls = (float*)(lds + 51200);
    float* cA = (float*)(lds + 83968); float* cH = (float*)(lds + 86016); float* cw = (float*)(lds + 88064);
    const bool fwd = (dir == 0);
    if (tid < 256) cw[tid] = A.conv_w[(tid >> 6) * 512 + n * 64 + (tid & 63)];
    else if (tid < 320) cw[tid] = A.conv_b[n * 64 + (tid - 256)];
    const int rt = wid >> 1, ch = wid & 1;
    bf16x8 wfa[4], wfx[4];
    {
        const bf16* wa = A.LWT + ((size_t)((dir * 8 + n) * 2 + 0) * 64 + ch * 32 + r32) * 64 + hi * 8;
        const bf16* wx = A.LWT + ((size_t)((dir * 8 + n) * 2 + 1) * 64 + ch * 32 + r32) * 64 + hi * 8;
#pragma unroll
        for (int ks = 0; ks < 4; ++ks) { wfa[ks] = *(const bf16x8*)(wa + ks * 16); wfx[ks] = *(const bf16x8*)(wx + ks * 16); }
    }
    const int cg_ = ch * 32 + r32;
    const float bav = A.ba[dir * 512 + n * 64 + cg_], bxv = A.bx[dir * 512 + n * 64 + cg_];
    const float lamv = A.lam[dir * 512 + n * 64 + cg_];
    const float spv = -8.0f * log1pf(__expf(-lamv));
    float state = 0.f;
    const long tokb = (long)b * 4096;
    __syncthreads();
    for (int ci = 0; ci < 32; ++ci) {
        const int t0 = (fwd ? ci : 31 - ci) * 128;
        {
            const int tt = tid >> 2, c0 = (tid & 3) * 16;
            float accv[16];
#pragma unroll
            for (int i = 0; i < 16; ++i) accv[i] = cw[256 + c0 + i];
#pragma unroll
            for (int j = 0; j < 4; ++j) {
                const int s = t0 + tt + j - 2;
                if (s >= 0 && s < 4096) {
                    const u32x4 w0 = *(const u32x4*)(A.LIN + (tokb + s) * 512 + n * 64 + c0), w1 = *(const u32x4*)(A.LIN + (tokb + s) * 512 + n * 64 + c0 + 8);
                    const float* cwj = cw + j * 64 + c0;
                    accv[0] += bflo(w0.x) * cwj[0]; accv[1] += bfhi(w0.x) * cwj[1]; accv[2] += bflo(w0.y) * cwj[2]; accv[3] += bfhi(w0.y) * cwj[3];
                    accv[4] += bflo(w0.z) * cwj[4]; accv[5] += bfhi(w0.z) * cwj[5]; accv[6] += bflo(w0.w) * cwj[6]; accv[7] += bfhi(w0.w) * cwj[7];
                    accv[8] += bflo(w1.x) * cwj[8]; accv[9] += bfhi(w1.x) * cwj[9]; accv[10] += bflo(w1.y) * cwj[10]; accv[11] += bfhi(w1.y) * cwj[11];
                    accv[12] += bflo(w1.z) * cwj[12]; accv[13] += bfhi(w1.z) * cwj[13]; accv[14] += bflo(w1.w) * cwj[14]; accv[15] += bfhi(w1.w) * cwj[15];
                }
            }
            u32x4 o0 = {pk2(accv[0], accv[1]), pk2(accv[2], accv[3]), pk2(accv[4], accv[5]), pk2(accv[6], accv[7])};
            u32x4 o1 = {pk2(accv[8], accv[9]), pk2(accv[10], accv[11]), pk2(accv[12], accv[13]), pk2(accv[14], accv[15])};
            *(u32x4*)(ucs + tt * 72 + c0) = o0; *(u32x4*)(ucs + tt * 72 + c0 + 8) = o1;
        }
        __syncthreads();
        {
            f32x16 da = {}, dx = {};
#pragma unroll
            for (int ks = 0; ks < 4; ++ks) {
                const bf16x8 af = *(const bf16x8*)(ucs + (rt * 32 + r32) * 72 + ks * 16 + hi * 8);
                da = __builtin_amdgcn_mfma_f32_32x32x16_bf16(af, wfa[ks], da, 0, 0, 0);
                dx = __builtin_amdgcn_mfma_f32_32x32x16_bf16(af, wfx[ks], dx, 0, 0, 0);
            }
#pragma unroll
            for (int r = 0; r < 16; ++r) {
                const int tk = rt * 32 + crow16(r, hi);
                const float rr = sigm(da[r] + bav), ii = sigm(dx[r] + bxv);
                const float la = spv * rr, av = __expf(la), mult = sqrtf(fmaxf(1.0f - av * av, 0.f));
                const float uv = bf1(ucs[tk * 72 + cg_]);
                als[tk * 64 + cg_] = av; bls[tk * 64 + cg_] = mult * (ii * uv);
            }
        }
        __syncthreads();
        {
            const int c = tid & 63, j = tid >> 6;
            float hl[16], Ac[16]; float hh = 0.f, AA = 1.f;
#pragma unroll
            for (int i = 0; i < 16; ++i) { const int p = j * 16 + i, tt = fwd ? p : 127 - p; const float av = als[tt * 64 + c], bv = bls[tt * 64 + c]; hh = av * hh + bv; AA = AA * av; hl[i] = hh; Ac[i] = AA; }
            cA[j * 64 + c] = AA; cH[j * 64 + c] = hh;
            __syncthreads();
            float s = state, sin_ = state;
#pragma unroll
            for (int jj = 0; jj < 8; ++jj) { if (jj == j) sin_ = s; s = cA[jj * 64 + c] * s + cH[jj * 64 + c]; }
            state = s;
            bf16* outp = A.HOUT + (tokb + t0) * 512 + n * 64 + c;
#pragma unroll
            for (int i = 0; i < 16; ++i) { const int p = j * 16 + i, tt = fwd ? p : 127 - p; outp[(long)tt * 512] = (bf16)f2bf(hl[i] + Ac[i] * sin_); }
        }
        __syncthreads();
    }
}

__device__ __forceinline__ unsigned mono_key(float f) { const unsigned b = __float_as_uint(f); return b ^ ((unsigned)((int)b >> 31) | 0x80000000u); }
#define TK_INS(L, xin) do { unsigned x_ = (xin); _Pragma("unroll") for (int q_ = 0; q_ < 16; ++q_) { const unsigned t_ = max(L[q_], x_); x_ = min(L[q_], x_); L[q_] = t_; } } while (0)
struct TopkArgs { const bf16* QP; const bf16* KEYS; unsigned short* IDX; float* GW; };
__device__ __forceinline__ void topk_unit(int tile, const TopkArgs& A, const bf16x8 (&kf)[4][4], char* lds) {
    const int tid = fresh_tid(), wid = tid >> 6, lane = tid & 63, r32 = lane & 31, hi = lane >> 5;
    float* sc = (float*)lds; unsigned* sci = (unsigned*)lds;
    const int t0 = tile * 64;
    for (int hp = 0; hp < 4; ++hp) {
        {
            const int combo = wid >> 1, head = 2 * hp + (wid >> 2), half = (wid >> 1) & 1, rtile = wid & 1;
            const bf16* qrow = A.QP + (size_t)(t0 + rtile * 32 + r32) * 1024 + head * 128 + half * 64 + hi * 8;
            bf16x8 af[4];
#pragma unroll
            for (int ks = 0; ks < 4; ++ks) af[ks] = *(const bf16x8*)(qrow + ks * 16);
#pragma unroll
            for (int ct = 0; ct < 4; ++ct) {
                f32x16 d = {};
#pragma unroll
                for (int ks = 0; ks < 4; ++ks) d = __builtin_amdgcn_mfma_f32_32x32x16_bf16(af[ks], kf[ct][ks], d, 0, 0, 0);
#pragma unroll
                for (int r = 0; r < 16; ++r) sc[(combo * 64 + rtile * 32 + crow16(r, hi)) * 132 + ct * 32 + r32] = d[r];
            }
        }
        __syncthreads();
        {
            const int row = tid >> 1, part = tid & 1;
            const float* rowp = sc + row * 132 + part * 64;
            unsigned L[16];
#pragma unroll
            for (int q = 0; q < 16; ++q) L[q] = 0u;
#pragma unroll
            for (int i = 0; i < 16; ++i) {
                const f32x4 v = *(const f32x4*)(rowp + 4 * i);
#pragma unroll
                for (int j = 0; j < 4; ++j) { const unsigned key = (mono_key(v[j]) & ~127u) | (127u - (unsigned)(part * 64 + 4 * i + j)); TK_INS(L, key); }
            }
            unsigned P[16];
#pragma unroll
            for (int q = 0; q < 16; ++q) P[q] = __shfl_xor(L[q], 1);
#pragma unroll
            for (int q = 0; q < 16; ++q) TK_INS(L, P[q]);
            float vals[16]; unsigned ids[16];
#pragma unroll
            for (int q = 0; q < 16; ++q) { ids[q] = 127u - (L[q] & 127u); vals[q] = sc[row * 132 + ids[q]]; }
            asm volatile("s_waitcnt lgkmcnt(0)" ::: "memory");
            if (part == 0) {
#pragma unroll
                for (int q = 0; q < 16; ++q) { sc[row * 132 + q] = vals[q]; sci[row * 132 + 16 + q] = ids[q]; }
            }
        }
        __syncthreads();
        if (tid < 128) {
            const int tok = tid & 63, hh = tid >> 6;
            const int row1 = (hh * 2 + 0) * 64 + tok, row2 = (hh * 2 + 1) * 64 + tok;
            float v1[16], v2[16];
#pragma unroll
            for (int q = 0; q < 16; ++q) { v1[q] = sc[row1 * 132 + q]; v2[q] = sc[row2 * 132 + q]; }
            unsigned L[16];
#pragma unroll
            for (int q = 0; q < 16; ++q) L[q] = 0u;
#pragma unroll
            for (int i = 0; i < 16; ++i)
#pragma unroll
                for (int j = 0; j < 16; ++j)
                    if ((i + 1) * (j + 1) <= 16) { const unsigned key = (mono_key(v1[i] + v2[j]) & ~255u) | (255u - (unsigned)(i * 16 + j)); TK_INS(L, key); }
            float sv[16]; unsigned ev[16]; float mx = -3.0e38f;
#pragma unroll
            for (int q = 0; q < 16; ++q) {
                const unsigned pos = 255u - (L[q] & 255u), i = pos >> 4, j = pos & 15u;
                sv[q] = sc[row1 * 132 + i] + sc[row2 * 132 + j];
                ev[q] = sci[row1 * 132 + 16 + i] * 128u + sci[row2 * 132 + 16 + j];
                mx = fmaxf(mx, sv[q]);
            }
            float sum = 0.f;
#pragma unroll
            for (int q = 0; q < 16; ++q) { sv[q] = __expf(sv[q] - mx); sum += sv[q]; }
            const float inv = 1.0f / sum;
            const size_t ob = (size_t)(t0 + tok) * 128 + (2 * hp + hh) * 16;
#pragma unroll
            for (int q = 0; q < 16; ++q) { A.IDX[ob + q] = (unsigned short)ev[q]; A.GW[ob + q] = sv[q] * inv; }
        }
        __syncthreads();
    }
}

struct PeerArgs { const unsigned short* IDX; const bf16* HB; const bf16* UT; const bf16* VT; float* PLOG; const float* ACT; float* H; bf16* H2B; float* SS2; };
__device__ __forceinline__ float dot8(const float (&x)[8], u32x4 u) {
    float s = x[0] * bflo(u.x); s = fmaf(x[1], bfhi(u.x), s); s = fmaf(x[2], bflo(u.y), s); s = fmaf(x[3], bfhi(u.y), s);
    s = fmaf(x[4], bflo(u.z), s); s = fmaf(x[5], bfhi(u.z), s); s = fmaf(x[6], bflo(u.w), s); s = fmaf(x[7], bfhi(u.w), s); return s;
}
__device__ __forceinline__ void peer_u_item(int tile, int s, const PeerArgs& A, char* lds) {
    const int tid = fresh_tid(), wid = tid >> 6, lane = tid & 63, e4 = lane >> 4, c = lane & 15;
    unsigned short* widx = (unsigned short*)(lds + wid * 1024);
    for (int tt = wid; tt < 128; tt += 8) {
        const int t = tile * 128 + tt;
        widx[lane] = A.IDX[(size_t)t * 128 + lane]; widx[64 + lane] = A.IDX[(size_t)t * 128 + 64 + lane];
        const u32x4 xw = *(const u32x4*)(A.HB + (size_t)t * 1024 + s * 128 + c * 8);
        const float xf[8] = {bflo(xw.x), bfhi(xw.x), bflo(xw.y), bfhi(xw.y), bflo(xw.z), bfhi(xw.z), bflo(xw.w), bfhi(xw.w)};
        asm volatile("s_waitcnt lgkmcnt(0)" ::: "memory");
        float p[32];
#pragma unroll
        for (int gb = 0; gb < 4; ++gb) {
            u32x4 uw[8];
#pragma unroll
            for (int g = 0; g < 8; ++g) { const unsigned e = widx[4 * (gb * 8 + g) + e4]; uw[g] = *(const u32x4*)(A.UT + (size_t)e * 1024 + s * 128 + c * 8); }
#pragma unroll
            for (int g = 0; g < 8; ++g) p[gb * 8 + g] = dot8(xf, uw[g]);
        }
#pragma unroll
        for (int i = 0; i < 16; ++i) { const bool up = (c & 8) != 0; const float give = up ? p[i] : p[i + 16]; const float keep = up ? p[i + 16] : p[i]; p[i] = keep + __shfl_xor(give, 8); }
#pragma unroll
        for (int i = 0; i < 8; ++i) { const bool up = (c & 4) != 0; const float give = up ? p[i] : p[i + 8]; const float keep = up ? p[i + 8] : p[i]; p[i] = keep + __shfl_xor(give, 4); }
#pragma unroll
        for (int i = 0; i < 4; ++i) { const bool up = (c & 2) != 0; const float give = up ? p[i] : p[i + 4]; const float keep = up ? p[i + 4] : p[i]; p[i] = keep + __shfl_xor(give, 2); }
#pragma unroll
        for (int i = 0; i < 2; ++i) { const bool up = (c & 1) != 0; const float give = up ? p[i] : p[i + 2]; const float keep = up ? p[i + 2] : p[i]; p[i] = keep + __shfl_xor(give, 1); }
        float* po = A.PLOG + ((size_t)s * T + t) * 128;
        po[4 * (2 * c) + e4] = p[0]; po[4 * (2 * c + 1) + e4] = p[1];
    }
}
__device__ __forceinline__ void peer_v_item(int tile, int s, const PeerArgs& A, char* lds) {
    const int tid = fresh_tid(), wid = tid >> 6, lane = tid & 63, e4 = lane >> 4, c = lane & 15;
    unsigned short* widx = (unsigned short*)(lds + wid * 1024); float* wact = (float*)(lds + wid * 1024 + 256);
    for (int tt = wid; tt < 128; tt += 8) {
        const int t = tile * 128 + tt;
        widx[lane] = A.IDX[(size_t)t * 128 + lane]; widx[64 + lane] = A.IDX[(size_t)t * 128 + 64 + lane];
        wact[lane] = A.ACT[(size_t)t * 128 + lane]; wact[64 + lane] = A.ACT[(size_t)t * 128 + 64 + lane];
        asm volatile("s_waitcnt lgkmcnt(0)" ::: "memory");
        float acc[8];
#pragma unroll
        for (int j = 0; j < 8; ++j) acc[j] = 0.f;
#pragma unroll
        for (int gb = 0; gb < 4; ++gb) {
            u32x4 vw[8]; float av[8];
#pragma unroll
            for (int g = 0; g < 8; ++g) { const int k = 4 * (gb * 8 + g) + e4; const unsigned e = widx[k]; av[g] = wact[k]; vw[g] = *(const u32x4*)(A.VT + (size_t)e * 1024 + s * 128 + c * 8); }
#pragma unroll
            for (int g = 0; g < 8; ++g) {
                acc[0] = fmaf(av[g], bflo(vw[g].x), acc[0]); acc[1] = fmaf(av[g], bfhi(vw[g].x), acc[1]); acc[2] = fmaf(av[g], bflo(vw[g].y), acc[2]); acc[3] = fmaf(av[g], bfhi(vw[g].y), acc[3]);
                acc[4] = fmaf(av[g], bflo(vw[g].z), acc[4]); acc[5] = fmaf(av[g], bfhi(vw[g].z), acc[5]); acc[6] = fmaf(av[g], bflo(vw[g].w), acc[6]); acc[7] = fmaf(av[g], bfhi(vw[g].w), acc[7]);
            }
        }
#pragma unroll
        for (int j = 0; j < 8; ++j) { acc[j] += __shfl_xor(acc[j], 16); acc[j] += __shfl_xor(acc[j], 32); }
        float* hp = A.H + (size_t)t * 1024 + s * 128 + c * 8;
        float ssq = 0.f;
        if (e4 == 0) {
            f32x4 h0 = *(const f32x4*)hp, h1 = *(const f32x4*)(hp + 4);
            h0[0] += acc[0]; h0[1] += acc[1]; h0[2] += acc[2]; h0[3] += acc[3]; h1[0] += acc[4]; h1[1] += acc[5]; h1[2] += acc[6]; h1[3] += acc[7];
            *(f32x4*)hp = h0; *(f32x4*)(hp + 4) = h1;
            u32x4 w = {pk2(h0[0], h0[1]), pk2(h0[2], h0[3]), pk2(h1[0], h1[1]), pk2(h1[2], h1[3])};
            *(u32x4*)(A.H2B + (size_t)t * 1024 + s * 128 + c * 8) = w;
            ssq = (h0[0] * h0[0] + h0[1] * h0[1]) + (h0[2] * h0[2] + h0[3] * h0[3]) + (h1[0] * h1[0] + h1[1] * h1[1]) + (h1[2] * h1[2] + h1[3] * h1[3]);
        }
        ssq += __shfl_xor(ssq, 1); ssq += __shfl_xor(ssq, 2); ssq += __shfl_xor(ssq, 4); ssq += __shfl_xor(ssq, 8);
        if (lane == 0) A.SS2[(size_t)t * 8 + s] = ssq;
    }
}

constexpr size_t MiB = (size_t)1 << 20;
constexpr size_t WS_CTL = 0, CTL_ZERO_BYTES = 1 * MiB;
constexpr size_t WS_WIN = 1 * MiB, WS_WOUT = 6 * MiB, WS_WQ = 8 * MiB, WS_WG = 10 * MiB, WS_WP = 12 * MiB;
constexpr size_t WS_KEYS = 12 * MiB + 512 * 1024, WS_LWT = 12 * MiB + 768 * 1024, WS_ROPE = 13 * MiB, WS_MISC = 15 * MiB;
constexpr size_t WS_SS1 = 16 * MiB, WS_SS2 = 18 * MiB, WS_SS3 = 20 * MiB;
constexpr size_t WS_IDX = 24 * MiB, WS_GW = 32 * MiB, WS_PB = 48 * MiB;
constexpr size_t WS_UT = 64 * MiB, WS_VT = 96 * MiB;
constexpr size_t WS_XN = 128 * MiB;
constexpr size_t WS_Q = 192 * MiB, WS_K = 224 * MiB, WS_V = 256 * MiB, WS_LIN = 288 * MiB, WS_LGATE = 320 * MiB;
constexpr size_t WS_QP = 192 * MiB;
constexpr size_t WS_MIXED = 352 * MiB, WS_HF = 416 * MiB, WS_HB = 448 * MiB;
constexpr size_t WS_PLOG = 352 * MiB;
constexpr size_t WS_ACT = 256 * MiB;
constexpr size_t WS_END = 480 * MiB;
constexpr int LDS_BYTES = 147456;

struct Args {
    const float* in[29]; float* out; unsigned char* ws; int ph_lo, ph_hi, coop, pad;
};
struct Frame { char* lds; int G, bid; const Args* a; unsigned char* ws; };


__device__ __forceinline__ void p0_transpose_item(const float* W, int K, int N, bf16* WT, const float* gk, float* scr, int item, int lane) {
    const int nblk = N / 32, kb = item / nblk, nb = item % nblk, k0 = 64 * kb, n0 = 32 * nb;
#pragma unroll 8
    for (int i = 0; i < 32; ++i) { const int kk = 2 * i + (lane >> 5); float w = W[(size_t)(k0 + kk) * N + n0 + (lane & 31)]; if (gk) w *= gk[k0 + kk]; scr[kk * 33 + (lane & 31)] = w; }
    asm volatile("s_waitcnt lgkmcnt(0)" ::: "memory");
    const int c = lane & 7;
#pragma unroll
    for (int j = 0; j < 4; ++j) { const int n = (lane >> 3) + 8 * j; const float* s = scr + (8 * c) * 33 + n;
        u32x4 o; o.x = pk2(s[0 * 33], s[1 * 33]); o.y = pk2(s[2 * 33], s[3 * 33]); o.z = pk2(s[4 * 33], s[5 * 33]); o.w = pk2(s[6 * 33], s[7 * 33]);
        *(u32x4*)(WT + (size_t)(n0 + n) * K + k0 + 8 * c) = o; }
    asm volatile("s_waitcnt lgkmcnt(0)" ::: "memory");
}
__device__ __forceinline__ void p0_prologue(Frame& F) {
    const int tid_ = fresh_tid(), lane_ = tid_ & 63, wave_ = __builtin_amdgcn_readfirstlane(tid_ >> 6);
    float* scr = (float*)(F.lds + wave_ * 16384);
    const int gw = F.bid * 8 + wave_, NGW = F.G * 8;
    const long gt = (long)F.bid * 512 + tid_, NGT = (long)F.G * 512;
    unsigned char* ws = F.ws;
    constexpr int I_IN = 16 * 80, I_SQ = 16 * 32, I_P = 4 * 32;
    for (int it = gw; it < I_IN + 3 * I_SQ + I_P; it += NGW) {
        int r = it;
        if (r < I_IN) { p0_transpose_item(F.a->in[4], 1024, 2560, (bf16*)(ws + WS_WIN), nullptr, scr, r, lane_); continue; } r -= I_IN;
        if (r < I_SQ) { p0_transpose_item(F.a->in[18], 1024, 1024, (bf16*)(ws + WS_WOUT), nullptr, scr, r, lane_); continue; } r -= I_SQ;
        if (r < I_SQ) { p0_transpose_item(F.a->in[20], 1024, 1024, (bf16*)(ws + WS_WQ), F.a->in[19], scr, r, lane_); continue; } r -= I_SQ;
        if (r < I_SQ) { p0_transpose_item(F.a->in[26], 1024, 1024, (bf16*)(ws + WS_WG), F.a->in[25], scr, r, lane_); continue; } r -= I_SQ;
        p0_transpose_item(F.a->in[27], 256, 1024, (bf16*)(ws + WS_WP), nullptr, scr, r, lane_);
    }
    for (int m = gw; m < T; m += NGW) {
        const f32x4* xr = (const f32x4*)(F.a->in[0] + (size_t)m * 1024) + lane_; const f32x4* gr = (const f32x4*)F.a->in[3] + lane_;
        f32x4 v[4]; float s = 0.f;
#pragma unroll
        for (int j = 0; j < 4; ++j) { v[j] = xr[64 * j]; s += (v[j][0] * v[j][0] + v[j][1] * v[j][1]) + (v[j][2] * v[j][2] + v[j][3] * v[j][3]); }
        const float rstd = 1.0f / sqrtf(wave_sum(s) * (1.0f / 1024.0f) + EPS);
        u32x2* o8 = (u32x2*)(ws + WS_XN + (size_t)m * 2048) + lane_;
#pragma unroll
        for (int j = 0; j < 4; ++j) { const f32x4 g = gr[64 * j]; u32x2 w = {pk2(v[j][0] * rstd * g[0], v[j][1] * rstd * g[1]), pk2(v[j][2] * rstd * g[2], v[j][3] * rstd * g[3])}; o8[64 * j] = w; }
    }
    for (long i = gt; i < (long)T * PLE / 8; i += NGT) {
        const f32x4 a = *(const f32x4*)(F.a->in[1] + i * 8), b = *(const f32x4*)(F.a->in[1] + i * 8 + 4);
        u32x4 w = {pk2(a[0], a[1]), pk2(a[2], a[3]), pk2(b[0], b[1]), pk2(b[2], b[3])}; *(u32x4*)(ws + WS_PB + i * 16) = w;
    }
    for (long i = gt; i < (long)16384 * 1024 / 8; i += NGT) {
        const int c0 = (int)((i * 8) & 1023);
        const f32x4 a = *(const f32x4*)(F.a->in[23] + i * 8), b = *(const f32x4*)(F.a->in[23] + i * 8 + 4), g0 = *(const f32x4*)(F.a->in[19] + c0), g1 = *(const f32x4*)(F.a->in[19] + c0 + 4);
        u32x4 w = {pk2(a[0] * g0[0], a[1] * g0[1]), pk2(a[2] * g0[2], a[3] * g0[3]), pk2(b[0] * g1[0], b[1] * g1[1]), pk2(b[2] * g1[2], b[3] * g1[3])}; *(u32x4*)(ws + WS_UT + i * 16) = w;
        const f32x4 c = *(const f32x4*)(F.a->in[24] + i * 8), d = *(const f32x4*)(F.a->in[24] + i * 8 + 4);
        u32x4 w2 = {pk2(c[0], c[1]), pk2(c[2], c[3]), pk2(d[0], d[1]), pk2(d[2], d[3])}; *(u32x4*)(ws + WS_VT + i * 16) = w2;
    }
    for (long i = gt; i < (long)T * 8; i += NGT) {
        const int t = (int)(i >> 3), k = (int)(i & 7);
        const float invf[8] = {1.0f, 0.19392274474868576f, 0.03760603093086393f, 0.007292664737217109f, 0.001414213562373095f, 0.0002742481756762073f, 5.318295896944988e-05f, 1.031338537721246e-05f};
        float fr = 1.0f;
#pragma unroll
        for (int q = 0; q < 8; ++q) if (q == k) fr = invf[q];
        const float ang = (float)((const int*)F.a->in[2])[t] * fr; float sn, cs; sincosf(ang, &sn, &cs);
        float* rp = (float*)(ws + WS_ROPE) + (size_t)t * 16; rp[k] = cs; rp[8 + k] = sn;
    }
    for (long i = gt; i < 2 * 8192; i += NGT) { const float v = (i < 8192) ? F.a->in[21][i] : F.a->in[22][i - 8192]; ((bf16*)(ws + WS_KEYS))[i] = (bf16)f2bf(v); }
    for (long i = gt; i < 2 * 8 * 2 * 64 * 64; i += NGT) {
        const int c = (int)(i & 63), e = (int)((i >> 6) & 63), gate = (int)((i >> 12) & 1), n = (int)((i >> 13) & 7), dir = (int)(i >> 16);
        const float* w = gate ? F.a->in[14] : F.a->in[12]; ((bf16*)(ws + WS_LWT))[i] = (bf16)f2bf(w[(((size_t)dir * 8 + n) * 64 + c) * 64 + e]);
    }
    if (F.bid == 0 && tid_ == 0) {
        float s1 = 0.f, s2 = 0.f;
        for (int i = 0; i < 64; ++i) { s1 += F.a->in[5][i] * F.a->in[6][i]; s2 += F.a->in[7][i] * F.a->in[8][i]; }
        ((float*)(ws + WS_MISC))[0] = expf(s1) - expf(s2) + LAMBDA_INIT;
    }
}

__global__ void __launch_bounds__(512, 2) enc_fwd(Args args) {
    extern __shared__ __attribute__((aligned(16))) unsigned char lds_raw[];
    Frame F;
    F.lds = (char*)lds_raw; F.G = gridDim.x; F.bid = blockIdx.x;
    F.a = &args; F.ws = args.ws;
    unsigned char* ws = args.ws;
    const int lo = args.ph_lo, hi = args.ph_hi;
    cg::grid_group grid = cg::this_grid();
#ifndef PHMASK
#define PHMASK 0x1fff
#endif
#define IN(k) ((((PHMASK) >> (k)) & 1) && lo <= (k) && (k) < hi)
#define SEAM(k) do { if (IN(k) && IN((k) + 1)) { if (args.coop) grid.sync(); } } while (0)
    PG8_LAS unsigned char* ldsl = (PG8_LAS unsigned char*)lds_raw;

    if (IN(0)) { p0_prologue(F); __syncthreads(); }
    SEAM(0);
    if (IN(1)) {
        pg8::Gemm g{(const bf16*)(ws + WS_XN), (const bf16*)(ws + WS_WIN), T, INC, 1024}; pg8::StaticOrder S; S.init(T, INC, F.G, F.bid);
        pg8::EpiProj E{(bf16*)(ws + WS_Q), (const float*)(ws + WS_ROPE)};
        pg8::gemm_phase<pg8::EpiProj, pg8::StaticOrder, true, true>(ldsl, g, S, E);
    }
    SEAM(1);
    if (IN(2)) {
        const float lam = ((const float*)(ws + WS_MISC))[0];
        for (int it = F.bid; it < 128; it += F.G) {
            const int b = it & 7, nd = it >> 3, n = nd & 7, dir = nd >> 3;
            LruArgs A{(const bf16*)(ws + WS_LIN), F.a->in[10], F.a->in[11], (const bf16*)(ws + WS_LWT), F.a->in[13], F.a->in[15], F.a->in[16], (bf16*)(ws + (dir ? WS_HB : WS_HF))};
            lru_item(b, n, dir, A, F.lds);
        }
        for (int it = F.bid; it < 1024; it += F.G) {
            const int xx = it & 7, rest = it >> 3, qb = rest & 31, i4 = rest >> 5, bh = i4 * 8 + xx;
            att::attn_unit(bh >> 2, bh & 3, qb, (const bf16*)(ws + WS_Q), (const bf16*)(ws + WS_K), (const bf16*)(ws + WS_V), (bf16*)(ws + WS_MIXED), F.a->in[9], lam, F.lds);
        }
    }
    SEAM(2);
    if (IN(3)) {
        const int tid_ = fresh_tid(), lane_ = tid_ & 63, wave_ = __builtin_amdgcn_readfirstlane(tid_ >> 6);
        const int gw = F.bid * 8 + wave_, NGW = F.G * 8;
        for (int t = gw; t < T; t += NGW) {
            const u32x4 a = *(const u32x4*)(ws + WS_HF + ((size_t)t * 512 + lane_ * 8) * 2), b = *(const u32x4*)(ws + WS_HB + ((size_t)t * 512 + lane_ * 8) * 2), gt = *(const u32x4*)(ws + WS_LGATE + ((size_t)t * 512 + lane_ * 8) * 2);
            float y[8];
            y[0] = (bflo(a.x) + bflo(b.x)) * gelu_tanh(bflo(gt.x)); y[1] = (bfhi(a.x) + bfhi(b.x)) * gelu_tanh(bfhi(gt.x));
            y[2] = (bflo(a.y) + bflo(b.y)) * gelu_tanh(bflo(gt.y)); y[3] = (bfhi(a.y) + bfhi(b.y)) * gelu_tanh(bfhi(gt.y));
            y[4] = (bflo(a.z) + bflo(b.z)) * gelu_tanh(bflo(gt.z)); y[5] = (bfhi(a.z) + bfhi(b.z)) * gelu_tanh(bfhi(gt.z));
            y[6] = (bflo(a.w) + bflo(b.w)) * gelu_tanh(bflo(gt.w)); y[7] = (bfhi(a.w) + bfhi(b.w)) * gelu_tanh(bfhi(gt.w));
            float s = 0.f;
#pragma unroll
            for (int j = 0; j < 8; ++j) s += y[j] * y[j];
            const float rstd = 1.0f / sqrtf(wave_sum(s) * (1.0f / 512.0f) + EPS);
            const f32x4 g0 = *(const f32x4*)(F.a->in[17] + lane_ * 8), g1 = *(const f32x4*)(F.a->in[17] + lane_ * 8 + 4);
            u32x4 w = {pk2(y[0] * rstd * g0[0], y[1] * rstd * g0[1]), pk2(y[2] * rstd * g0[2], y[3] * rstd * g0[3]), pk2(y[4] * rstd * g1[0], y[5] * rstd * g1[1]), pk2(y[6] * rstd * g1[2], y[7] * rstd * g1[3])};
            *(u32x4*)(ws + WS_MIXED + ((size_t)t * 1024 + 512 + lane_ * 8) * 2) = w;
        }
    }
    SEAM(3);
    if (IN(4)) {
        pg8::Gemm g{(const bf16*)(ws + WS_MIXED), (const bf16*)(ws + WS_WOUT), T, 1024, 1024}; pg8::StaticOrder S; S.init(T, 1024, F.G, F.bid);
        pg8::EpiResid E{F.a->in[0], F.a->out, (bf16*)(ws + WS_XN), (float*)(ws + WS_SS1)};
        pg8::gemm_phase<pg8::EpiResid, pg8::StaticOrder, true, true>(ldsl, g, S, E);
    }
    SEAM(4);
    if (IN(5)) {
        pg8::Gemm g{(const bf16*)(ws + WS_XN), (const bf16*)(ws + WS_WQ), T, 1024, 1024}; pg8::StaticOrder S; S.init(T, 1024, F.G, F.bid);
        pg8::EpiScaleBf16 E{(bf16*)(ws + WS_QP), (const float*)(ws + WS_SS1)};
        pg8::gemm_phase<pg8::EpiScaleBf16, pg8::StaticOrder, true, true>(ldsl, g, S, E);
    }
    SEAM(5);
    if (IN(6)) {
        TopkArgs A{(const bf16*)(ws + WS_QP), (const bf16*)(ws + WS_KEYS), (unsigned short*)(ws + WS_IDX), (float*)(ws + WS_GW)};
        bf16x8 kf[4][4];
        { const int tid_ = fresh_tid(), lane_ = tid_ & 63, wave_ = __builtin_amdgcn_readfirstlane(tid_ >> 6); const int half = (wave_ >> 1) & 1, r32 = lane_ & 31, hi5 = lane_ >> 5;
#pragma unroll
          for (int ct = 0; ct < 4; ++ct)
#pragma unroll
            for (int ks = 0; ks < 4; ++ks) kf[ct][ks] = *(const bf16x8*)(A.KEYS + (size_t)half * 8192 + (ct * 32 + r32) * 64 + ks * 16 + hi5 * 8); }
        for (int tile = F.bid; tile < T / 64; tile += F.G) topk_unit(tile, A, kf, F.lds);
    }
    SEAM(6);
    PeerArgs PA{(const unsigned short*)(ws + WS_IDX), (const bf16*)(ws + WS_XN), (const bf16*)(ws + WS_UT), (const bf16*)(ws + WS_VT), (float*)(ws + WS_PLOG), (const float*)(ws + WS_ACT), F.a->out, (bf16*)(ws + WS_XN), (float*)(ws + WS_SS2)};
    if (IN(7)) {
        for (int it = F.bid; it < 8 * (T / 128); it += F.G) peer_u_item(it >> 3, it & 7, PA, F.lds);
    }
    SEAM(7);
    if (IN(8)) {
        const int tid_ = fresh_tid();
        const long gt = (long)F.bid * 512 + tid_, NGT = (long)F.G * 512;
        const float* plog = (const float*)(ws + WS_PLOG); const float* gwp = (const float*)(ws + WS_GW); float* act = (float*)(ws + WS_ACT);
        for (long i = gt; i < (long)T * 128; i += NGT) {
            const int t = (int)(i >> 7);
            float s = 0.f;
#pragma unroll
            for (int q = 0; q < 8; ++q) s += plog[(size_t)q * T * 128 + i];
            const float rs = pg8::rowscale16((const float*)(ws + WS_SS1), t);
            act[i] = gelu_tanh(s * rs) * gwp[i];
        }
    }
    SEAM(8);
    if (IN(9)) {
        for (int it = F.bid; it < 8 * (T / 128); it += F.G) peer_v_item(it >> 3, it & 7, PA, F.lds);
    }
    SEAM(9);
    if (IN(10)) {
        pg8::Gemm g{(const bf16*)(ws + WS_PB), (const bf16*)(ws + WS_WP), T, 1024, 256}; pg8::StaticOrder S; S.init(T, 1024, F.G, F.bid);
        pg8::EpiScaleBf16 E{(bf16*)(ws + WS_QP), nullptr};
        pg8::gemm_phase<pg8::EpiScaleBf16, pg8::StaticOrder, true, true>(ldsl, g, S, E);
    }
    SEAM(10);
    if (IN(11)) {
        pg8::Gemm g{(const bf16*)(ws + WS_XN), (const bf16*)(ws + WS_WG), T, 1024, 1024}; pg8::StaticOrder S; S.init(T, 1024, F.G, F.bid);
        pg8::EpiPle E{F.a->out, (const bf16*)(ws + WS_QP), (const float*)(ws + WS_SS2), (float*)(ws + WS_SS3)};
        pg8::gemm_phase<pg8::EpiPle, pg8::StaticOrder, true, true>(ldsl, g, S, E);
    }
    SEAM(11);
    if (IN(12)) {
        const int tid_ = fresh_tid(), lane_ = tid_ & 63, wave_ = __builtin_amdgcn_readfirstlane(tid_ >> 6);
        const int gw = F.bid * 8 + wave_, NGW = F.G * 8;
        for (int m = gw; m < T; m += NGW) {
            const float rs = pg8::rowscale16((const float*)(ws + WS_SS3), m);
            f32x4* hr = (f32x4*)(F.a->out + (size_t)m * 1024) + lane_; const f32x4* gr = (const f32x4*)F.a->in[28] + lane_;
#pragma unroll
            for (int j = 0; j < 4; ++j) { const f32x4 v = hr[64 * j], g = gr[64 * j]; hr[64 * j] = v * rs * g; }
        }
    }
#undef IN
#undef SEAM
}

#ifndef MK_MULTI
#define MK_MULTI 1
#endif
constexpr int NPH = 13;
extern "C" void kernel_launch(void* const* d_in, const int* in_sizes, int n_in, void* d_out, int out_size, void* d_ws, size_t ws_size, hipStream_t stream) {
    static int grid = 0;
    if (grid == 0) {
        if (n_in != 29 || out_size != T * DM || ws_size < WS_END) { fprintf(stderr, "kernel_launch: unexpected shapes: n_in %d out %d ws %zu (need %zu)\n", n_in, out_size, ws_size, (size_t)WS_END); grid = -1; return; }
        int dev = 0, cus = 0, per_cu = 0;
        if (hipGetDevice(&dev) != hipSuccess || hipDeviceGetAttribute(&cus, hipDeviceAttributeMultiprocessorCount, dev) != hipSuccess) { grid = -1; return; }
        if (hipFuncSetAttribute((const void*)enc_fwd, hipFuncAttributeMaxDynamicSharedMemorySize, LDS_BYTES) != hipSuccess) { fprintf(stderr, "kernel_launch: hipFuncSetAttribute failed\n"); grid = -1; return; }
        if (hipOccupancyMaxActiveBlocksPerMultiprocessor(&per_cu, (const void*)enc_fwd, 512, LDS_BYTES) != hipSuccess || per_cu < 1) { fprintf(stderr, "kernel_launch: occupancy query says %d\n", per_cu); per_cu = 1; }
        (void)hipGetLastError();
        grid = cus * 1;
    }
    if (grid < 0) return;
    (void)hipMemsetAsync((char*)d_ws + WS_CTL, 0, CTL_ZERO_BYTES, stream);
    Args a{};
    for (int i = 0; i < 29; ++i) a.in[i] = (const float*)d_in[i];
    a.out = (float*)d_out; a.ws = (unsigned char*)d_ws;
#if MK_MULTI
    for (int ph = 0; ph < NPH; ++ph) { a.ph_lo = ph; a.ph_hi = ph + 1; a.coop = 0; hipLaunchKernelGGL(enc_fwd, dim3(grid), dim3(512), LDS_BYTES, stream, a); }
#else
    a.ph_lo = 0; a.ph_hi = NPH; a.coop = 1;
    void* kargs[] = {&a};
    hipError_t e = hipLaunchCooperativeKernel((const void*)enc_fwd, dim3(grid), dim3(512), kargs, LDS_BYTES, stream);
    if (e != hipSuccess) fprintf(stderr, "cooperative launch failed: %s (grid %d)\n", hipGetErrorString(e), grid);
#endif
}
```

```cpp
#include <hip/hip_runtime.h>
#include <hip/hip_cooperative_groups.h>
#include <cstdio>
#include <cstdint>
namespace cg = cooperative_groups;

constexpr int NB = 8, SEQ = 4096, T = NB * SEQ, DM = 1024, INC = 2560, PLE = 256;
constexpr float EPS = 1e-6f;
constexpr float LAMBDA_INIT = 0.2f;

__device__ __forceinline__ int fresh_tid() { int t = threadIdx.x; asm volatile("" : "+v"(t)); return t; }

namespace pg8 {
#define PG8_LAS __attribute__((address_space(3)))
typedef unsigned short bf16_t;
typedef short bf16x8 __attribute__((ext_vector_type(8)));
typedef float f32x4 __attribute__((ext_vector_type(4)));
typedef unsigned u32x4 __attribute__((ext_vector_type(4)));
constexpr int BM = 256, BK = 64, HALF = 128, HTB = HALF * BK * 2  , STAGE_BYTES = 8 * HTB, NXCD = 8, WGM = 8;

__host__ __device__ __forceinline__ int lds_byte(int r, int c) { const int st = (r >> 4) * 2 + (c >> 5), rr = r & 15, cc = c & 31, ob = rr * 64 + cc * 2; return st * 1024 + (ob ^ (((ob >> 9) & 1) << 5)); }
__host__ __device__ __forceinline__ void stage_rc(int b, int& R, int& C) { const int st = b / 1024, sb = b % 1024, swz = sb ^ (((sb >> 9) & 1) << 5); R = (st >> 1) * 16 + swz / 64; C = (st & 1) * 32 + (swz % 64) / 2; }
__host__ __device__ __forceinline__ int perm32(int rho) { const int n = rho >> 4, i = rho & 15; return 8 * (i >> 2) + 4 * n + (i & 3); }

struct Unit { int pm, pn; };
struct Gemm { const bf16_t* A; const bf16_t* Bt; int M, N, K; };

struct StaticOrder {
    int nM, nN, nwg, G, c;
    __host__ __device__ void init(int M, int N, int G_, int c_) { nM = M / BM; nN = N / BM; nwg = nM * nN; G = G_; c = c_; }
    __host__ __device__ bool next(int i, Unit& u) const {
        const long L = (long)i * G + c; if (L >= nwg) return false;
        int wgid = (int)L; { const int q = nwg / NXCD, r = nwg % NXCD, xcd = wgid % NXCD, off = wgid / NXCD; wgid = (xcd < r ? xcd * (q + 1) : r * (q + 1) + (xcd - r) * q) + off; }
        const int nig = WGM * nN, gid = wgid / nig, fm = gid * WGM, gsz = (nM - fm) < WGM ? (nM - fm) : WGM;
        u.pm = fm + ((wgid % nig) % gsz); u.pn = (wgid % nig) / gsz; return true;
    }
    __device__ __forceinline__ void a_ready(const Unit&) const {}
    __device__ __forceinline__ void done(const Unit&) const {}
};

__device__ __forceinline__ unsigned cvt_pk_bf16(float lo, float hi) { unsigned r; asm volatile("v_cvt_pk_bf16_f32 %0, %1, %2" : "=v"(r) : "v"(lo), "v"(hi)); return r; }
typedef float f32x2 __attribute__((ext_vector_type(2)));
typedef unsigned u32x2 __attribute__((ext_vector_type(2)));
__device__ __forceinline__ float fsigmoid(float z) { return __builtin_amdgcn_rcpf(1.0f + __expf(-z)); }
__device__ __forceinline__ float rowscale_n(const float* ss, int n) { float s = 0.f; for (int i = 0; i < n; ++i) s += ss[i]; return 1.0f / sqrtf(s * (1.0f / 1024.0f) + 1e-6f); }
__device__ __forceinline__ float rowscale16(const float* ss, int row) { const f32x4* p = (const f32x4*)(ss + (size_t)row * 16); const f32x4 a = p[0], b = p[1], c = p[2], d = p[3];
    const float s = ((a[0] + a[1]) + (a[2] + a[3])) + ((b[0] + b[1]) + (b[2] + b[3])) + ((c[0] + c[1]) + (c[2] + c[3])) + ((d[0] + d[1]) + (d[2] + d[3])); return 1.0f / sqrtf(s * (1.0f / 1024.0f) + 1e-6f); }
__device__ __forceinline__ float rowscale8(const float* ss, int row) { const f32x4* p = (const f32x4*)(ss + (size_t)row * 8); const f32x4 a = p[0], b = p[1];
    const float s = ((a[0] + a[1]) + (a[2] + a[3])) + ((b[0] + b[1]) + (b[2] + b[3])); return 1.0f / sqrtf(s * (1.0f / 1024.0f) + 1e-6f); }
__device__ __forceinline__ u32x4 pack8(f32x4 v0, f32x4 v1) { u32x4 w; w.x = cvt_pk_bf16(v0[0], v0[1]); w.y = cvt_pk_bf16(v0[2], v0[3]); w.z = cvt_pk_bf16(v1[0], v1[1]); w.w = cvt_pk_bf16(v1[2], v1[3]); return w; }
__device__ __forceinline__ float bf_lo(unsigned w) { return __uint_as_float(w << 16); }
__device__ __forceinline__ float bf_hi(unsigned w) { return __uint_as_float(w & 0xffff0000u); }

struct EpiProj {
    static constexpr bool PERM = true, AFTER_DRAIN = false;
    bf16_t* base; const float* rope;
    __device__ __forceinline__ void operator()(const f32x4 (&acc)[2][2][4][2], const Unit& u, int wr, int wc, int fr, int fq) const {
        const int region = u.pn >> 1;
        bf16_t* O = base + (size_t)region * ((size_t)32768 * 512);
        const int colb = (u.pn & 1) * 256 + wc * 32 + 8 * fq;
        const bool rot = (region < 2) && ((wc & 1) == 0);
        const float qs = (region == 0) ? 0.125f : 1.0f;
        const float sgn = (fq == 0) ? -1.0f : 1.0f;
#pragma unroll
        for (int ai = 0; ai < 2; ++ai)
#pragma unroll
            for (int m = 0; m < 4; ++m) {
                const int row = u.pm * BM + ai * HALF + wr * 64 + m * 16 + fr;
                f32x4 c0 = {1.f, 1.f, 1.f, 1.f}, c1 = c0, s0 = {0.f, 0.f, 0.f, 0.f}, s1 = s0;
                if (rot) { const f32x4* rp = (const f32x4*)(rope + (size_t)row * 16); c0 = rp[0]; c1 = rp[1]; s0 = rp[2]; s1 = rp[3]; }
#pragma unroll
                for (int bj = 0; bj < 2; ++bj) {
                    f32x4 v0 = acc[ai][bj][m][0], v1 = acc[ai][bj][m][1];
                    if (rot) {
                        f32x4 o0, o1;
#pragma unroll
                        for (int j = 0; j < 4; ++j) { o0[j] = __shfl_xor(v0[j], 16); o1[j] = __shfl_xor(v1[j], 16); }
                        if (fq < 2) { v0 = v0 * c0 + (o0 * s0) * sgn; v1 = v1 * c1 + (o1 * s1) * sgn; }
                    }
                    v0 = v0 * qs; v1 = v1 * qs;
                    *(u32x4*)(O + (size_t)row * 512 + colb + bj * HALF) = pack8(v0, v1);
                }
            }
    }
};
struct EpiResid {
    static constexpr bool PERM = true, AFTER_DRAIN = false;
    const float* X; float* H; bf16_t* HB; float* SS;
    __device__ __forceinline__ void operator()(const f32x4 (&acc)[2][2][4][2], const Unit& u, int wr, int wc, int fr, int fq) const {
        const int col0 = u.pn * BM + wc * 32 + 8 * fq;
#pragma unroll
        for (int ai = 0; ai < 2; ++ai)
#pragma unroll
            for (int m = 0; m < 4; ++m) {
                const int row = u.pm * BM + ai * HALF + wr * 64 + m * 16 + fr; float ssq = 0.f;
#pragma unroll
                for (int bj = 0; bj < 2; ++bj) {
                    const size_t off = (size_t)row * 1024 + col0 + bj * HALF;
                    const f32x4 h0 = *(const f32x4*)(X + off) + acc[ai][bj][m][0], h1 = *(const f32x4*)(X + off + 4) + acc[ai][bj][m][1];
                    *(f32x4*)(H + off) = h0; *(f32x4*)(H + off + 4) = h1; *(u32x4*)(HB + off) = pack8(h0, h1);
                    ssq += (h0[0] * h0[0] + h0[1] * h0[1]) + (h0[2] * h0[2] + h0[3] * h0[3]) + (h1[0] * h1[0] + h1[1] * h1[1]) + (h1[2] * h1[2] + h1[3] * h1[3]);
                }
                ssq += __shfl_xor(ssq, 16); ssq += __shfl_xor(ssq, 32);
                if (fq == 0) SS[(size_t)row * 16 + u.pn * 4 + wc] = ssq;
            }
    }
};
struct EpiScaleBf16 {
    static constexpr bool PERM = true, AFTER_DRAIN = false;
    bf16_t* O; const float* SS;
    __device__ __forceinline__ void operator()(const f32x4 (&acc)[2][2][4][2], const Unit& u, int wr, int wc, int fr, int fq) const {
        const int col0 = u.pn * BM + wc * 32 + 8 * fq;
#pragma unroll
        for (int ai = 0; ai < 2; ++ai)
#pragma unroll
            for (int m = 0; m < 4; ++m) {
                const int row = u.pm * BM + ai * HALF + wr * 64 + m * 16 + fr;
                const float rs = SS ? rowscale16(SS, row) : 1.0f;
#pragma unroll
                for (int bj = 0; bj < 2; ++bj) *(u32x4*)(O + (size_t)row * 1024 + col0 + bj * HALF) = pack8(acc[ai][bj][m][0] * rs, acc[ai][bj][m][1] * rs);
            }
    }
};
struct EpiPle {
    static constexpr bool PERM = true, AFTER_DRAIN = false;
    float* H; const bf16_t* PP; const float* SS2; float* SS3;
    __device__ __forceinline__ void operator()(const f32x4 (&acc)[2][2][4][2], const Unit& u, int wr, int wc, int fr, int fq) const {
        const int col0 = u.pn * BM + wc * 32 + 8 * fq;
#pragma unroll
        for (int ai = 0; ai < 2; ++ai)
#pragma unroll
            for (int m = 0; m < 4; ++m) {
                const int row = u.pm * BM + ai * HALF + wr * 64 + m * 16 + fr; float ssq = 0.f;
                const float rs = rowscale8(SS2, row);
#pragma unroll
                for (int bj = 0; bj < 2; ++bj) {
                    const size_t off = (size_t)row * 1024 + col0 + bj * HALF;
                    const u32x4 pw = *(const u32x4*)(PP + off);
                    const f32x4 p0 = {bf_lo(pw.x), bf_hi(pw.x), bf_lo(pw.y), bf_hi(pw.y)}, p1 = {bf_lo(pw.z), bf_hi(pw.z), bf_lo(pw.w), bf_hi(pw.w)};
                    f32x4 g0, g1;
#pragma unroll
                    for (int j = 0; j < 4; ++j) { g0[j] = fsigmoid(acc[ai][bj][m][0][j] * rs); g1[j] = fsigmoid(acc[ai][bj][m][1][j] * rs); }
                    const f32x4 h0 = *(const f32x4*)(H + off) + g0 * p0, h1 = *(const f32x4*)(H + off + 4) + g1 * p1;
                    *(f32x4*)(H + off) = h0; *(f32x4*)(H + off + 4) = h1;
                    ssq += (h0[0] * h0[0] + h0[1] * h0[1]) + (h0[2] * h0[2] + h0[3] * h0[3]) + (h1[0] * h1[0] + h1[1] * h1[1]) + (h1[2] * h1[2] + h1[3] * h1[3]);
                }
                ssq += __shfl_xor(ssq, 16); ssq += __shfl_xor(ssq, 32);
                if (fq == 0) SS3[(size_t)row * 16 + u.pn * 4 + wc] = ssq;
            }
    }
};

template <class Epi, class Sched, bool ALIGN_EPI = false, bool SP2 = false>
__device__ __forceinline__ void gemm_phase(PG8_LAS unsigned char* lds, const Gemm g, const Sched& S, const Epi& E) {
    const int tid = fresh_tid(), wid = __builtin_amdgcn_readfirstlane(tid >> 6), lane = tid & 63, wr = wid >> 2, wc = wid & 3, fr = lane & 15, fq = lane >> 4;
    const int K = g.K, nt = K / BK;
    unsigned voffA[2], voffB[2];
#pragma unroll
    for (int i = 0; i < 2; ++i) { int R, C; stage_rc(tid * 16 + i * 8192, R, C); const int Rb = Epi::PERM ? ((R & ~31) + perm32(R & 31)) : R;
        voffA[i] = (unsigned)(R * K + C) * 2u; voffB[i] = (unsigned)(Rb * K + C) * 2u; }
    const size_t kstep = (size_t)(BK * 2);
    const size_t hstep = (size_t)HALF * K * 2;
    const size_t tstep = 2 * hstep;
    const unsigned ldsw = (unsigned)wid * 1024u;
    const int aoff = lds_byte(wr * 64 + fr, fq * 8), boff = lds_byte(wc * 32 + fr, fq * 8);
#define PG8_SA(b, h) (((b) * 2 + (h)) * HTB)
#define PG8_SB(b, h) ((4 + (b) * 2 + (h)) * HTB)
#define PG8_STAGE(bufoff, gbase, voff) do { _Pragma("unroll") for (int _i = 0; _i < 2; ++_i) \
        __builtin_amdgcn_global_load_lds((const unsigned*)((const char*)(gbase) + (voff)[_i]), (PG8_LAS unsigned*)(lds + (bufoff) + ldsw + _i * 8192), 16, 0, 0); } while (0)
#define PG8_LDA(dst, b, h) do { _Pragma("unroll") for (int m = 0; m < 4; ++m) _Pragma("unroll") for (int k = 0; k < 2; ++k) dst[m][k] = *(const PG8_LAS bf16x8*)(lds + PG8_SA(b, h) + aoff + m * 2048 + k * 1024); } while (0)
#define PG8_LDB(dst, b, h) do { _Pragma("unroll") for (int n = 0; n < 2; ++n) _Pragma("unroll") for (int k = 0; k < 2; ++k) dst[n][k] = *(const PG8_LAS bf16x8*)(lds + PG8_SB(b, h) + boff + n * 2048 + k * 1024); } while (0)
#define PG8_MMA(ai, bj, At, Bt) do { __builtin_amdgcn_s_setprio(1); _Pragma("unroll") for (int m = 0; m < 4; ++m) _Pragma("unroll") for (int n = 0; n < 2; ++n) _Pragma("unroll") for (int k = 0; k < 2; ++k) \
        acc[ai][bj][m][n] = __builtin_amdgcn_mfma_f32_16x16x32_bf16(Bt[n][k], At[m][k], acc[ai][bj][m][n], 0, 0, 0); __builtin_amdgcn_s_setprio(0); } while (0)
#define PG8_WAIT_V(n) asm volatile("s_waitcnt vmcnt(" #n ")" ::: "memory")
#define PG8_WAIT_L(n) asm volatile("s_waitcnt lgkmcnt(" #n ")" ::: "memory")
#define PG8_BAR __builtin_amdgcn_s_barrier()
#define PG8_SCHED __builtin_amdgcn_sched_barrier(0)
    Unit cur, nxt; int ui = 0;
    if (!S.next(0, cur)) return;
    f32x4 acc[2][2][4][2];
#pragma unroll
    for (int a = 0; a < 2; ++a)
#pragma unroll
        for (int b = 0; b < 2; ++b)
#pragma unroll
            for (int m = 0; m < 4; ++m)
#pragma unroll
                for (int n = 0; n < 2; ++n) acc[a][b][m][n] = (f32x4){0.f, 0.f, 0.f, 0.f};
    bf16x8 At[4][2], B0[2][2], B1[2][2];
    const char* cA = (const char*)g.A + (size_t)cur.pm * tstep; const char* cB = (const char*)g.Bt + (size_t)cur.pn * tstep;
    S.a_ready(cur);
    if constexpr (SP2) {
        PG8_STAGE(PG8_SB(0, 0), cB, voffB); PG8_STAGE(PG8_SB(0, 1), cB + hstep, voffB); PG8_STAGE(PG8_SA(0, 0), cA, voffA); PG8_STAGE(PG8_SA(0, 1), cA + hstep, voffA);
        if (wr == 1) PG8_BAR;
        PG8_WAIT_V(2); PG8_BAR;
        PG8_STAGE(PG8_SB(1, 0), cB + kstep, voffB); PG8_STAGE(PG8_SA(1, 0), cA + kstep, voffA); PG8_STAGE(PG8_SB(1, 1), cB + hstep + kstep, voffB);
        PG8_WAIT_V(6); PG8_BAR;
    } else {
        PG8_STAGE(PG8_SB(0, 0), cB, voffB); PG8_STAGE(PG8_SA(0, 0), cA, voffA); PG8_STAGE(PG8_SB(0, 1), cB + hstep, voffB); PG8_STAGE(PG8_SA(0, 1), cA + hstep, voffA);
        if (wr == 1) PG8_BAR;
        PG8_WAIT_V(4); PG8_BAR;
        PG8_STAGE(PG8_SB(1, 0), cB + kstep, voffB); PG8_STAGE(PG8_SA(1, 0), cA + kstep, voffA); PG8_STAGE(PG8_SB(1, 1), cB + hstep + kstep, voffB);
        PG8_WAIT_V(6); PG8_BAR;
    }
    for (;;) {
        const bool has_next = S.next(ui + 1, nxt);
        const char* nA = has_next ? (const char*)g.A + (size_t)nxt.pm * tstep : cA; const char* nB = has_next ? (const char*)g.Bt + (size_t)nxt.pn * tstep : cB;
        for (int t = 0; t < nt; t += 2) {
            const bool last = (t == nt - 2);
            const char* a1 = cA + (size_t)(t + 1) * kstep;
            const char* a2 = last ? nA : cA + (size_t)(t + 2) * kstep; const char* b2 = last ? nB : cB + (size_t)(t + 2) * kstep;
            const char* a3 = a2 + kstep; const char* b3 = b2 + kstep;
            if (last && has_next) S.a_ready(nxt);
            if constexpr (SP2) {
            PG8_LDB(B0, 0, 0); PG8_LDB(B1, 0, 1); PG8_SCHED; PG8_LDA(At, 0, 0); PG8_STAGE(PG8_SA(1, 1), a1 + hstep, voffA);
            PG8_WAIT_V(8); PG8_WAIT_L(0); PG8_BAR; PG8_MMA(0, 0, At, B0); PG8_MMA(0, 1, At, B1); PG8_BAR; PG8_SCHED;
            PG8_LDA(At, 0, 1); PG8_STAGE(PG8_SB(0, 0), b2, voffB); PG8_STAGE(PG8_SB(0, 1), b2 + hstep, voffB); PG8_STAGE(PG8_SA(0, 0), a2, voffA);
            PG8_WAIT_V(8); PG8_WAIT_L(0); PG8_BAR; PG8_MMA(1, 0, At, B0); PG8_MMA(1, 1, At, B1); PG8_BAR; PG8_SCHED;
            PG8_LDB(B0, 1, 0); PG8_LDB(B1, 1, 1); PG8_SCHED; PG8_LDA(At, 1, 0); PG8_STAGE(PG8_SA(0, 1), a2 + hstep, voffA);
            PG8_WAIT_V(8); PG8_WAIT_L(0); PG8_BAR; PG8_MMA(0, 0, At, B0); PG8_MMA(0, 1, At, B1); PG8_BAR; PG8_SCHED;
            PG8_LDA(At, 1, 1); PG8_STAGE(PG8_SB(1, 0), b3, voffB); PG8_STAGE(PG8_SB(1, 1), b3 + hstep, voffB); PG8_STAGE(PG8_SA(1, 0), a3, voffA);
            PG8_WAIT_V(8); PG8_WAIT_L(0); PG8_BAR; PG8_MMA(1, 0, At, B0); PG8_MMA(1, 1, At, B1); PG8_BAR; PG8_SCHED;
            } else {
            PG8_LDB(B0, 0, 0); PG8_SCHED; PG8_LDA(At, 0, 0); PG8_STAGE(PG8_SA(1, 1), a1 + hstep, voffA);
            PG8_WAIT_L(8); PG8_BAR; PG8_WAIT_L(0); PG8_MMA(0, 0, At, B0); PG8_BAR; PG8_SCHED;
            PG8_LDB(B1, 0, 1); PG8_STAGE(PG8_SB(0, 0), b2, voffB);
            PG8_BAR; PG8_WAIT_L(0); PG8_MMA(0, 1, At, B1); PG8_BAR;
            PG8_LDA(At, 0, 1); PG8_STAGE(PG8_SA(0, 0), a2, voffA);
            PG8_BAR; PG8_WAIT_L(0); PG8_MMA(1, 0, At, B0); PG8_BAR; PG8_SCHED;
            PG8_STAGE(PG8_SB(0, 1), b2 + hstep, voffB);
            PG8_WAIT_V(6); PG8_BAR; PG8_MMA(1, 1, At, B1); PG8_BAR;
            PG8_LDB(B0, 1, 0); PG8_SCHED; PG8_LDA(At, 1, 0); PG8_STAGE(PG8_SA(0, 1), a2 + hstep, voffA);
            PG8_WAIT_L(8); PG8_BAR; PG8_WAIT_L(0); PG8_MMA(0, 0, At, B0); PG8_BAR; PG8_SCHED;
            PG8_LDB(B1, 1, 1); PG8_STAGE(PG8_SB(1, 0), b3, voffB);
            PG8_BAR; PG8_WAIT_L(0); PG8_MMA(0, 1, At, B1); PG8_BAR;
            PG8_LDA(At, 1, 1); PG8_STAGE(PG8_SA(1, 0), a3, voffA);
            PG8_BAR; PG8_WAIT_L(0); PG8_MMA(1, 0, At, B0); PG8_BAR; PG8_SCHED;
            PG8_STAGE(PG8_SB(1, 1), b3 + hstep, voffB);
            PG8_WAIT_V(6); PG8_BAR; PG8_MMA(1, 1, At, B1); PG8_BAR;
            }
        }
        if constexpr (ALIGN_EPI) { if (wr == 0) PG8_BAR; }
        if constexpr (!Epi::AFTER_DRAIN) { E(acc, cur, wr, wc, fr, fq); S.done(cur); }
        if (!has_next) break;
#pragma unroll
        for (int a = 0; a < 2; ++a)
#pragma unroll
            for (int b = 0; b < 2; ++b)
#pragma unroll
                for (int m = 0; m < 4; ++m)
#pragma unroll
                    for (int n = 0; n < 2; ++n) acc[a][b][m][n] = (f32x4){0.f, 0.f, 0.f, 0.f};
        cur = nxt; cA = nA; cB = nB; ++ui;
        if constexpr (ALIGN_EPI) { if (wr == 1) PG8_BAR; }
    }
    PG8_WAIT_V(0);
    if constexpr (!ALIGN_EPI) { if (wr == 0) PG8_BAR; }
    PG8_BAR;
    if constexpr (Epi::AFTER_DRAIN) { E.fused(acc, cur, wr, wc, fr, fq, lds, wid, lane); S.done(cur); }
#undef PG8_SA
#undef PG8_SB
#undef PG8_STAGE
#undef PG8_LDA
#undef PG8_LDB
#undef PG8_MMA
#undef PG8_WAIT_V
#undef PG8_WAIT_L
#undef PG8_BAR
#undef PG8_SCHED
}
}
namespace att {
using bf16x8 = __attribute__((ext_vector_type(8))) short;
using s16x4  = __attribute__((ext_vector_type(4))) short;
using f32x16 = __attribute__((ext_vector_type(16))) float;
using f32x4  = __attribute__((ext_vector_type(4))) float;
using u32x4  = __attribute__((ext_vector_type(4))) unsigned;
constexpr int NW = 8, QBLK = 32, KVBLK = 64, LDK = 512;
constexpr float THR = 8.f;
constexpr size_t SHM_V = KVBLK * 128 * 2, SHM_K = KVBLK * 128 * 2;
constexpr int OST_OFF = 69632, OST_LD = 132;
#define KSWZ(row, colB) ((row) * 256 + ((colB) ^ (((row) & 7) << 4)))
#define SBAR() __builtin_amdgcn_sched_barrier(0)
__device__ __forceinline__ int crow(int r, int hi) { return (r & 3) + 8 * (r >> 2) + 4 * hi; }
__device__ __forceinline__ unsigned cvtpk(float lo, float hi) { unsigned r; asm volatile("v_cvt_pk_bf16_f32 %0, %1, %2" : "=v"(r) : "v"(lo), "v"(hi)); return r; }

__device__ __forceinline__ void partialSM(f32x16& p0, f32x16& p1, float& m_reg, float& mn, float& alpha) {
  constexpr float C = 1.4426950408889634f;
  float pmax = p0[0];
#pragma unroll
  for (int r = 1; r < 16; ++r) pmax = fmaxf(pmax, p0[r]);
#pragma unroll
  for (int r = 0; r < 16; ++r) pmax = fmaxf(pmax, p1[r]);
  { auto rr = __builtin_amdgcn_permlane32_swap(__float_as_uint(pmax), __float_as_uint(pmax), false, false);
    pmax = fmaxf(__uint_as_float(rr[0]), __uint_as_float(rr[1])); }
  if (__builtin_expect(__all(pmax - m_reg <= THR), 1)) { mn = m_reg; alpha = 1.f; }
  else { mn = fmaxf(m_reg, pmax); alpha = __builtin_amdgcn_exp2f((m_reg - mn) * C); m_reg = mn; }
  float mnC = -mn * C;
#pragma unroll
  for (int r = 0; r < 16; ++r) p0[r] = fmaf(p0[r], C, mnC);
#pragma unroll
  for (int r = 0; r < 16; ++r) p1[r] = fmaf(p1[r], C, mnC);
#pragma unroll
  for (int r = 0; r < 16; ++r) p0[r] = __builtin_amdgcn_exp2f(p0[r]);
}
__device__ __forceinline__ void finishSM(f32x16& p0, f32x16& p1, float alpha, float& l_reg, bf16x8& pa0, bf16x8& pa1, bf16x8& pa2, bf16x8& pa3) {
#pragma unroll
  for (int r = 0; r < 16; ++r) p1[r] = __builtin_amdgcn_exp2f(p1[r]);
  float ps = 0;
#pragma unroll
  for (int r = 0; r < 16; ++r) ps += p0[r];
#pragma unroll
  for (int r = 0; r < 16; ++r) ps += p1[r];
  { auto rr = __builtin_amdgcn_permlane32_swap(__float_as_uint(ps), __float_as_uint(ps), false, false);
    ps = __uint_as_float(rr[0]) + __uint_as_float(rr[1]); }
  l_reg = l_reg * alpha + ps;
#define PK4(P, BASE, OUT) do { unsigned a0 = cvtpk(P[BASE + 0], P[BASE + 1]), a1 = cvtpk(P[BASE + 2], P[BASE + 3]);   \
    unsigned b0 = cvtpk(P[BASE + 4], P[BASE + 5]), b1 = cvtpk(P[BASE + 6], P[BASE + 7]);                              \
    auto r0 = __builtin_amdgcn_permlane32_swap(a0, b0, false, false); auto r1 = __builtin_amdgcn_permlane32_swap(a1, b1, false, false); \
    u32x4 w = {r0[0], r1[0], r0[1], r1[1]}; OUT = *reinterpret_cast<bf16x8*>(&w); } while (0)
  PK4(p0, 0, pa0); PK4(p0, 8, pa1); PK4(p1, 0, pa2); PK4(p1, 8, pa3);
#undef PK4
}
__device__ __forceinline__ void qkt(f32x16& p0, f32x16& p1, const char* Ks, const bf16x8* qr, int r32, int hi, int mcolB) {
  p0 = f32x16{}; p1 = f32x16{};
#pragma unroll
  for (int d0 = 0; d0 < 4; ++d0) { int cb = mcolB + (d0 * 16 + hi * 8) * 2;
    bf16x8 b0 = *reinterpret_cast<const bf16x8*>(Ks + KSWZ(r32, cb));
    bf16x8 b1 = *reinterpret_cast<const bf16x8*>(Ks + KSWZ(32 + r32, cb));
    p0 = __builtin_amdgcn_mfma_f32_32x32x16_bf16(b0, qr[d0], p0, 0, 0, 0);
    p1 = __builtin_amdgcn_mfma_f32_32x32x16_bf16(b1, qr[d0], p1, 0, 0, 0); }
}
__device__ __forceinline__ int v_st(int k, int c) { const int kk = (k & ~0xC) | ((k & 4) << 1) | ((k & 8) >> 1); return ((kk >> 3) * 4 + (c >> 5)) * 512 + ((kk & 7) * 32 + (c & 31)) * 2; }
__device__ __forceinline__ int v_rd_base(int lane) { return ((lane & 3) << 3) | (((lane >> 2) & 3) << 6) | (((lane >> 4) & 1) << 5) | (((lane >> 5) & 1) << 8); }
constexpr int v_rd_off(int d0, int ks, int half) { return d0 * 512 + ks * 4096 + half * 2048; }
template <int OFF> __device__ __forceinline__ s16x4 tr_read(int vb) {
  s16x4 r; asm volatile("ds_read_b64_tr_b16 %0, %1 offset:%2" : "=&v"(r) : "v"(vb), "i"(OFF) : "memory"); return r;
}
template <int D0> __device__ __forceinline__ void pv_one(f32x16& od, int vb, bf16x8 pa0, bf16x8 pa1, bf16x8 pa2, bf16x8 pa3) {
  const s16x4 l0 = tr_read<v_rd_off(D0, 0, 0)>(vb), h0 = tr_read<v_rd_off(D0, 0, 1)>(vb), l1 = tr_read<v_rd_off(D0, 1, 0)>(vb), h1 = tr_read<v_rd_off(D0, 1, 1)>(vb);
  const s16x4 l2 = tr_read<v_rd_off(D0, 2, 0)>(vb), h2 = tr_read<v_rd_off(D0, 2, 1)>(vb), l3 = tr_read<v_rd_off(D0, 3, 0)>(vb), h3 = tr_read<v_rd_off(D0, 3, 1)>(vb);
  asm volatile("s_waitcnt lgkmcnt(0)" ::: "memory"); SBAR();
#define PK(L, H) (bf16x8){L[0], L[1], L[2], L[3], H[0], H[1], H[2], H[3]}
  od = __builtin_amdgcn_mfma_f32_32x32x16_bf16(pa0, PK(l0, h0), od, 0, 0, 0);
  od = __builtin_amdgcn_mfma_f32_32x32x16_bf16(pa1, PK(l1, h1), od, 0, 0, 0);
  od = __builtin_amdgcn_mfma_f32_32x32x16_bf16(pa2, PK(l2, h2), od, 0, 0, 0);
  od = __builtin_amdgcn_mfma_f32_32x32x16_bf16(pa3, PK(l3, h3), od, 0, 0, 0);
#undef PK
}
__device__ __forceinline__ void pv_d0(f32x16* o, int vb, bf16x8 pa0, bf16x8 pa1, bf16x8 pa2, bf16x8 pa3) {
  pv_one<0>(o[0], vb, pa0, pa1, pa2, pa3); pv_one<1>(o[1], vb, pa0, pa1, pa2, pa3); pv_one<2>(o[2], vb, pa0, pa1, pa2, pa3); pv_one<3>(o[3], vb, pa0, pa1, pa2, pa3);
}

__device__ __forceinline__ void attn_unit(int b, int h, int qb, const unsigned short* __restrict__ Qb, const unsigned short* __restrict__ Kb, const unsigned short* __restrict__ Vb,
                                          unsigned short* __restrict__ MX, const float* __restrict__ gdn, float lam, char* lds) {
  constexpr int SDEPTH = 1;
  const int tid = fresh_tid(), wid = tid >> 6, lane = tid & 63, r32 = lane & 31, hi = lane >> 5;
  const int mp = wid >> 2, qg = wid & 3;
  char* V_lds = lds; char* K_lds = lds + 2 * SHM_V;
  float* ws = (float*)(lds + 2 * SHM_V + 2 * SHM_K) + wid * 64; float* li_l = ws; float* al_l = ws + 32;
  float m_reg = -1e30f, l_reg = 0; f32x16 o[4] = {}; bf16x8 qr[4];
  const long tok0 = (long)b * 4096;
  const unsigned short* Qw = Qb + (tok0 + qb * 128 + qg * QBLK + r32) * LDK + h * 128 + mp * 64 + hi * 8;
#pragma unroll
  for (int d0 = 0; d0 < 4; ++d0) qr[d0] = *reinterpret_cast<const bf16x8*>(Qw + d0 * 16);
  const unsigned short* Kh = Kb + tok0 * LDK + h * 128; const unsigned short* Vh = Vb + tok0 * LDK + h * 128;
  const int sr = tid >> 4, sc = (tid & 15) * 8, vst0 = v_st(sr, sc), vst1 = v_st(32 + sr, sc);
  const int vb0 = (int)(uintptr_t)V_lds + v_rd_base(lane);
  const int mcolB = mp * 128;
  struct { bf16x8 vs0, vs1, ks0, ks1; } sr_[SDEPTH];
#define SLOAD(i, k0) do { sr_[i].vs0 = *reinterpret_cast<const bf16x8*>(&Vh[(long)((k0) + sr) * LDK + sc]); sr_[i].vs1 = *reinterpret_cast<const bf16x8*>(&Vh[(long)((k0) + 32 + sr) * LDK + sc]); \
    sr_[i].ks0 = *reinterpret_cast<const bf16x8*>(&Kh[(long)((k0) + sr) * LDK + sc]); sr_[i].ks1 = *reinterpret_cast<const bf16x8*>(&Kh[(long)((k0) + 32 + sr) * LDK + sc]); } while (0)
#define SWRITE(bb, i) do { *(bf16x8*)(V_lds + (bb) * SHM_V + vst0) = sr_[i].vs0;          \
    *(bf16x8*)(V_lds + (bb) * SHM_V + vst1) = sr_[i].vs1; int kc = sc * 2;               \
    *(bf16x8*)(K_lds + (bb) * SHM_K + KSWZ(sr, kc)) = sr_[i].ks0;                       \
    *(bf16x8*)(K_lds + (bb) * SHM_K + KSWZ(32 + sr, kc)) = sr_[i].ks1; } while (0)
#define SWAIT() do { if constexpr (SDEPTH == 2) asm volatile("s_waitcnt vmcnt(4)" ::: "memory"); else asm volatile("s_waitcnt vmcnt(0)" ::: "memory"); } while (0)
#define RESC(a) do { if (__any((a) < 1.f)) { if (hi == 0) al_l[r32] = (a); asm volatile("s_waitcnt lgkmcnt(0)" ::: "memory"); \
    _Pragma("unroll") for (int d = 0; d < 4; ++d) _Pragma("unroll") for (int r = 0; r < 16; ++r) o[d][r] *= al_l[crow(r, hi)]; } } while (0)
  f32x16 pA0, pA1, pB0, pB1; float mnA, mnB, alA, alB; bf16x8 pa0, pa1, pa2, pa3; const int NT = 4096 / KVBLK;
  constexpr int SE = 0, SO = SDEPTH - 1;
  SLOAD(SE, 0); asm volatile("s_waitcnt vmcnt(0)" ::: "memory"); SWRITE(0, SE); __syncthreads();
  qkt(pA0, pA1, K_lds, qr, r32, hi, mcolB); partialSM(pA0, pA1, m_reg, mnA, alA);
  SLOAD(SO, KVBLK); if constexpr (SDEPTH == 2) SLOAD(SE, 2 * KVBLK);
  SWAIT(); SWRITE(1, SO); __syncthreads();
  for (int j = 1; j + 1 < NT; j += 2) {
    SBAR(); qkt(pB0, pB1, K_lds + SHM_K, qr, r32, hi, mcolB);
    finishSM(pA0, pA1, alA, l_reg, pa0, pa1, pa2, pa3); SBAR();
    SLOAD(SO, (j + SDEPTH) * KVBLK); SBAR();
    pv_d0(o, vb0, pa0, pa1, pa2, pa3); partialSM(pB0, pB1, m_reg, mnB, alB);
    __syncthreads(); SWAIT(); SWRITE(0, SE);
    RESC(alB); __syncthreads();
    SBAR(); qkt(pA0, pA1, K_lds, qr, r32, hi, mcolB);
    finishSM(pB0, pB1, alB, l_reg, pa0, pa1, pa2, pa3); SBAR();
    if (SDEPTH == 1 || j + 3 < NT) SLOAD(SE, (j + 1 + SDEPTH) * KVBLK); SBAR();
    pv_d0(o, vb0 + (int)SHM_V, pa0, pa1, pa2, pa3); partialSM(pA0, pA1, m_reg, mnA, alA);
    __syncthreads(); SWAIT(); SWRITE(1, SO);
    RESC(alA); __syncthreads();
  }
  SBAR(); qkt(pB0, pB1, K_lds + SHM_K, qr, r32, hi, mcolB);
  finishSM(pA0, pA1, alA, l_reg, pa0, pa1, pa2, pa3); SBAR();
  pv_d0(o, vb0, pa0, pa1, pa2, pa3); partialSM(pB0, pB1, m_reg, mnB, alB);
  __syncthreads(); RESC(alB);
  finishSM(pB0, pB1, alB, l_reg, pa0, pa1, pa2, pa3); SBAR();
  pv_d0(o, vb0 + (int)SHM_V, pa0, pa1, pa2, pa3);
  if (hi == 0) li_l[r32] = l_reg; asm volatile("s_waitcnt lgkmcnt(0)" ::: "memory");
  float rli[16];
#pragma unroll
  for (int r = 0; r < 16; ++r) rli[r] = __builtin_amdgcn_rcpf(li_l[crow(r, hi)]);
  float* Ost = (float*)(lds + OST_OFF);
  const int rowb = 32 * qg;
  if (mp == 1) {
#pragma unroll
    for (int r = 0; r < 16; ++r)
#pragma unroll
      for (int d0 = 0; d0 < 4; ++d0) Ost[(rowb + crow(r, hi)) * OST_LD + d0 * 32 + r32] = lam * (o[d0][r] * rli[r]);
  }
  __syncthreads();
  if (mp == 0) {
#pragma unroll
    for (int r = 0; r < 16; ++r)
#pragma unroll
      for (int d0 = 0; d0 < 4; ++d0) { const int ix = (rowb + crow(r, hi)) * OST_LD + d0 * 32 + r32; Ost[ix] = o[d0][r] * rli[r] - Ost[ix]; }
  }
  __syncthreads();
  {
    const int row = 16 * wid + (lane >> 2), cb = (lane & 3) * 32;
    f32x4 v[8]; float ss = 0.f;
#pragma unroll
    for (int i = 0; i < 8; ++i) { v[i] = *(const f32x4*)&Ost[row * OST_LD + cb + 4 * i]; ss += (v[i][0] * v[i][0] + v[i][1] * v[i][1]) + (v[i][2] * v[i][2] + v[i][3] * v[i][3]); }
    ss += __shfl_xor(ss, 1); ss += __shfl_xor(ss, 2);
    const float scl = (1.0f - 0.2f) / sqrtf(ss * (1.0f / 128.0f) + 1e-6f);
    unsigned short* op = MX + (tok0 + qb * 128 + row) * 1024 + h * 128 + cb;
#pragma unroll
    for (int i = 0; i < 4; ++i) {
      const f32x4 g0 = *(const f32x4*)(gdn + cb + 8 * i), g1 = *(const f32x4*)(gdn + cb + 8 * i + 4);
      const f32x4 a = v[2 * i] * g0 * scl, c = v[2 * i + 1] * g1 * scl;
      u32x4 w = {cvtpk(a[0], a[1]), cvtpk(a[2], a[3]), cvtpk(c[0], c[1]), cvtpk(c[2], c[3])};
      *(u32x4*)(op + 8 * i) = w;
    }
  }
  __syncthreads();
#undef SLOAD
#undef SWRITE
#undef SWAIT
#undef RESC
}
#undef KSWZ
#undef SBAR
}

#define LAS __attribute__((address_space(3)))
typedef unsigned short bf16;
typedef float f32x4 __attribute__((ext_vector_type(4)));
typedef float f32x16 __attribute__((ext_vector_type(16)));
typedef short bf16x8 __attribute__((ext_vector_type(8)));
typedef unsigned u32x4 __attribute__((ext_vector_type(4)));
typedef unsigned u32x2 __attribute__((ext_vector_type(2)));
__device__ __forceinline__ unsigned f2bf(float f) { unsigned u = __builtin_bit_cast(unsigned, f); return (u + 0x7fffu + ((u >> 16) & 1u)) >> 16; }
__device__ __forceinline__ unsigned pk2(float lo, float hi) { return f2bf(lo) | (f2bf(hi) << 16); }
__device__ __forceinline__ float bflo(unsigned w) { return __uint_as_float(w << 16); }
__device__ __forceinline__ float bfhi(unsigned w) { return __uint_as_float(w & 0xffff0000u); }
__device__ __forceinline__ float bf1(unsigned short h) { return __uint_as_float(((unsigned)h) << 16); }
__device__ __forceinline__ float sigm(float z) { return __builtin_amdgcn_rcpf(1.0f + __expf(-z)); }
__device__ __forceinline__ float gelu_tanh(float x) { return x * sigm(1.5957691216057308f * (x + 0.044715f * x * x * x)); }
__device__ __forceinline__ float wave_sum(float v) {
#pragma unroll
    for (int o = 1; o < 64; o <<= 1) v += __shfl_xor(v, o);
    return v;
}
__device__ __forceinline__ int crow16(int r, int hi) { return (r & 3) + 8 * (r >> 2) + 4 * hi; }

struct LruArgs { const bf16* LIN; const float* conv_w; const float* conv_b; const bf16* LWT; const float* ba; const float* bx; const float* lam; bf16* HOUT; };
__device__ __forceinline__ void lru_item(int b, int n, int dir, const LruArgs& A, char* lds) {
    const int tid = fresh_tid(), wid = tid >> 6, lane = tid & 63, r32 = lane & 31, hi = lane >> 5;
    bf16* ucs = (bf16*)lds; float* als = (float*)(lds + 18432); float* bls = (float*)(lds + 51200);
    float* cA = (float*)(lds + 83968); float* cH = (float*)(lds + 86016); float* cw = (float*)(lds + 88064);
    const bool fwd = (dir == 0);
    if (tid < 256) cw[tid] = A.conv_w[(tid >> 6) * 512 + n * 64 + (tid & 63)];
    else if (tid < 320) cw[tid] = A.conv_b[n * 64 + (tid - 256)];
    const int rt = wid >> 1, ch = wid & 1;
    bf16x8 wfa[4], wfx[4];
    {
        const bf16* wa = A.LWT + ((size_t)((dir * 8 + n) * 2 + 0) * 64 + ch * 32 + r32) * 64 + hi * 8;
        const bf16* wx = A.LWT + ((size_t)((dir * 8 + n) * 2 + 1) * 64 + ch * 32 + r32) * 64 + hi * 8;
#pragma unroll
        for (int ks = 0; ks < 4; ++ks) { wfa[ks] = *(const bf16x8*)(wa + ks * 16); wfx[ks] = *(const bf16x8*)(wx + ks * 16); }
    }
    const int cg_ = ch * 32 + r32;
    const float bav = A.ba[dir * 512 + n * 64 + cg_], bxv = A.bx[dir * 512 + n * 64 + cg_];
    const float lamv = A.lam[dir * 512 + n * 64 + cg_];
    const float spv = -8.0f * log1pf(__expf(-lamv));
    float state = 0.f;
    const long tokb = (long)b * 4096;
    __syncthreads();
    for (int ci = 0; ci < 32; ++ci) {
        const int t0 = (fwd ? ci : 31 - ci) * 128;
        {
            const int tt = tid >> 2, c0 = (tid & 3) * 16;
            float accv[16];
#pragma unroll
            for (int i = 0; i < 16; ++i) accv[i] = cw[256 + c0 + i];
#pragma unroll
            for (int j = 0; j < 4; ++j) {
                const int s = t0 + tt + j - 2;
                if (s >= 0 && s < 4096) {
                    const u32x4 w0 = *(const u32x4*)(A.LIN + (tokb + s) * 512 + n * 64 + c0), w1 = *(const u32x4*)(A.LIN + (tokb + s) * 512 + n * 64 + c0 + 8);
                    const float* cwj = cw + j * 64 + c0;
                    accv[0] += bflo(w0.x) * cwj[0]; accv[1] += bfhi(w0.x) * cwj[1]; accv[2] += bflo(w0.y) * cwj[2]; accv[3] += bfhi(w0.y) * cwj[3];
                    accv[4] += bflo(w0.z) * cwj[4]; accv[5] += bfhi(w0.z) * cwj[5]; accv[6] += bflo(w0.w) * cwj[6]; accv[7] += bfhi(w0.w) * cwj[7];
                    accv[8] += bflo(w1.x) * cwj[8]; accv[9] += bfhi(w1.x) * cwj[9]; accv[10] += bflo(w1.y) * cwj[10]; accv[11] += bfhi(w1.y) * cwj[11];
                    accv[12] += bflo(w1.z) * cwj[12]; accv[13] += bfhi(w1.z) * cwj[13]; accv[14] += bflo(w1.w) * cwj[14]; accv[15] += bfhi(w1.w) * cwj[15];
                }
            }
            u32x4 o0 = {pk2(accv[0], accv[1]), pk2(accv[2], accv[3]), pk2(accv[4], accv[5]), pk2(accv[6], accv[7])};
            u32x4 o1 = {pk2(accv[8], accv[9]), pk2(accv[10], accv[11]), pk2(accv[12], accv[13]), pk2(accv[14], accv[15])};
            *(u32x4*)(ucs + tt * 72 + c0) = o0; *(u32x4*)(ucs + tt * 72 + c0 + 8) = o1;
        }
        __syncthreads();
        {
            f32x16 da = {}, dx = {};
#pragma unroll
            for (int ks = 0; ks < 4; ++ks) {
                const bf16x8 af = *(const bf16x8*)(ucs + (rt * 32 + r32) * 72 + ks * 16 + hi * 8);
                da = __builtin_amdgcn_mfma_f32_32x32x16_bf16(af, wfa[ks], da, 0, 0, 0);
                dx = __builtin_amdgcn_mfma_f32_32x32x16_bf16(af, wfx[ks], dx, 0, 0, 0);
            }
#pragma unroll
            for (int r = 0; r < 16; ++r) {
                const int tk = rt * 32 + crow16(r, hi);
                const float rr = sigm(da[r] + bav), ii = sigm(dx[r] + bxv);
                const float la = spv * rr, av = __expf(la), mult = sqrtf(fmaxf(1.0f - av * av, 0.f));
                const float uv = bf1(ucs[tk * 72 + cg_]);
                als[tk * 64 + cg_] = av; bls[tk * 64 + cg_] = mult * (ii * uv);
            }
        }
        __syncthreads();
        {
            const int c = tid & 63, j = tid >> 6;
            float hl[16], Ac[16]; float hh = 0.f, AA = 1.f;
#pragma unroll
            for (int i = 0; i < 16; ++i) { const int p = j * 16 + i, tt = fwd ? p : 127 - p; const float av = als[tt * 64 + c], bv = bls[tt * 64 + c]; hh = av * hh + bv; AA = AA * av; hl[i] = hh; Ac[i] = AA; }
            cA[j * 64 + c] = AA; cH[j * 64 + c] = hh;
            __syncthreads();
            float s = state, sin_ = state;
#pragma unroll
            for (int jj = 0; jj < 8; ++jj) { if (jj == j) sin_ = s; s = cA[jj * 64 + c] * s + cH[jj * 64 + c]; }
            state = s;
            bf16* outp = A.HOUT + (tokb + t0) * 512 + n * 64 + c;
#pragma unroll
            for (int i = 0; i < 16; ++i) { const int p = j * 16 + i, tt = fwd ? p : 127 - p; outp[(long)tt * 512] = (bf16)f2bf(hl[i] + Ac[i] * sin_); }
        }
        __syncthreads();
    }
}

__device__ __forceinline__ unsigned mono_key(float f) { const unsigned b = __float_as_uint(f); return b ^ ((unsigned)((int)b >> 31) | 0x80000000u); }
#define TK_INS(L, xin) do { unsigned x_ = (xin); _Pragma("unroll") for (int q_ = 0; q_ < 16; ++q_) { const unsigned t_ = max(L[q_], x_); x_ = min(L[q_], x_); L[q_] = t_; } } while (0)
struct TopkArgs { const bf16* QP; const bf16* KEYS; unsigned short* IDX; float* GW; };
__device__ __forceinline__ void topk_unit(int tile, const TopkArgs& A, const bf16x8 (&kf)[4][4], char* lds) {
    const int tid = fresh_tid(), wid = tid >> 6, lane = tid & 63, r32 = lane & 31, hi = lane >> 5;
    float* sc = (float*)lds; unsigned* sci = (unsigned*)lds;
    const int t0 = tile * 64;
    for (int hp = 0; hp < 4; ++hp) {
        {
            const int combo = wid >> 1, head = 2 * hp + (wid >> 2), half = (wid >> 1) & 1, rtile = wid & 1;
            const bf16* qrow = A.QP + (size_t)(t0 + rtile * 32 + r32) * 1024 + head * 128 + half * 64 + hi * 8;
            bf16x8 af[4];
#pragma unroll
            for (int ks = 0; ks < 4; ++ks) af[ks] = *(const bf16x8*)(qrow + ks * 16);
#pragma unroll
            for (int ct = 0; ct < 4; ++ct) {
                f32x16 d = {};
#pragma unroll
                for (int ks = 0; ks < 4; ++ks) d = __builtin_amdgcn_mfma_f32_32x32x16_bf16(af[ks], kf[ct][ks], d, 0, 0, 0);
#pragma unroll
                for (int r = 0; r < 16; ++r) sc[(combo * 64 + rtile * 32 + crow16(r, hi)) * 132 + ct * 32 + r32] = d[r];
            }
        }
        __syncthreads();
        {
            const int row = tid >> 1, part = tid & 1;
            const float* rowp = sc + row * 132 + part * 64;
            unsigned L[16];
#pragma unroll
            for (int q = 0; q < 16; ++q) L[q] = 0u;
#pragma unroll
            for (int i = 0; i < 16; ++i) {
                const f32x4 v = *(const f32x4*)(rowp + 4 * i);
#pragma unroll
                for (int j = 0; j < 4; ++j) { const unsigned key = (mono_key(v[j]) & ~127u) | (127u - (unsigned)(part * 64 + 4 * i + j)); TK_INS(L, key); }
            }
            unsigned P[16];
#pragma unroll
            for (int q = 0; q < 16; ++q) P[q] = __shfl_xor(L[q], 1);
#pragma unroll
            for (int q = 0; q < 16; ++q) TK_INS(L, P[q]);
            float vals[16]; unsigned ids[16];
#pragma unroll
            for (int q = 0; q < 16; ++q) { ids[q] = 127u - (L[q] & 127u); vals[q] = sc[row * 132 + ids[q]]; }
            asm volatile("s_waitcnt lgkmcnt(0)" ::: "memory");
            if (part == 0) {
#pragma unroll
                for (int q = 0; q < 16; ++q) { sc[row * 132 + q] = vals[q]; sci[row * 132 + 16 + q] = ids[q]; }
            }
        }
        __syncthreads();
        if (tid < 128) {
            const int tok = tid & 63, hh = tid >> 6;
            const int row1 = (hh * 2 + 0) * 64 + tok, row2 = (hh * 2 + 1) * 64 + tok;
            float v1[16], v2[16];
#pragma unroll
            for (int q = 0; q < 16; ++q) { v1[q] = sc[row1 * 132 + q]; v2[q] = sc[row2 * 132 + q]; }
            unsigned L[16];
#pragma unroll
            for (int q = 0; q < 16; ++q) L[q] = 0u;
#pragma unroll
            for (int i = 0; i < 16; ++i)
#pragma unroll
                for (int j = 0; j < 16; ++j)
                    if ((i + 1) * (j + 1) <= 16) { const unsigned key = (mono_key(v1[i] + v2[j]) & ~255u) | (255u - (unsigned)(i * 16 + j)); TK_INS(L, key); }
            float sv[16]; unsigned ev[16]; float mx = -3.0e38f;
#pragma unroll
            for (int q = 0; q < 16; ++q) {
                const unsigned pos = 255u - (L[q] & 255u), i = pos >> 4, j = pos & 15u;
                sv[q] = sc[row1 * 132 + i] + sc[row2 * 132 + j];
                ev[q] = sci[row1 * 132 + 16 + i] * 128u + sci[row2 * 132 + 16 + j];
                mx = fmaxf(mx, sv[q]);
            }
            float sum = 0.f;
#pragma unroll
            for (int q = 0; q < 16; ++q) { sv[q] = __expf(sv[q] - mx); sum += sv[q]; }
            const float inv = 1.0f / sum;
            const size_t ob = (size_t)(t0 + tok) * 128 + (2 * hp + hh) * 16;
#pragma unroll
            for (int q = 0; q < 16; ++q) { A.IDX[ob + q] = (unsigned short)ev[q]; A.GW[ob + q] = sv[q] * inv; }
        }
        __syncthreads();
    }
}

struct PeerArgs { const unsigned short* IDX; const bf16* HB; const bf16* UT; const bf16* VT; float* PLOG; const float* ACT; float* H; bf16* H2B; float* SS2; };
__device__ __forceinline__ float dot8(const float (&x)[8], u32x4 u) {
    float s = x[0] * bflo(u.x); s = fmaf(x[1], bfhi(u.x), s); s = fmaf(x[2], bflo(u.y), s); s = fmaf(x[3], bfhi(u.y), s);
    s = fmaf(x[4], bflo(u.z), s); s = fmaf(x[5], bfhi(u.z), s); s = fmaf(x[6], bflo(u.w), s); s = fmaf(x[7], bfhi(u.w), s); return s;
}
__device__ __forceinline__ void peer_u_item(int tile, int s, const PeerArgs& A, char* lds) {
    const int tid = fresh_tid(), wid = tid >> 6, lane = tid & 63, e4 = lane >> 4, c = lane & 15;
    unsigned short* widx = (unsigned short*)(lds + wid * 1024);
    for (int tt = wid; tt < 128; tt += 8) {
        const int t = tile * 128 + tt;
        widx[lane] = A.IDX[(size_t)t * 128 + lane]; widx[64 + lane] = A.IDX[(size_t)t * 128 + 64 + lane];
        const u32x4 xw = *(const u32x4*)(A.HB + (size_t)t * 1024 + s * 128 + c * 8);
        const float xf[8] = {bflo(xw.x), bfhi(xw.x), bflo(xw.y), bfhi(xw.y), bflo(xw.z), bfhi(xw.z), bflo(xw.w), bfhi(xw.w)};
        asm volatile("s_waitcnt lgkmcnt(0)" ::: "memory");
        float p[32];
#pragma unroll
        for (int gb = 0; gb < 4; ++gb) {
            u32x4 uw[8];
#pragma unroll
            for (int g = 0; g < 8; ++g) { const unsigned e = widx[4 * (gb * 8 + g) + e4]; uw[g] = *(const u32x4*)(A.UT + (size_t)e * 1024 + s * 128 + c * 8); }
#pragma unroll
            for (int g = 0; g < 8; ++g) p[gb * 8 + g] = dot8(xf, uw[g]);
        }
#pragma unroll
        for (int i = 0; i < 16; ++i) { const bool up = (c & 8) != 0; const float give = up ? p[i] : p[i + 16]; const float keep = up ? p[i + 16] : p[i]; p[i] = keep + __shfl_xor(give, 8); }
#pragma unroll
        for (int i = 0; i < 8; ++i) { const bool up = (c & 4) != 0; const float give = up ? p[i] : p[i + 8]; const float keep = up ? p[i + 8] : p[i]; p[i] = keep + __shfl_xor(give, 4); }
#pragma unroll
        for (int i = 0; i < 4; ++i) { const bool up = (c & 2) != 0; const float give = up ? p[i] : p[i + 4]; const float keep = up ? p[i + 4] : p[i]; p[i] = keep + __shfl_xor(give, 2); }
#pragma unroll
        for (int i = 0; i < 2; ++i) { const bool up = (c & 1) != 0; const float give = up ? p[i] : p[i + 2]; const float keep = up ? p[i + 2] : p[i]; p[i] = keep + __shfl_xor(give, 1); }
        float* po = A.PLOG + ((size_t)s * T + t) * 128;
        po[4 * (2 * c) + e4] = p[0]; po[4 * (2 * c + 1) + e4] = p[1];
    }
}
__device__ __forceinline__ void peer_v_item(int tile, int s, const PeerArgs& A, char* lds) {
    const int tid = fresh_tid(), wid = tid >> 6, lane = tid & 63, e4 = lane >> 4, c = lane & 15;
    unsigned short* widx = (unsigned short*)(lds + wid * 1024); float* wact = (float*)(lds + wid * 1024 + 256);
    for (int tt = wid; tt < 128; tt += 8) {
        const int t = tile * 128 + tt;
        widx[lane] = A.IDX[(size_t)t * 128 + lane]; widx[64 + lane] = A.IDX[(size_t)t * 128 + 64 + lane];
        wact[lane] = A.ACT[(size_t)t * 128 + lane]; wact[64 + lane] = A.ACT[(size_t)t * 128 + 64 + lane];
        asm volatile("s_waitcnt lgkmcnt(0)" ::: "memory");
        float acc[8];
#pragma unroll
        for (int j = 0; j < 8; ++j) acc[j] = 0.f;
#pragma unroll
        for (int gb = 0; gb < 4; ++gb) {
            u32x4 vw[8]; float av[8];
#pragma unroll
            for (int g = 0; g < 8; ++g) { const int k = 4 * (gb * 8 + g) + e4; const unsigned e = widx[k]; av[g] = wact[k]; vw[g] = *(const u32x4*)(A.VT + (size_t)e * 1024 + s * 128 + c * 8); }
#pragma unroll
            for (int g = 0; g < 8; ++g) {
                acc[0] = fmaf(av[g], bflo(vw[g].x), acc[0]); acc[1] = fmaf(av[g], bfhi(vw[g].x), acc[1]); acc[2] = fmaf(av[g], bflo(vw[g].y), acc[2]); acc[3] = fmaf(av[g], bfhi(vw[g].y), acc[3]);
                acc[4] = fmaf(av[g], bflo(vw[g].z), acc[4]); acc[5] = fmaf(av[g], bfhi(vw[g].z), acc[5]); acc[6] = fmaf(av[g], bflo(vw[g].w), acc[6]); acc[7] = fmaf(av[g], bfhi(vw[g].w), acc[7]);
            }
        }
#pragma unroll
        for (int j = 0; j < 8; ++j) { acc[j] += __shfl_xor(acc[j], 16); acc[j] += __shfl_xor(acc[j], 32); }
        float* hp = A.H + (size_t)t * 1024 + s * 128 + c * 8;
        float ssq = 0.f;
        if (e4 == 0) {
            f32x4 h0 = *(const f32x4*)hp, h1 = *(const f32x4*)(hp + 4);
            h0[0] += acc[0]; h0[1] += acc[1]; h0[2] += acc[2]; h0[3] += acc[3]; h1[0] += acc[4]; h1[1] += acc[5]; h1[2] += acc[6]; h1[3] += acc[7];
            *(f32x4*)hp = h0; *(f32x4*)(hp + 4) = h1;
            u32x4 w = {pk2(h0[0], h0[1]), pk2(h0[2], h0[3]), pk2(h1[0], h1[1]), pk2(h1[2], h1[3])};
            *(u32x4*)(A.H2B + (size_t)t * 1024 + s * 128 + c * 8) = w;
            ssq = (h0[0] * h0[0] + h0[1] * h0[1]) + (h0[2] * h0[2] + h0[3] * h0[3]) + (h1[0] * h1[0] + h1[1] * h1[1]) + (h1[2] * h1[2] + h1[3] * h1[3]);
        }
        ssq += __shfl_xor(ssq, 1); ssq += __shfl_xor(ssq, 2); ssq += __shfl_xor(ssq, 4); ssq += __shfl_xor(ssq, 8);
        if (lane == 0) A.SS2[(size_t)t * 8 + s] = ssq;
    }
}

constexpr size_t MiB = (size_t)1 << 20;
constexpr size_t WS_CTL = 0, CTL_ZERO_BYTES = 1 * MiB;
constexpr size_t WS_WIN = 1 * MiB, WS_WOUT = 6 * MiB, WS_WQ = 8 * MiB, WS_WG = 10 * MiB, WS_WP = 12 * MiB;
constexpr size_t WS_KEYS = 12 * MiB + 512 * 1024, WS_LWT = 12 * MiB + 768 * 1024, WS_ROPE = 13 * MiB, WS_MISC = 15 * MiB;
constexpr size_t WS_SS1 = 16 * MiB, WS_SS2 = 18 * MiB, WS_SS3 = 20 * MiB;
constexpr size_t WS_IDX = 24 * MiB, WS_GW = 32 * MiB, WS_PB = 48 * MiB;
constexpr size_t WS_UT = 64 * MiB, WS_VT = 96 * MiB;
constexpr size_t WS_XN = 128 * MiB;
constexpr size_t WS_Q = 192 * MiB, WS_K = 224 * MiB, WS_V = 256 * MiB, WS_LIN = 288 * MiB, WS_LGATE = 320 * MiB;
constexpr size_t WS_QP = 192 * MiB;
constexpr size_t WS_MIXED = 352 * MiB, WS_HF = 416 * MiB, WS_HB = 448 * MiB;
constexpr size_t WS_PLOG = 352 * MiB;
constexpr size_t WS_ACT = 256 * MiB;
constexpr size_t WS_END = 480 * MiB;
constexpr int LDS_BYTES = 147456;

struct Args {
    const float* in[29]; float* out; unsigned char* ws; int ph_lo, ph_hi, coop, pad;
};
struct Frame { char* lds; int G, bid; const Args* a; unsigned char* ws; };


__device__ __forceinline__ void p0_transpose_item(const float* W, int K, int N, bf16* WT, const float* gk, float* scr, int item, int lane) {
    const int nblk = N / 32, kb = item / nblk, nb = item % nblk, k0 = 64 * kb, n0 = 32 * nb;
#pragma unroll 8
    for (int i = 0; i < 32; ++i) { const int kk = 2 * i + (lane >> 5); float w = W[(size_t)(k0 + kk) * N + n0 + (lane & 31)]; if (gk) w *= gk[k0 + kk]; scr[kk * 33 + (lane & 31)] = w; }
    asm volatile("s_waitcnt lgkmcnt(0)" ::: "memory");
    const int c = lane & 7;
#pragma unroll
    for (int j = 0; j < 4; ++j) { const int n = (lane >> 3) + 8 * j; const float* s = scr + (8 * c) * 33 + n;
        u32x4 o; o.x = pk2(s[0 * 33], s[1 * 33]); o.y = pk2(s[2 * 33], s[3 * 33]); o.z = pk2(s[4 * 33], s[5 * 33]); o.w = pk2(s[6 * 33], s[7 * 33]);
        *(u32x4*)(WT + (size_t)(n0 + n) * K + k0 + 8 * c) = o; }
    asm volatile("s_waitcnt lgkmcnt(0)" ::: "memory");
}
__device__ __forceinline__ void p0_prologue(Frame& F) {
    const int tid_ = fresh_tid(), lane_ = tid_ & 63, wave_ = __builtin_amdgcn_readfirstlane(tid_ >> 6);
    float* scr = (float*)(F.lds + wave_ * 16384);
    const int gw = F.bid * 8 + wave_, NGW = F.G * 8;
    const long gt = (long)F.bid * 512 + tid_, NGT = (long)F.G * 512;
    unsigned char* ws = F.ws;
    constexpr int I_IN = 16 * 80, I_SQ = 16 * 32, I_P = 4 * 32;
    for (int it = gw; it < I_IN + 3 * I_SQ + I_P; it += NGW) {
        int r = it;
        if (r < I_IN) { p0_transpose_item(F.a->in[4], 1024, 2560, (bf16*)(ws + WS_WIN), nullptr, scr, r, lane_); continue; } r -= I_IN;
        if (r < I_SQ) { p0_transpose_item(F.a->in[18], 1024, 1024, (bf16*)(ws + WS_WOUT), nullptr, scr, r, lane_); continue; } r -= I_SQ;
        if (r < I_SQ) { p0_transpose_item(F.a->in[20], 1024, 1024, (bf16*)(ws + WS_WQ), F.a->in[19], scr, r, lane_); continue; } r -= I_SQ;
        if (r < I_SQ) { p0_transpose_item(F.a->in[26], 1024, 1024, (bf16*)(ws + WS_WG), F.a->in[25], scr, r, lane_); continue; } r -= I_SQ;
        p0_transpose_item(F.a->in[27], 256, 1024, (bf16*)(ws + WS_WP), nullptr, scr, r, lane_);
    }
    for (int m = gw; m < T; m += NGW) {
        const f32x4* xr = (const f32x4*)(F.a->in[0] + (size_t)m * 1024) + lane_; const f32x4* gr = (const f32x4*)F.a->in[3] + lane_;
        f32x4 v[4]; float s = 0.f;
#pragma unroll
        for (int j = 0; j < 4; ++j) { v[j] = xr[64 * j]; s += (v[j][0] * v[j][0] + v[j][1] * v[j][1]) + (v[j][2] * v[j][2] + v[j][3] * v[j][3]); }
        const float rstd = 1.0f / sqrtf(wave_sum(s) * (1.0f / 1024.0f) + EPS);
        u32x2* o8 = (u32x2*)(ws + WS_XN + (size_t)m * 2048) + lane_;
#pragma unroll
        for (int j = 0; j < 4; ++j) { const f32x4 g = gr[64 * j]; u32x2 w = {pk2(v[j][0] * rstd * g[0], v[j][1] * rstd * g[1]), pk2(v[j][2] * rstd * g[2], v[j][3] * rstd * g[3])}; o8[64 * j] = w; }
    }
    for (long i = gt; i < (long)T * PLE / 8; i += NGT) {
        const f32x4 a = *(const f32x4*)(F.a->in[1] + i * 8), b = *(const f32x4*)(F.a->in[1] + i * 8 + 4);
        u32x4 w = {pk2(a[0], a[1]), pk2(a[2], a[3]), pk2(b[0], b[1]), pk2(b[2], b[3])}; *(u32x4*)(ws + WS_PB + i * 16) = w;
    }
    for (long i = gt; i < (long)16384 * 1024 / 8; i += NGT) {
        const int c0 = (int)((i * 8) & 1023);
        const f32x4 a = *(const f32x4*)(F.a->in[23] + i * 8), b = *(const f32x4*)(F.a->in[23] + i * 8 + 4), g0 = *(const f32x4*)(F.a->in[19] + c0), g1 = *(const f32x4*)(F.a->in[19] + c0 + 4);
        u32x4 w = {pk2(a[0] * g0[0], a[1] * g0[1]), pk2(a[2] * g0[2], a[3] * g0[3]), pk2(b[0] * g1[0], b[1] * g1[1]), pk2(b[2] * g1[2], b[3] * g1[3])}; *(u32x4*)(ws + WS_UT + i * 16) = w;
        const f32x4 c = *(const f32x4*)(F.a->in[24] + i * 8), d = *(const f32x4*)(F.a->in[24] + i * 8 + 4);
        u32x4 w2 = {pk2(c[0], c[1]), pk2(c[2], c[3]), pk2(d[0], d[1]), pk2(d[2], d[3])}; *(u32x4*)(ws + WS_VT + i * 16) = w2;
    }
    for (long i = gt; i < (long)T * 8; i += NGT) {
        const int t = (int)(i >> 3), k = (int)(i & 7);
        const float invf[8] = {1.0f, 0.19392274474868576f, 0.03760603093086393f, 0.007292664737217109f, 0.001414213562373095f, 0.0002742481756762073f, 5.318295896944988e-05f, 1.031338537721246e-05f};
        float fr = 1.0f;
#pragma unroll
        for (int q = 0; q < 8; ++q) if (q == k) fr = invf[q];
        const float ang = (float)((const int*)F.a->in[2])[t] * fr; float sn, cs; sincosf(ang, &sn, &cs);
        float* rp = (float*)(ws + WS_ROPE) + (size_t)t * 16; rp[k] = cs; rp[8 + k] = sn;
    }
    for (long i = gt; i < 2 * 8192; i += NGT) { const float v = (i < 8192) ? F.a->in[21][i] : F.a->in[22][i - 8192]; ((bf16*)(ws + WS_KEYS))[i] = (bf16)f2bf(v); }
    for (long i = gt; i < 2 * 8 * 2 * 64 * 64; i += NGT) {
        const int c = (int)(i & 63), e = (int)((i >> 6) & 63), gate = (int)((i >> 12) & 1), n = (int)((i >> 13) & 7), dir = (int)(i >> 16);
        const float* w = gate ? F.a->in[14] : F.a->in[12]; ((bf16*)(ws + WS_LWT))[i] = (bf16)f2bf(w[(((size_t)dir * 8 + n) * 64 + c) * 64 + e]);
    }
    if (F.bid == 0 && tid_ == 0) {
        float s1 = 0.f, s2 = 0.f;
        for (int i = 0; i < 64; ++i) { s1 += F.a->in[5][i] * F.a->in[6][i]; s2 += F.a->in[7][i] * F.a->in[8][i]; }
        ((float*)(ws + WS_MISC))[0] = expf(s1) - expf(s2) + LAMBDA_INIT;
    }
}

__global__ void __launch_bounds__(512, 2) enc_fwd(Args args) {
    extern __shared__ __attribute__((aligned(16))) unsigned char lds_raw[];
    Frame F;
    F.lds = (char*)lds_raw; F.G = gridDim.x; F.bid = blockIdx.x;
    F.a = &args; F.ws = args.ws;
    unsigned char* ws = args.ws;
    const int lo = args.ph_lo, hi = args.ph_hi;
    cg::grid_group grid = cg::this_grid();
#ifndef PHMASK
#define PHMASK 0x1fff
#endif
#define IN(k) ((((PHMASK) >> (k)) & 1) && lo <= (k) && (k) < hi)
#define SEAM(k) do { if (IN(k) && IN((k) + 1)) { if (args.coop) grid.sync(); } } while (0)
    PG8_LAS unsigned char* ldsl = (PG8_LAS unsigned char*)lds_raw;

    if (IN(0)) { p0_prologue(F); __syncthreads(); }
    SEAM(0);
    if (IN(1)) {
        pg8::Gemm g{(const bf16*)(ws + WS_XN), (const bf16*)(ws + WS_WIN), T, INC, 1024}; pg8::StaticOrder S; S.init(T, INC, F.G, F.bid);
        pg8::EpiProj E{(bf16*)(ws + WS_Q), (const float*)(ws + WS_ROPE)};
        pg8::gemm_phase<pg8::EpiProj, pg8::StaticOrder, true, true>(ldsl, g, S, E);
    }
    SEAM(1);
    if (IN(2)) {
        const float lam = ((const float*)(ws + WS_MISC))[0];
        for (int it = F.bid; it < 128; it += F.G) {
            const int b = it & 7, nd = it >> 3, n = nd & 7, dir = nd >> 3;
            LruArgs A{(const bf16*)(ws + WS_LIN), F.a->in[10], F.a->in[11], (const bf16*)(ws + WS_LWT), F.a->in[13], F.a->in[15], F.a->in[16], (bf16*)(ws + (dir ? WS_HB : WS_HF))};
            lru_item(b, n, dir, A, F.lds);
        }
        for (int it = F.bid; it < 1024; it += F.G) {
            const int xx = it & 7, rest = it >> 3, qb = rest & 31, i4 = rest >> 5, bh = i4 * 8 + xx;
            att::attn_unit(bh >> 2, bh & 3, qb, (const bf16*)(ws + WS_Q), (const bf16*)(ws + WS_K), (const bf16*)(ws + WS_V), (bf16*)(ws + WS_MIXED), F.a->in[9], lam, F.lds);
        }
    }
    SEAM(2);
    if (IN(3)) {
        const int tid_ = fresh_tid(), lane_ = tid_ & 63, wave_ = __builtin_amdgcn_readfirstlane(tid_ >> 6);
        const int gw = F.bid * 8 + wave_, NGW = F.G * 8;
        for (int t = gw; t < T; t += NGW) {
            const u32x4 a = *(const u32x4*)(ws + WS_HF + ((size_t)t * 512 + lane_ * 8) * 2), b = *(const u32x4*)(ws + WS_HB + ((size_t)t * 512 + lane_ * 8) * 2), gt = *(const u32x4*)(ws + WS_LGATE + ((size_t)t * 512 + lane_ * 8) * 2);
            float y[8];
            y[0] = (bflo(a.x) + bflo(b.x)) * gelu_tanh(bflo(gt.x)); y[1] = (bfhi(a.x) + bfhi(b.x)) * gelu_tanh(bfhi(gt.x));
            y[2] = (bflo(a.y) + bflo(b.y)) * gelu_tanh(bflo(gt.y)); y[3] = (bfhi(a.y) + bfhi(b.y)) * gelu_tanh(bfhi(gt.y));
            y[4] = (bflo(a.z) + bflo(b.z)) * gelu_tanh(bflo(gt.z)); y[5] = (bfhi(a.z) + bfhi(b.z)) * gelu_tanh(bfhi(gt.z));
            y[6] = (bflo(a.w) + bflo(b.w)) * gelu_tanh(bflo(gt.w)); y[7] = (bfhi(a.w) + bfhi(b.w)) * gelu_tanh(bfhi(gt.w));
            float s = 0.f;
#pragma unroll
            for (int j = 0; j < 8; ++j) s += y[j] * y[j];
            const float rstd = 1.0f / sqrtf(wave_sum(s) * (1.0f / 512.0f) + EPS);
            const f32x4 g0 = *(const f32x4*)(F.a->in[17] + lane_ * 8), g1 = *(const f32x4*)(F.a->in[17] + lane_ * 8 + 4);
            u32x4 w = {pk2(y[0] * rstd * g0[0], y[1] * rstd * g0[1]), pk2(y[2] * rstd * g0[2], y[3] * rstd * g0[3]), pk2(y[4] * rstd * g1[0], y[5] * rstd * g1[1]), pk2(y[6] * rstd * g1[2], y[7] * rstd * g1[3])};
            *(u32x4*)(ws + WS_MIXED + ((size_t)t * 1024 + 512 + lane_ * 8) * 2) = w;
        }
    }
    SEAM(3);
    if (IN(4)) {
        pg8::Gemm g{(const bf16*)(ws + WS_MIXED), (const bf16*)(ws + WS_WOUT), T, 1024, 1024}; pg8::StaticOrder S; S.init(T, 1024, F.G, F.bid);
        pg8::EpiResid E{F.a->in[0], F.a->out, (bf16*)(ws + WS_XN), (float*)(ws + WS_SS1)};
        pg8::gemm_phase<pg8::EpiResid, pg8::StaticOrder, true, true>(ldsl, g, S, E);
    }
    SEAM(4);
    if (IN(5)) {
        pg8::Gemm g{(const bf16*)(ws + WS_XN), (const bf16*)(ws + WS_WQ), T, 1024, 1024}; pg8::StaticOrder S; S.init(T, 1024, F.G, F.bid);
        pg8::EpiScaleBf16 E{(bf16*)(ws + WS_QP), (const float*)(ws + WS_SS1)};
        pg8::gemm_phase<pg8::EpiScaleBf16, pg8::StaticOrder, true, true>(ldsl, g, S, E);
    }
    SEAM(5);
    if (IN(6)) {
        TopkArgs A{(const bf16*)(ws + WS_QP), (const bf16*)(ws + WS_KEYS), (unsigned short*)(ws + WS_IDX), (float*)(ws + WS_GW)};
        bf16x8 kf[4][4];
        { const int tid_ = fresh_tid(), lane_ = tid_ & 63, wave_ = __builtin_amdgcn_readfirstlane(tid_ >> 6); const int half = (wave_ >> 1) & 1, r32 = lane_ & 31, hi5 = lane_ >> 5;
#pragma unroll
          for (int ct = 0; ct < 4; ++ct)
#pragma unroll
            for (int ks = 0; ks < 4; ++ks) kf[ct][ks] = *(const bf16x8*)(A.KEYS + (size_t)half * 8192 + (ct * 32 + r32) * 64 + ks * 16 + hi5 * 8); }
        for (int tile = F.bid; tile < T / 64; tile += F.G) topk_unit(tile, A, kf, F.lds);
    }
    SEAM(6);
    PeerArgs PA{(const unsigned short*)(ws + WS_IDX), (const bf16*)(ws + WS_XN), (const bf16*)(ws + WS_UT), (const bf16*)(ws + WS_VT), (float*)(ws + WS_PLOG), (const float*)(ws + WS_ACT), F.a->out, (bf16*)(ws + WS_XN), (float*)(ws + WS_SS2)};
    if (IN(7)) {
        for (int it = F.bid; it < 8 * (T / 128); it += F.G) peer_u_item(it >> 3, it & 7, PA, F.lds);
    }
    SEAM(7);
    if (IN(8)) {
        const int tid_ = fresh_tid();
        const long gt = (long)F.bid * 512 + tid_, NGT = (long)F.G * 512;
        const float* plog = (const float*)(ws + WS_PLOG); const float* gwp = (const float*)(ws + WS_GW); float* act = (float*)(ws + WS_ACT);
        for (long i = gt; i < (long)T * 128; i += NGT) {
            const int t = (int)(i >> 7);
            float s = 0.f;
#pragma unroll
            for (int q = 0; q < 8; ++q) s += plog[(size_t)q * T * 128 + i];
            const float rs = pg8::rowscale16((const float*)(ws + WS_SS1), t);
            act[i] = gelu_tanh(s * rs) * gwp[i];
        }
    }
    SEAM(8);
    if (IN(9)) {
        for (int it = F.bid; it < 8 * (T / 128); it += F.G) peer_v_item(it >> 3, it & 7, PA, F.lds);
    }
    SEAM(9);
    if (IN(10)) {
        pg8::Gemm g{(const bf16*)(ws + WS_PB), (const bf16*)(ws + WS_WP), T, 1024, 256}; pg8::StaticOrder S; S.init(T, 1024, F.G, F.bid);
        pg8::EpiScaleBf16 E{(bf16*)(ws + WS_QP), nullptr};
        pg8::gemm_phase<pg8::EpiScaleBf16, pg8::StaticOrder, true, true>(ldsl, g, S, E);
    }
    SEAM(10);
    if (IN(11)) {
        pg8::Gemm g{(const bf16*)(ws + WS_XN), (const bf16*)(ws + WS_WG), T, 1024, 1024}; pg8::StaticOrder S; S.init(T, 1024, F.G, F.bid);
        pg8::EpiPle E{F.a->out, (const bf16*)(ws + WS_QP), (const float*)(ws + WS_SS2), (float*)(ws + WS_SS3)};
        pg8::gemm_phase<pg8::EpiPle, pg8::StaticOrder, true, true>(ldsl, g, S, E);
    }
    SEAM(11);
    if (IN(12)) {
        const int tid_ = fresh_tid(), lane_ = tid_ & 63, wave_ = __builtin_amdgcn_readfirstlane(tid_ >> 6);
        const int gw = F.bid * 8 + wave_, NGW = F.G * 8;
        for (int m = gw; m < T; m += NGW) {
            const float rs = pg8::rowscale16((const float*)(ws + WS_SS3), m);
            f32x4* hr = (f32x4*)(F.a->out + (size_t)m * 1024) + lane_; const f32x4* gr = (const f32x4*)F.a->in[28] + lane_;
#pragma unroll
            for (int j = 0; j < 4; ++j) { const f32x4 v = hr[64 * j], g = gr[64 * j]; hr[64 * j] = v * rs * g; }
        }
    }
#undef IN
#undef SEAM
}

#ifndef MK_MULTI
#define MK_MULTI 0
#endif
constexpr int NPH = 13;
extern "C" void kernel_launch(void* const* d_in, const int* in_sizes, int n_in, void* d_out, int out_size, void* d_ws, size_t ws_size, hipStream_t stream) {
    static int grid = 0;
    if (grid == 0) {
        if (n_in != 29 || out_size != T * DM || ws_size < WS_END) { fprintf(stderr, "kernel_launch: unexpected shapes: n_in %d out %d ws %zu (need %zu)\n", n_in, out_size, ws_size, (size_t)WS_END); grid = -1; return; }
        int dev = 0, cus = 0, per_cu = 0;
        if (hipGetDevice(&dev) != hipSuccess || hipDeviceGetAttribute(&cus, hipDeviceAttributeMultiprocessorCount, dev) != hipSuccess) { grid = -1; return; }
        if (hipFuncSetAttribute((const void*)enc_fwd, hipFuncAttributeMaxDynamicSharedMemorySize, LDS_BYTES) != hipSuccess) { fprintf(stderr, "kernel_launch: hipFuncSetAttribute failed\n"); grid = -1; return; }
        if (hipOccupancyMaxActiveBlocksPerMultiprocessor(&per_cu, (const void*)enc_fwd, 512, LDS_BYTES) != hipSuccess || per_cu < 1) { fprintf(stderr, "kernel_launch: occupancy query says %d\n", per_cu); per_cu = 1; }
        (void)hipGetLastError();
        grid = cus * 1;
    }
    if (grid < 0) return;
    (void)hipMemsetAsync((char*)d_ws + WS_CTL, 0, CTL_ZERO_BYTES, stream);
    Args a{};
    for (int i = 0; i < 29; ++i) a.in[i] = (const float*)d_in[i];
    a.out = (float*)d_out; a.ws = (unsigned char*)d_ws;
#if MK_MULTI
    for (int ph = 0; ph < NPH; ++ph) { a.ph_lo = ph; a.ph_hi = ph + 1; a.coop = 0; hipLaunchKernelGGL(enc_fwd, dim3(grid), dim3(512), LDS_BYTES, stream, a); }
#else
    a.ph_lo = 0; a.ph_hi = NPH; a.coop = 1;
    void* kargs[] = {&a};
    hipError_t e = hipLaunchCooperativeKernel((const void*)enc_fwd, dim3(grid), dim3(512), kargs, LDS_BYTES, stream);
    if (e != hipSuccess) fprintf(stderr, "cooperative launch failed: %s (grid %d)\n", hipGetErrorString(e), grid);
#endif
}
```

```cpp
#include <hip/hip_runtime.h>
#include <hip/hip_cooperative_groups.h>
#include <cstdio>
#include <cstdint>
namespace cg = cooperative_groups;

#ifndef REPMASK
#define REPMASK 0
#endif
constexpr int NB = 8, SEQ = 4096, T = NB * SEQ, DM = 1024, INC = 2560, PLE = 256;
constexpr float EPS = 1e-6f;
constexpr float LAMBDA_INIT = 0.2f;

__device__ __forceinline__ int fresh_tid() { int t = threadIdx.x; asm volatile("" : "+v"(t)); return t; }

namespace pg8 {
#define PG8_LAS __attribute__((address_space(3)))
typedef unsigned short bf16_t;
typedef short bf16x8 __attribute__((ext_vector_type(8)));
typedef float f32x4 __attribute__((ext_vector_type(4)));
typedef unsigned u32x4 __attribute__((ext_vector_type(4)));
constexpr int BM = 256, BK = 64, HALF = 128, HTB = HALF * BK * 2  , STAGE_BYTES = 8 * HTB, NXCD = 8, WGM = 8;

__host__ __device__ __forceinline__ int lds_byte(int r, int c) { const int st = (r >> 4) * 2 + (c >> 5), rr = r & 15, cc = c & 31, ob = rr * 64 + cc * 2; return st * 1024 + (ob ^ (((ob >> 9) & 1) << 5)); }
__host__ __device__ __forceinline__ void stage_rc(int b, int& R, int& C) { const int st = b / 1024, sb = b % 1024, swz = sb ^ (((sb >> 9) & 1) << 5); R = (st >> 1) * 16 + swz / 64; C = (st & 1) * 32 + (swz % 64) / 2; }
__host__ __device__ __forceinline__ int perm32(int rho) { const int n = rho >> 4, i = rho & 15; return 8 * (i >> 2) + 4 * n + (i & 3); }

struct Unit { int pm, pn; };
struct Gemm { const bf16_t* A; const bf16_t* Bt; int M, N, K; };

struct StaticOrder {
    int nM, nN, nwg, G, c;
    __host__ __device__ void init(int M, int N, int G_, int c_) { nM = M / BM; nN = N / BM; nwg = nM * nN; G = G_; c = c_; }
    __host__ __device__ bool next(int i, Unit& u) const {
        const long L = (long)i * G + c; if (L >= nwg) return false;
        int wgid = (int)L; { const int q = nwg / NXCD, r = nwg % NXCD, xcd = wgid % NXCD, off = wgid / NXCD; wgid = (xcd < r ? xcd * (q + 1) : r * (q + 1) + (xcd - r) * q) + off; }
        const int nig = WGM * nN, gid = wgid / nig, fm = gid * WGM, gsz = (nM - fm) < WGM ? (nM - fm) : WGM;
        u.pm = fm + ((wgid % nig) % gsz); u.pn = (wgid % nig) / gsz; return true;
    }
    __device__ __forceinline__ void a_ready(const Unit&) const {}
    __device__ __forceinline__ void done(const Unit&) const {}
};

__device__ __forceinline__ unsigned cvt_pk_bf16(float lo, float hi) { unsigned r; asm volatile("v_cvt_pk_bf16_f32 %0, %1, %2" : "=v"(r) : "v"(lo), "v"(hi)); return r; }
typedef float f32x2 __attribute__((ext_vector_type(2)));
typedef unsigned u32x2 __attribute__((ext_vector_type(2)));
__device__ __forceinline__ float fsigmoid(float z) { return __builtin_amdgcn_rcpf(1.0f + __expf(-z)); }
__device__ __forceinline__ float rowscale_n(const float* ss, int n) { float s = 0.f; for (int i = 0; i < n; ++i) s += ss[i]; return 1.0f / sqrtf(s * (1.0f / 1024.0f) + 1e-6f); }
__device__ __forceinline__ float rowscale16(const float* ss, int row) { const f32x4* p = (const f32x4*)(ss + (size_t)row * 16); const f32x4 a = p[0], b = p[1], c = p[2], d = p[3];
    const float s = ((a[0] + a[1]) + (a[2] + a[3])) + ((b[0] + b[1]) + (b[2] + b[3])) + ((c[0] + c[1]) + (c[2] + c[3])) + ((d[0] + d[1]) + (d[2] + d[3])); return 1.0f / sqrtf(s * (1.0f / 1024.0f) + 1e-6f); }
__device__ __forceinline__ float rowscale8(const float* ss, int row) { const f32x4* p = (const f32x4*)(ss + (size_t)row * 8); const f32x4 a = p[0], b = p[1];
    const float s = ((a[0] + a[1]) + (a[2] + a[3])) + ((b[0] + b[1]) + (b[2] + b[3])); return 1.0f / sqrtf(s * (1.0f / 1024.0f) + 1e-6f); }
__device__ __forceinline__ u32x4 pack8(f32x4 v0, f32x4 v1) { u32x4 w; w.x = cvt_pk_bf16(v0[0], v0[1]); w.y = cvt_pk_bf16(v0[2], v0[3]); w.z = cvt_pk_bf16(v1[0], v1[1]); w.w = cvt_pk_bf16(v1[2], v1[3]); return w; }
__device__ __forceinline__ float bf_lo(unsigned w) { return __uint_as_float(w << 16); }
__device__ __forceinline__ float bf_hi(unsigned w) { return __uint_as_float(w & 0xffff0000u); }

struct EpiProj {
    static constexpr bool PERM = true, AFTER_DRAIN = false;
    bf16_t* base; const float* rope;
    __device__ __forceinline__ void operator()(const f32x4 (&acc)[2][2][4][2], const Unit& u, int wr, int wc, int fr, int fq) const {
        const int region = u.pn >> 1;
        bf16_t* O = base + (size_t)region * ((size_t)32768 * 512);
        const int colb = (u.pn & 1) * 256 + wc * 32 + 8 * fq;
        const bool rot = (region < 2) && ((wc & 1) == 0);
        const float qs = (region == 0) ? 0.125f : 1.0f;
        const float sgn = (fq == 0) ? -1.0f : 1.0f;
#pragma unroll
        for (int ai = 0; ai < 2; ++ai)
#pragma unroll
            for (int m = 0; m < 4; ++m) {
                const int row = u.pm * BM + ai * HALF + wr * 64 + m * 16 + fr;
                f32x4 c0 = {1.f, 1.f, 1.f, 1.f}, c1 = c0, s0 = {0.f, 0.f, 0.f, 0.f}, s1 = s0;
                if (rot) { const f32x4* rp = (const f32x4*)(rope + (size_t)row * 16); c0 = rp[0]; c1 = rp[1]; s0 = rp[2]; s1 = rp[3]; }
#pragma unroll
                for (int bj = 0; bj < 2; ++bj) {
                    f32x4 v0 = acc[ai][bj][m][0], v1 = acc[ai][bj][m][1];
                    if (rot) {
                        f32x4 o0, o1;
#pragma unroll
                        for (int j = 0; j < 4; ++j) { o0[j] = __shfl_xor(v0[j], 16); o1[j] = __shfl_xor(v1[j], 16); }
                        if (fq < 2) { v0 = v0 * c0 + (o0 * s0) * sgn; v1 = v1 * c1 + (o1 * s1) * sgn; }
                    }
                    v0 = v0 * qs; v1 = v1 * qs;
                    *(u32x4*)(O + (size_t)row * 512 + colb + bj * HALF) = pack8(v0, v1);
                }
            }
    }
};
struct EpiResid {
    static constexpr bool PERM = true, AFTER_DRAIN = false;
    const float* X; bf16_t* HB; float* SS;
    __device__ __forceinline__ void operator()(const f32x4 (&acc)[2][2][4][2], const Unit& u, int wr, int wc, int fr, int fq) const {
        const int col0 = u.pn * BM + wc * 32 + 8 * fq;
#pragma unroll
        for (int ai = 0; ai < 2; ++ai)
#pragma unroll
            for (int m = 0; m < 4; ++m) {
                const int row = u.pm * BM + ai * HALF + wr * 64 + m * 16 + fr; float ssq = 0.f;
#pragma unroll
                for (int bj = 0; bj < 2; ++bj) {
                    const size_t off = (size_t)row * 1024 + col0 + bj * HALF;
                    const f32x4 h0 = *(const f32x4*)(X + off) + acc[ai][bj][m][0], h1 = *(const f32x4*)(X + off + 4) + acc[ai][bj][m][1];
                    *(u32x4*)(HB + off) = pack8(h0, h1);
                    ssq += (h0[0] * h0[0] + h0[1] * h0[1]) + (h0[2] * h0[2] + h0[3] * h0[3]) + (h1[0] * h1[0] + h1[1] * h1[1]) + (h1[2] * h1[2] + h1[3] * h1[3]);
                }
                ssq += __shfl_xor(ssq, 16); ssq += __shfl_xor(ssq, 32);
                if (fq == 0) SS[(size_t)row * 16 + u.pn * 4 + wc] = ssq;
            }
    }
};
struct EpiScaleBf16 {
    static constexpr bool PERM = true, AFTER_DRAIN = false;
    bf16_t* O; const float* SS; float* RS;
    __device__ __forceinline__ void operator()(const f32x4 (&acc)[2][2][4][2], const Unit& u, int wr, int wc, int fr, int fq) const {
        const int col0 = u.pn * BM + wc * 32 + 8 * fq;
#pragma unroll
        for (int ai = 0; ai < 2; ++ai)
#pragma unroll
            for (int m = 0; m < 4; ++m) {
                const int row = u.pm * BM + ai * HALF + wr * 64 + m * 16 + fr;
                const float rs = SS ? rowscale16(SS, row) : 1.0f;
                if (RS && u.pn == 0 && wc == 0 && fq == 0) RS[row] = rs;
#pragma unroll
                for (int bj = 0; bj < 2; ++bj) *(u32x4*)(O + (size_t)row * 1024 + col0 + bj * HALF) = pack8(acc[ai][bj][m][0] * rs, acc[ai][bj][m][1] * rs);
            }
    }
};
struct EpiPle {
    static constexpr bool PERM = true, AFTER_DRAIN = false;
    const bf16_t* H2B; bf16_t* H3B; const bf16_t* PP; const float* SS2; float* SS3; float gsc;
    __device__ __forceinline__ void operator()(const f32x4 (&acc)[2][2][4][2], const Unit& u, int wr, int wc, int fr, int fq) const {
        const int col0 = u.pn * BM + wc * 32 + 8 * fq;
#pragma unroll
        for (int ai = 0; ai < 2; ++ai)
#pragma unroll
            for (int m = 0; m < 4; ++m) {
                const int row = u.pm * BM + ai * HALF + wr * 64 + m * 16 + fr; float ssq = 0.f;
                const float rs = rowscale8(SS2, row);
#pragma unroll
                for (int bj = 0; bj < 2; ++bj) {
                    const size_t off = (size_t)row * 1024 + col0 + bj * HALF;
                    const u32x4 pw = *(const u32x4*)(PP + off);
                    const f32x4 p0 = {bf_lo(pw.x), bf_hi(pw.x), bf_lo(pw.y), bf_hi(pw.y)}, p1 = {bf_lo(pw.z), bf_hi(pw.z), bf_lo(pw.w), bf_hi(pw.w)};
                    f32x4 g0, g1;
#pragma unroll
                    for (int j = 0; j < 4; ++j) { g0[j] = fsigmoid(acc[ai][bj][m][0][j] * rs); g1[j] = fsigmoid(acc[ai][bj][m][1][j] * rs); }
                    const u32x4 hw = *(const u32x4*)(H2B + off);
                    const f32x4 r0 = {bf_lo(hw.x), bf_hi(hw.x), bf_lo(hw.y), bf_hi(hw.y)}, r1 = {bf_lo(hw.z), bf_hi(hw.z), bf_lo(hw.w), bf_hi(hw.w)};
                    const f32x4 h0 = r0 + g0 * p0 * gsc, h1 = r1 + g1 * p1 * gsc;
                    *(u32x4*)(H3B + off) = pack8(h0, h1);
                    ssq += (h0[0] * h0[0] + h0[1] * h0[1]) + (h0[2] * h0[2] + h0[3] * h0[3]) + (h1[0] * h1[0] + h1[1] * h1[1]) + (h1[2] * h1[2] + h1[3] * h1[3]);
                }
                ssq += __shfl_xor(ssq, 16); ssq += __shfl_xor(ssq, 32);
                if (fq == 0) SS3[(size_t)row * 16 + u.pn * 4 + wc] = ssq;
            }
    }
};

template <class Epi, class Sched, bool ALIGN_EPI = false, bool SP2 = false>
__device__ __forceinline__ void gemm_phase(PG8_LAS unsigned char* lds, const Gemm g, const Sched& S, const Epi& E) {
    const int tid = fresh_tid(), wid = __builtin_amdgcn_readfirstlane(tid >> 6), lane = tid & 63, wr = wid >> 2, wc = wid & 3, fr = lane & 15, fq = lane >> 4;
    const int K = g.K, nt = K / BK;
    unsigned voffA[2], voffB[2];
#pragma unroll
    for (int i = 0; i < 2; ++i) { int R, C; stage_rc(tid * 16 + i * 8192, R, C); const int Rb = Epi::PERM ? ((R & ~31) + perm32(R & 31)) : R;
        voffA[i] = (unsigned)(R * K + C) * 2u; voffB[i] = (unsigned)(Rb * K + C) * 2u; }
    const size_t kstep = (size_t)(BK * 2);
    const size_t hstep = (size_t)HALF * K * 2;
    const size_t tstep = 2 * hstep;
    const unsigned ldsw = (unsigned)wid * 1024u;
    const int aoff = lds_byte(wr * 64 + fr, fq * 8), boff = lds_byte(wc * 32 + fr, fq * 8);
#define PG8_SA(b, h) (((b) * 2 + (h)) * HTB)
#define PG8_SB(b, h) ((4 + (b) * 2 + (h)) * HTB)
#define PG8_STAGE(bufoff, gbase, voff) do { _Pragma("unroll") for (int _i = 0; _i < 2; ++_i) \
        __builtin_amdgcn_global_load_lds((const unsigned*)((const char*)(gbase) + (voff)[_i]), (PG8_LAS unsigned*)(lds + (bufoff) + ldsw + _i * 8192), 16, 0, 0); } while (0)
#define PG8_LDA(dst, b, h) do { _Pragma("unroll") for (int m = 0; m < 4; ++m) _Pragma("unroll") for (int k = 0; k < 2; ++k) dst[m][k] = *(const PG8_LAS bf16x8*)(lds + PG8_SA(b, h) + aoff + m * 2048 + k * 1024); } while (0)
#define PG8_LDB(dst, b, h) do { _Pragma("unroll") for (int n = 0; n < 2; ++n) _Pragma("unroll") for (int k = 0; k < 2; ++k) dst[n][k] = *(const PG8_LAS bf16x8*)(lds + PG8_SB(b, h) + boff + n * 2048 + k * 1024); } while (0)
#define PG8_MMA(ai, bj, At, Bt) do { __builtin_amdgcn_s_setprio(1); _Pragma("unroll") for (int m = 0; m < 4; ++m) _Pragma("unroll") for (int n = 0; n < 2; ++n) _Pragma("unroll") for (int k = 0; k < 2; ++k) \
        acc[ai][bj][m][n] = __builtin_amdgcn_mfma_f32_16x16x32_bf16(Bt[n][k], At[m][k], acc[ai][bj][m][n], 0, 0, 0); __builtin_amdgcn_s_setprio(0); } while (0)
#define PG8_WAIT_V(n) asm volatile("s_waitcnt vmcnt(" #n ")" ::: "memory")
#define PG8_WAIT_L(n) asm volatile("s_waitcnt lgkmcnt(" #n ")" ::: "memory")
#define PG8_BAR __builtin_amdgcn_s_barrier()
#define PG8_SCHED __builtin_amdgcn_sched_barrier(0)
    Unit cur, nxt; int ui = 0;
    if (!S.next(0, cur)) return;
    f32x4 acc[2][2][4][2];
#pragma unroll
    for (int a = 0; a < 2; ++a)
#pragma unroll
        for (int b = 0; b < 2; ++b)
#pragma unroll
            for (int m = 0; m < 4; ++m)
#pragma unroll
                for (int n = 0; n < 2; ++n) acc[a][b][m][n] = (f32x4){0.f, 0.f, 0.f, 0.f};
    bf16x8 At[4][2], B0[2][2], B1[2][2];
    const char* cA = (const char*)g.A + (size_t)cur.pm * tstep; const char* cB = (const char*)g.Bt + (size_t)cur.pn * tstep;
    S.a_ready(cur);
    if constexpr (SP2) {
        PG8_STAGE(PG8_SB(0, 0), cB, voffB); PG8_STAGE(PG8_SB(0, 1), cB + hstep, voffB); PG8_STAGE(PG8_SA(0, 0), cA, voffA); PG8_STAGE(PG8_SA(0, 1), cA + hstep, voffA);
        if (wr == 1) PG8_BAR;
        PG8_WAIT_V(2); PG8_BAR;
        PG8_STAGE(PG8_SB(1, 0), cB + kstep, voffB); PG8_STAGE(PG8_SA(1, 0), cA + kstep, voffA); PG8_STAGE(PG8_SB(1, 1), cB + hstep + kstep, voffB);
        PG8_WAIT_V(6); PG8_BAR;
    } else {
        PG8_STAGE(PG8_SB(0, 0), cB, voffB); PG8_STAGE(PG8_SA(0, 0), cA, voffA); PG8_STAGE(PG8_SB(0, 1), cB + hstep, voffB); PG8_STAGE(PG8_SA(0, 1), cA + hstep, voffA);
        if (wr == 1) PG8_BAR;
        PG8_WAIT_V(4); PG8_BAR;
        PG8_STAGE(PG8_SB(1, 0), cB + kstep, voffB); PG8_STAGE(PG8_SA(1, 0), cA + kstep, voffA); PG8_STAGE(PG8_SB(1, 1), cB + hstep + kstep, voffB);
        PG8_WAIT_V(6); PG8_BAR;
    }
    for (;;) {
        const bool has_next = S.next(ui + 1, nxt);
        const char* nA = has_next ? (const char*)g.A + (size_t)nxt.pm * tstep : cA; const char* nB = has_next ? (const char*)g.Bt + (size_t)nxt.pn * tstep : cB;
        for (int t = 0; t < nt; t += 2) {
            const bool last = (t == nt - 2);
            const char* a1 = cA + (size_t)(t + 1) * kstep;
            const char* a2 = last ? nA : cA + (size_t)(t + 2) * kstep; const char* b2 = last ? nB : cB + (size_t)(t + 2) * kstep;
            const char* a3 = a2 + kstep; const char* b3 = b2 + kstep;
            if (last && has_next) S.a_ready(nxt);
            if constexpr (SP2) {
            PG8_LDB(B0, 0, 0); PG8_LDB(B1, 0, 1); PG8_SCHED; PG8_LDA(At, 0, 0); PG8_STAGE(PG8_SA(1, 1), a1 + hstep, voffA);
            PG8_WAIT_V(8); PG8_WAIT_L(0); PG8_BAR; PG8_MMA(0, 0, At, B0); PG8_MMA(0, 1, At, B1); PG8_BAR; PG8_SCHED;
            PG8_LDA(At, 0, 1); PG8_STAGE(PG8_SB(0, 0), b2, voffB); PG8_STAGE(PG8_SB(0, 1), b2 + hstep, voffB); PG8_STAGE(PG8_SA(0, 0), a2, voffA);
            PG8_WAIT_V(8); PG8_WAIT_L(0); PG8_BAR; PG8_MMA(1, 0, At, B0); PG8_MMA(1, 1, At, B1); PG8_BAR; PG8_SCHED;
            PG8_LDB(B0, 1, 0); PG8_LDB(B1, 1, 1); PG8_SCHED; PG8_LDA(At, 1, 0); PG8_STAGE(PG8_SA(0, 1), a2 + hstep, voffA);
            PG8_WAIT_V(8); PG8_WAIT_L(0); PG8_BAR; PG8_MMA(0, 0, At, B0); PG8_MMA(0, 1, At, B1); PG8_BAR; PG8_SCHED;
            PG8_LDA(At, 1, 1); PG8_STAGE(PG8_SB(1, 0), b3, voffB); PG8_STAGE(PG8_SB(1, 1), b3 + hstep, voffB); PG8_STAGE(PG8_SA(1, 0), a3, voffA);
            PG8_WAIT_V(8); PG8_WAIT_L(0); PG8_BAR; PG8_MMA(1, 0, At, B0); PG8_MMA(1, 1, At, B1); PG8_BAR; PG8_SCHED;
            } else {
            PG8_LDB(B0, 0, 0); PG8_SCHED; PG8_LDA(At, 0, 0); PG8_STAGE(PG8_SA(1, 1), a1 + hstep, voffA);
            PG8_WAIT_L(8); PG8_BAR; PG8_WAIT_L(0); PG8_MMA(0, 0, At, B0); PG8_BAR; PG8_SCHED;
            PG8_LDB(B1, 0, 1); PG8_STAGE(PG8_SB(0, 0), b2, voffB);
            PG8_BAR; PG8_WAIT_L(0); PG8_MMA(0, 1, At, B1); PG8_BAR;
            PG8_LDA(At, 0, 1); PG8_STAGE(PG8_SA(0, 0), a2, voffA);
            PG8_BAR; PG8_WAIT_L(0); PG8_MMA(1, 0, At, B0); PG8_BAR; PG8_SCHED;
            PG8_STAGE(PG8_SB(0, 1), b2 + hstep, voffB);
            PG8_WAIT_V(6); PG8_BAR; PG8_MMA(1, 1, At, B1); PG8_BAR;
            PG8_LDB(B0, 1, 0); PG8_SCHED; PG8_LDA(At, 1, 0); PG8_STAGE(PG8_SA(0, 1), a2 + hstep, voffA);
            PG8_WAIT_L(8); PG8_BAR; PG8_WAIT_L(0); PG8_MMA(0, 0, At, B0); PG8_BAR; PG8_SCHED;
            PG8_LDB(B1, 1, 1); PG8_STAGE(PG8_SB(1, 0), b3, voffB);
            PG8_BAR; PG8_WAIT_L(0); PG8_MMA(0, 1, At, B1); PG8_BAR;
            PG8_LDA(At, 1, 1); PG8_STAGE(PG8_SA(1, 0), a3, voffA);
            PG8_BAR; PG8_WAIT_L(0); PG8_MMA(1, 0, At, B0); PG8_BAR; PG8_SCHED;
            PG8_STAGE(PG8_SB(1, 1), b3 + hstep, voffB);
            PG8_WAIT_V(6); PG8_BAR; PG8_MMA(1, 1, At, B1); PG8_BAR;
            }
        }
        if constexpr (ALIGN_EPI) { if (wr == 0) PG8_BAR; }
        if constexpr (!Epi::AFTER_DRAIN) { E(acc, cur, wr, wc, fr, fq); S.done(cur); }
        if (!has_next) break;
#pragma unroll
        for (int a = 0; a < 2; ++a)
#pragma unroll
            for (int b = 0; b < 2; ++b)
#pragma unroll
                for (int m = 0; m < 4; ++m)
#pragma unroll
                    for (int n = 0; n < 2; ++n) acc[a][b][m][n] = (f32x4){0.f, 0.f, 0.f, 0.f};
        cur = nxt; cA = nA; cB = nB; ++ui;
        if constexpr (ALIGN_EPI) { if (wr == 1) PG8_BAR; }
    }
    PG8_WAIT_V(0);
    if constexpr (!ALIGN_EPI) { if (wr == 0) PG8_BAR; }
    PG8_BAR;
    if constexpr (Epi::AFTER_DRAIN) { E.fused(acc, cur, wr, wc, fr, fq, lds, wid, lane); S.done(cur); }
#undef PG8_SA
#undef PG8_SB
#undef PG8_STAGE
#undef PG8_LDA
#undef PG8_LDB
#undef PG8_MMA
#undef PG8_WAIT_V
#undef PG8_WAIT_L
#undef PG8_BAR
#undef PG8_SCHED
}
}
namespace att {
using bf16x8 = __attribute__((ext_vector_type(8))) short;
using s16x4  = __attribute__((ext_vector_type(4))) short;
using f32x16 = __attribute__((ext_vector_type(16))) float;
using f32x4  = __attribute__((ext_vector_type(4))) float;
using u32x4  = __attribute__((ext_vector_type(4))) unsigned;
constexpr int NW = 8, QBLK = 32, KVBLK = 64, LDK = 512;
constexpr float THR = 8.f;
constexpr size_t SHM_V = KVBLK * 128 * 2, SHM_K = KVBLK * 128 * 2;
constexpr int OST_OFF = 69632, OST_LD = 132;
#define KSWZ(row, colB) ((row) * 256 + ((colB) ^ (((row) & 7) << 4)))
#define SBAR() __builtin_amdgcn_sched_barrier(0)
__device__ __forceinline__ int crow(int r, int hi) { return (r & 3) + 8 * (r >> 2) + 4 * hi; }
__device__ __forceinline__ unsigned cvtpk(float lo, float hi) { unsigned r; asm volatile("v_cvt_pk_bf16_f32 %0, %1, %2" : "=v"(r) : "v"(lo), "v"(hi)); return r; }

__device__ __forceinline__ void partialSM(f32x16& p0, f32x16& p1, float& m_reg, float& mn, float& alpha) {
  constexpr float C = 1.4426950408889634f;
  float pmax = p0[0];
#pragma unroll
  for (int r = 1; r < 16; ++r) pmax = fmaxf(pmax, p0[r]);
#pragma unroll
  for (int r = 0; r < 16; ++r) pmax = fmaxf(pmax, p1[r]);
  { auto rr = __builtin_amdgcn_permlane32_swap(__float_as_uint(pmax), __float_as_uint(pmax), false, false);
    pmax = fmaxf(__uint_as_float(rr[0]), __uint_as_float(rr[1])); }
  if (__builtin_expect(__all(pmax - m_reg <= THR), 1)) { mn = m_reg; alpha = 1.f; }
  else { mn = fmaxf(m_reg, pmax); alpha = __builtin_amdgcn_exp2f((m_reg - mn) * C); m_reg = mn; }
  float mnC = -mn * C;
#pragma unroll
  for (int r = 0; r < 16; ++r) p0[r] = fmaf(p0[r], C, mnC);
#pragma unroll
  for (int r = 0; r < 16; ++r) p1[r] = fmaf(p1[r], C, mnC);
#pragma unroll
  for (int r = 0; r < 16; ++r) p0[r] = __builtin_amdgcn_exp2f(p0[r]);
}
__device__ __forceinline__ void finishSM(f32x16& p0, f32x16& p1, float alpha, float& l_reg, bf16x8& pa0, bf16x8& pa1, bf16x8& pa2, bf16x8& pa3) {
#pragma unroll
  for (int r = 0; r < 16; ++r) p1[r] = __builtin_amdgcn_exp2f(p1[r]);
  float ps = 0;
#pragma unroll
  for (int r = 0; r < 16; ++r) ps += p0[r];
#pragma unroll
  for (int r = 0; r < 16; ++r) ps += p1[r];
  { auto rr = __builtin_amdgcn_permlane32_swap(__float_as_uint(ps), __float_as_uint(ps), false, false);
    ps = __uint_as_float(rr[0]) + __uint_as_float(rr[1]); }
  l_reg = l_reg * alpha + ps;
#define PK4(P, BASE, OUT) do { unsigned a0 = cvtpk(P[BASE + 0], P[BASE + 1]), a1 = cvtpk(P[BASE + 2], P[BASE + 3]);   \
    unsigned b0 = cvtpk(P[BASE + 4], P[BASE + 5]), b1 = cvtpk(P[BASE + 6], P[BASE + 7]);                              \
    auto r0 = __builtin_amdgcn_permlane32_swap(a0, b0, false, false); auto r1 = __builtin_amdgcn_permlane32_swap(a1, b1, false, false); \
    u32x4 w = {r0[0], r1[0], r0[1], r1[1]}; OUT = *reinterpret_cast<bf16x8*>(&w); } while (0)
  PK4(p0, 0, pa0); PK4(p0, 8, pa1); PK4(p1, 0, pa2); PK4(p1, 8, pa3);
#undef PK4
}
__device__ __forceinline__ void qkt(f32x16& p0, f32x16& p1, const char* Ks, const bf16x8* qr, int r32, int hi, int mcolB) {
  p0 = f32x16{}; p1 = f32x16{};
#pragma unroll
  for (int d0 = 0; d0 < 4; ++d0) { int cb = mcolB + (d0 * 16 + hi * 8) * 2;
    bf16x8 b0 = *reinterpret_cast<const bf16x8*>(Ks + KSWZ(r32, cb));
    bf16x8 b1 = *reinterpret_cast<const bf16x8*>(Ks + KSWZ(32 + r32, cb));
    p0 = __builtin_amdgcn_mfma_f32_32x32x16_bf16(b0, qr[d0], p0, 0, 0, 0);
    p1 = __builtin_amdgcn_mfma_f32_32x32x16_bf16(b1, qr[d0], p1, 0, 0, 0); }
}
__device__ __forceinline__ int v_st(int k, int c) { const int kk = (k & ~0xC) | ((k & 4) << 1) | ((k & 8) >> 1); return ((kk >> 3) * 4 + (c >> 5)) * 512 + ((kk & 7) * 32 + (c & 31)) * 2; }
__device__ __forceinline__ int v_rd_base(int lane) { return ((lane & 3) << 3) | (((lane >> 2) & 3) << 6) | (((lane >> 4) & 1) << 5) | (((lane >> 5) & 1) << 8); }
constexpr int v_rd_off(int d0, int ks, int half) { return d0 * 512 + ks * 4096 + half * 2048; }
template <int OFF> __device__ __forceinline__ s16x4 tr_read(int vb) {
  s16x4 r; asm volatile("ds_read_b64_tr_b16 %0, %1 offset:%2" : "=&v"(r) : "v"(vb), "i"(OFF) : "memory"); return r;
}
template <int D0> __device__ __forceinline__ void pv_one(f32x16& od, int vb, bf16x8 pa0, bf16x8 pa1, bf16x8 pa2, bf16x8 pa3) {
  const s16x4 l0 = tr_read<v_rd_off(D0, 0, 0)>(vb), h0 = tr_read<v_rd_off(D0, 0, 1)>(vb), l1 = tr_read<v_rd_off(D0, 1, 0)>(vb), h1 = tr_read<v_rd_off(D0, 1, 1)>(vb);
  const s16x4 l2 = tr_read<v_rd_off(D0, 2, 0)>(vb), h2 = tr_read<v_rd_off(D0, 2, 1)>(vb), l3 = tr_read<v_rd_off(D0, 3, 0)>(vb), h3 = tr_read<v_rd_off(D0, 3, 1)>(vb);
  asm volatile("s_waitcnt lgkmcnt(0)" ::: "memory"); SBAR();
#define PK(L, H) (bf16x8){L[0], L[1], L[2], L[3], H[0], H[1], H[2], H[3]}
  od = __builtin_amdgcn_mfma_f32_32x32x16_bf16(pa0, PK(l0, h0), od, 0, 0, 0);
  od = __builtin_amdgcn_mfma_f32_32x32x16_bf16(pa1, PK(l1, h1), od, 0, 0, 0);
  od = __builtin_amdgcn_mfma_f32_32x32x16_bf16(pa2, PK(l2, h2), od, 0, 0, 0);
  od = __builtin_amdgcn_mfma_f32_32x32x16_bf16(pa3, PK(l3, h3), od, 0, 0, 0);
#undef PK
}
__device__ __forceinline__ void pv_d0(f32x16* o, int vb, bf16x8 pa0, bf16x8 pa1, bf16x8 pa2, bf16x8 pa3) {
  pv_one<0>(o[0], vb, pa0, pa1, pa2, pa3); pv_one<1>(o[1], vb, pa0, pa1, pa2, pa3); pv_one<2>(o[2], vb, pa0, pa1, pa2, pa3); pv_one<3>(o[3], vb, pa0, pa1, pa2, pa3);
}

__device__ __forceinline__ void attn_unit(int b, int h, int qb, const unsigned short* __restrict__ Qb, const unsigned short* __restrict__ Kb, const unsigned short* __restrict__ Vb,
                                          unsigned short* __restrict__ MX, const float* __restrict__ gdn, float lam, char* lds) {
  constexpr int SDEPTH = 1;
  const int tid = fresh_tid(), wid = tid >> 6, lane = tid & 63, r32 = lane & 31, hi = lane >> 5;
  const int mp = wid >> 2, qg = wid & 3;
  char* V_lds = lds; char* K_lds = lds + 2 * SHM_V;
  float* ws = (float*)(lds + 2 * SHM_V + 2 * SHM_K) + wid * 64; float* li_l = ws; float* al_l = ws + 32;
  float m_reg = -1e30f, l_reg = 0; f32x16 o[4] = {}; bf16x8 qr[4];
  const long tok0 = (long)b * 4096;
  const unsigned short* Qw = Qb + (tok0 + qb * 128 + qg * QBLK + r32) * LDK + h * 128 + mp * 64 + hi * 8;
#pragma unroll
  for (int d0 = 0; d0 < 4; ++d0) qr[d0] = *reinterpret_cast<const bf16x8*>(Qw + d0 * 16);
  const unsigned short* Kh = Kb + tok0 * LDK + h * 128; const unsigned short* Vh = Vb + tok0 * LDK + h * 128;
  const int sr = tid >> 4, sc = (tid & 15) * 8, vst0 = v_st(sr, sc), vst1 = v_st(32 + sr, sc);
  const int vb0 = (int)(uintptr_t)V_lds + v_rd_base(lane);
  const int mcolB = mp * 128;
  struct { bf16x8 vs0, vs1, ks0, ks1; } sr_[SDEPTH];
#define SLOAD(i, k0) do { sr_[i].vs0 = *reinterpret_cast<const bf16x8*>(&Vh[(long)((k0) + sr) * LDK + sc]); sr_[i].vs1 = *reinterpret_cast<const bf16x8*>(&Vh[(long)((k0) + 32 + sr) * LDK + sc]); \
    sr_[i].ks0 = *reinterpret_cast<const bf16x8*>(&Kh[(long)((k0) + sr) * LDK + sc]); sr_[i].ks1 = *reinterpret_cast<const bf16x8*>(&Kh[(long)((k0) + 32 + sr) * LDK + sc]); } while (0)
#define SWRITE(bb, i) do { *(bf16x8*)(V_lds + (bb) * SHM_V + vst0) = sr_[i].vs0;          \
    *(bf16x8*)(V_lds + (bb) * SHM_V + vst1) = sr_[i].vs1; int kc = sc * 2;               \
    *(bf16x8*)(K_lds + (bb) * SHM_K + KSWZ(sr, kc)) = sr_[i].ks0;                       \
    *(bf16x8*)(K_lds + (bb) * SHM_K + KSWZ(32 + sr, kc)) = sr_[i].ks1; } while (0)
#define SWAIT() do { if constexpr (SDEPTH == 2) asm volatile("s_waitcnt vmcnt(4)" ::: "memory"); else asm volatile("s_waitcnt vmcnt(0)" ::: "memory"); } while (0)
#define RESC(a) do { if (__any((a) < 1.f)) { if (hi == 0) al_l[r32] = (a); asm volatile("s_waitcnt lgkmcnt(0)" ::: "memory"); \
    _Pragma("unroll") for (int d = 0; d < 4; ++d) _Pragma("unroll") for (int r = 0; r < 16; ++r) o[d][r] *= al_l[crow(r, hi)]; } } while (0)
  f32x16 pA0, pA1, pB0, pB1; float mnA, mnB, alA, alB; bf16x8 pa0, pa1, pa2, pa3; const int NT = 4096 / KVBLK;
  constexpr int SE = 0, SO = SDEPTH - 1;
  SLOAD(SE, 0); asm volatile("s_waitcnt vmcnt(0)" ::: "memory"); SWRITE(0, SE); __syncthreads();
  qkt(pA0, pA1, K_lds, qr, r32, hi, mcolB); partialSM(pA0, pA1, m_reg, mnA, alA);
  SLOAD(SO, KVBLK); if constexpr (SDEPTH == 2) SLOAD(SE, 2 * KVBLK);
  SWAIT(); SWRITE(1, SO); __syncthreads();
  for (int j = 1; j + 1 < NT; j += 2) {
    SBAR(); qkt(pB0, pB1, K_lds + SHM_K, qr, r32, hi, mcolB);
    finishSM(pA0, pA1, alA, l_reg, pa0, pa1, pa2, pa3); SBAR();
    SLOAD(SO, (j + SDEPTH) * KVBLK); SBAR();
    pv_d0(o, vb0, pa0, pa1, pa2, pa3); partialSM(pB0, pB1, m_reg, mnB, alB);
    __syncthreads(); SWAIT(); SWRITE(0, SE);
    RESC(alB); __syncthreads();
    SBAR(); qkt(pA0, pA1, K_lds, qr, r32, hi, mcolB);
    finishSM(pB0, pB1, alB, l_reg, pa0, pa1, pa2, pa3); SBAR();
    if (SDEPTH == 1 || j + 3 < NT) SLOAD(SE, (j + 1 + SDEPTH) * KVBLK); SBAR();
    pv_d0(o, vb0 + (int)SHM_V, pa0, pa1, pa2, pa3); partialSM(pA0, pA1, m_reg, mnA, alA);
    __syncthreads(); SWAIT(); SWRITE(1, SO);
    RESC(alA); __syncthreads();
  }
  SBAR(); qkt(pB0, pB1, K_lds + SHM_K, qr, r32, hi, mcolB);
  finishSM(pA0, pA1, alA, l_reg, pa0, pa1, pa2, pa3); SBAR();
  pv_d0(o, vb0, pa0, pa1, pa2, pa3); partialSM(pB0, pB1, m_reg, mnB, alB);
  __syncthreads(); RESC(alB);
  finishSM(pB0, pB1, alB, l_reg, pa0, pa1, pa2, pa3); SBAR();
  pv_d0(o, vb0 + (int)SHM_V, pa0, pa1, pa2, pa3);
  if (hi == 0) li_l[r32] = l_reg; asm volatile("s_waitcnt lgkmcnt(0)" ::: "memory");
  float rli[16];
#pragma unroll
  for (int r = 0; r < 16; ++r) rli[r] = __builtin_amdgcn_rcpf(li_l[crow(r, hi)]);
  float* Ost = (float*)(lds + OST_OFF);
  const int rowb = 32 * qg;
  if (mp == 1) {
#pragma unroll
    for (int r = 0; r < 16; ++r)
#pragma unroll
      for (int d0 = 0; d0 < 4; ++d0) Ost[(rowb + crow(r, hi)) * OST_LD + d0 * 32 + r32] = lam * (o[d0][r] * rli[r]);
  }
  __syncthreads();
  if (mp == 0) {
#pragma unroll
    for (int r = 0; r < 16; ++r)
#pragma unroll
      for (int d0 = 0; d0 < 4; ++d0) { const int ix = (rowb + crow(r, hi)) * OST_LD + d0 * 32 + r32; Ost[ix] = o[d0][r] * rli[r] - Ost[ix]; }
  }
  __syncthreads();
  {
    const int row = 16 * wid + (lane >> 2), cb = (lane & 3) * 32;
    f32x4 v[8]; float ss = 0.f;
#pragma unroll
    for (int i = 0; i < 8; ++i) { v[i] = *(const f32x4*)&Ost[row * OST_LD + cb + 4 * i]; ss += (v[i][0] * v[i][0] + v[i][1] * v[i][1]) + (v[i][2] * v[i][2] + v[i][3] * v[i][3]); }
    ss += __shfl_xor(ss, 1); ss += __shfl_xor(ss, 2);
    const float scl = (1.0f - 0.2f) / sqrtf(ss * (1.0f / 128.0f) + 1e-6f);
    unsigned short* op = MX + (tok0 + qb * 128 + row) * 1024 + h * 128 + cb;
#pragma unroll
    for (int i = 0; i < 4; ++i) {
      const f32x4 g0 = *(const f32x4*)(gdn + cb + 8 * i), g1 = *(const f32x4*)(gdn + cb + 8 * i + 4);
      const f32x4 a = v[2 * i] * g0 * scl, c = v[2 * i + 1] * g1 * scl;
      u32x4 w = {cvtpk(a[0], a[1]), cvtpk(a[2], a[3]), cvtpk(c[0], c[1]), cvtpk(c[2], c[3])};
      *(u32x4*)(op + 8 * i) = w;
    }
  }
  __syncthreads();
#undef SLOAD
#undef SWRITE
#undef SWAIT
#undef RESC
}
#undef KSWZ
#undef SBAR
}

#define LAS __attribute__((address_space(3)))
typedef unsigned short bf16;
typedef float f32x4 __attribute__((ext_vector_type(4)));
typedef float f32x16 __attribute__((ext_vector_type(16)));
typedef short bf16x8 __attribute__((ext_vector_type(8)));
typedef unsigned u32x4 __attribute__((ext_vector_type(4)));
typedef unsigned u32x2 __attribute__((ext_vector_type(2)));
__device__ __forceinline__ unsigned f2bf(float f) { unsigned u = __builtin_bit_cast(unsigned, f); return (u + 0x7fffu + ((u >> 16) & 1u)) >> 16; }
__device__ __forceinline__ unsigned pk2(float lo, float hi) { return f2bf(lo) | (f2bf(hi) << 16); }
__device__ __forceinline__ float bflo(unsigned w) { return __uint_as_float(w << 16); }
__device__ __forceinline__ float bfhi(unsigned w) { return __uint_as_float(w & 0xffff0000u); }
__device__ __forceinline__ float bf1(unsigned short h) { return __uint_as_float(((unsigned)h) << 16); }
__device__ __forceinline__ float sigm(float z) { return __builtin_amdgcn_rcpf(1.0f + __expf(-z)); }
__device__ __forceinline__ float gelu_tanh(float x) { return x * sigm(1.5957691216057308f * (x + 0.044715f * x * x * x)); }
__device__ __forceinline__ float wave_sum(float v) {
#pragma unroll
    for (int o = 1; o < 64; o <<= 1) v += __shfl_xor(v, o);
    return v;
}
__device__ __forceinline__ int crow16(int r, int hi) { return (r & 3) + 8 * (r >> 2) + 4 * hi; }

struct LruArgs { const bf16* LIN; const float* conv_w; const float* conv_b; const bf16* LWT; const float* ba; const float* bx; const float* lam; bf16* HOUT; };
__device__ __forceinline__ void lru_item(int b, int n, int dir, int hh, const LruArgs& A, char* lds) {
    const int tid = fresh_tid(), wid = tid >> 6, lane = tid & 63, r32 = lane & 31, hi = lane >> 5;
    bf16* ucs = (bf16*)lds; float* als = (float*)(lds + 18432); float* mls = (float*)(lds + 34816); float* ils = (float*)(lds + 51200);
    float* cA = (float*)(lds + 67584); float* cH = (float*)(lds + 69632); float* cw = (float*)(lds + 71680);
    const bool fwd = (dir == 0);
    if (tid < 256) cw[tid] = A.conv_w[(tid >> 6) * 512 + n * 64 + (tid & 63)];
    else if (tid < 320) cw[tid] = A.conv_b[n * 64 + (tid - 256)];
    const int rt = wid >> 1, gate = wid & 1;
    bf16x8 wf[4];
    {
        const bf16* wp = A.LWT + ((size_t)((dir * 8 + n) * 2 + gate) * 64 + hh * 32 + r32) * 64 + hi * 8;
#pragma unroll
        for (int ks = 0; ks < 4; ++ks) wf[ks] = *(const bf16x8*)(wp + ks * 16);
    }
    const int cg_ = hh * 32 + r32;
    const float bias = gate ? A.bx[dir * 512 + n * 64 + cg_] : A.ba[dir * 512 + n * 64 + cg_];
    const float spv = -8.0f * log1pf(__expf(-A.lam[dir * 512 + n * 64 + cg_]));
    float state = 0.f;
    const long tokb = (long)b * 4096;
    const int tt = tid >> 2, c0 = (tid & 3) * 16;
    u32x4 in0[4], in1[4];
#define LRU_LOAD(T0) do { _Pragma("unroll") for (int j = 0; j < 4; ++j) { const int s_ = (T0) + tt + j - 2; const bool ok_ = (s_ >= 0 && s_ < 4096); const int sc_ = ok_ ? s_ : 0; \
        in0[j] = *(const u32x4*)(A.LIN + (tokb + sc_) * 512 + n * 64 + c0); in1[j] = *(const u32x4*)(A.LIN + (tokb + sc_) * 512 + n * 64 + c0 + 8); \
        if (!ok_) { in0[j] = (u32x4){0u, 0u, 0u, 0u}; in1[j] = (u32x4){0u, 0u, 0u, 0u}; } } } while (0)
    LRU_LOAD((fwd ? 0 : 31) * 128);
    __syncthreads();
    for (int ci = 0; ci < 32; ++ci) {
        const int t0 = (fwd ? ci : 31 - ci) * 128;
        {
            float accv[16];
#pragma unroll
            for (int i = 0; i < 16; ++i) accv[i] = cw[256 + c0 + i];
#pragma unroll
            for (int j = 0; j < 4; ++j) {
                const u32x4 w0 = in0[j], w1 = in1[j];
                const float* cwj = cw + j * 64 + c0;
                accv[0] += bflo(w0.x) * cwj[0]; accv[1] += bfhi(w0.x) * cwj[1]; accv[2] += bflo(w0.y) * cwj[2]; accv[3] += bfhi(w0.y) * cwj[3];
                accv[4] += bflo(w0.z) * cwj[4]; accv[5] += bfhi(w0.z) * cwj[5]; accv[6] += bflo(w0.w) * cwj[6]; accv[7] += bfhi(w0.w) * cwj[7];
                accv[8] += bflo(w1.x) * cwj[8]; accv[9] += bfhi(w1.x) * cwj[9]; accv[10] += bflo(w1.y) * cwj[10]; accv[11] += bfhi(w1.y) * cwj[11];
                accv[12] += bflo(w1.z) * cwj[12]; accv[13] += bfhi(w1.z) * cwj[13]; accv[14] += bflo(w1.w) * cwj[14]; accv[15] += bfhi(w1.w) * cwj[15];
            }
            u32x4 o0 = {pk2(accv[0], accv[1]), pk2(accv[2], accv[3]), pk2(accv[4], accv[5]), pk2(accv[6], accv[7])};
            u32x4 o1 = {pk2(accv[8], accv[9]), pk2(accv[10], accv[11]), pk2(accv[12], accv[13]), pk2(accv[14], accv[15])};
            *(u32x4*)(ucs + tt * 72 + c0) = o0; *(u32x4*)(ucs + tt * 72 + c0 + 8) = o1;
        }
        if (ci < 31) LRU_LOAD((fwd ? ci + 1 : 30 - ci) * 128);
        __syncthreads();
        {
            f32x16 dg = {};
#pragma unroll
            for (int ks = 0; ks < 4; ++ks) {
                const bf16x8 af = *(const bf16x8*)(ucs + (rt * 32 + r32) * 72 + ks * 16 + hi * 8);
                dg = __builtin_amdgcn_mfma_f32_32x32x16_bf16(af, wf[ks], dg, 0, 0, 0);
            }
            if (gate == 0) {
#pragma unroll
                for (int r = 0; r < 16; ++r) { const int tk = rt * 32 + crow16(r, hi); const float rr = sigm(dg[r] + bias), av = __expf(spv * rr); als[tk * 32 + r32] = av; mls[tk * 32 + r32] = sqrtf(fmaxf(1.0f - av * av, 0.f)); }
            } else {
#pragma unroll
                for (int r = 0; r < 16; ++r) { const int tk = rt * 32 + crow16(r, hi); const float ii = sigm(dg[r] + bias); ils[tk * 32 + r32] = ii * bf1(ucs[tk * 72 + cg_]); }
            }
        }
        __syncthreads();
        {
            const int c = tid & 31, j = tid >> 5;
            float hl[8], Ac[8]; float hv = 0.f, AA = 1.f;
#pragma unroll
            for (int i = 0; i < 8; ++i) { const int p = j * 8 + i, tk = fwd ? p : 127 - p; const float av = als[tk * 32 + c], bv = mls[tk * 32 + c] * ils[tk * 32 + c]; hv = av * hv + bv; AA = AA * av; hl[i] = hv; Ac[i] = AA; }
            cA[j * 32 + c] = AA; cH[j * 32 + c] = hv;
            __syncthreads();
            float s = state, sin_ = state;
#pragma unroll
            for (int jj = 0; jj < 16; ++jj) { if (jj == j) sin_ = s; s = cA[jj * 32 + c] * s + cH[jj * 32 + c]; }
            state = s;
            bf16* outp = A.HOUT + (tokb + t0) * 512 + n * 64 + hh * 32 + c;
#pragma unroll
            for (int i = 0; i < 8; ++i) { const int p = j * 8 + i, tk = fwd ? p : 127 - p; outp[(long)tk * 512] = (bf16)f2bf(hl[i] + Ac[i] * sin_); }
        }
        __syncthreads();
    }
#undef LRU_LOAD
}

__device__ __forceinline__ unsigned mono_key(float f) { const unsigned b = __float_as_uint(f); return b ^ ((unsigned)((int)b >> 31) | 0x80000000u); }
#define TK_INS(L, xin) do { unsigned x_ = (xin); _Pragma("unroll") for (int q_ = 0; q_ < 16; ++q_) { const unsigned t_ = max(L[q_], x_); x_ = min(L[q_], x_); L[q_] = t_; } } while (0)
#define TK_CE(x, y) do { const unsigned h_ = max(x, y), l_ = min(x, y); x = h_; y = l_; } while (0)
__device__ __forceinline__ void tk_sort16(unsigned (&a)[16]) {
    TK_CE(a[0], a[1]); TK_CE(a[2], a[3]); TK_CE(a[0], a[2]); TK_CE(a[1], a[3]); TK_CE(a[1], a[2]); TK_CE(a[4], a[5]); TK_CE(a[6], a[7]); TK_CE(a[4], a[6]);
    TK_CE(a[5], a[7]); TK_CE(a[5], a[6]); TK_CE(a[0], a[4]); TK_CE(a[2], a[6]); TK_CE(a[2], a[4]); TK_CE(a[1], a[5]); TK_CE(a[3], a[7]); TK_CE(a[3], a[5]);
    TK_CE(a[1], a[2]); TK_CE(a[3], a[4]); TK_CE(a[5], a[6]); TK_CE(a[8], a[9]); TK_CE(a[10], a[11]); TK_CE(a[8], a[10]); TK_CE(a[9], a[11]); TK_CE(a[9], a[10]);
    TK_CE(a[12], a[13]); TK_CE(a[14], a[15]); TK_CE(a[12], a[14]); TK_CE(a[13], a[15]); TK_CE(a[13], a[14]); TK_CE(a[8], a[12]); TK_CE(a[10], a[14]); TK_CE(a[10], a[12]);
    TK_CE(a[9], a[13]); TK_CE(a[11], a[15]); TK_CE(a[11], a[13]); TK_CE(a[9], a[10]); TK_CE(a[11], a[12]); TK_CE(a[13], a[14]); TK_CE(a[0], a[8]); TK_CE(a[4], a[12]);
    TK_CE(a[4], a[8]); TK_CE(a[2], a[10]); TK_CE(a[6], a[14]); TK_CE(a[6], a[10]); TK_CE(a[2], a[4]); TK_CE(a[6], a[8]); TK_CE(a[10], a[12]); TK_CE(a[1], a[9]);
    TK_CE(a[5], a[13]); TK_CE(a[5], a[9]); TK_CE(a[3], a[11]); TK_CE(a[7], a[15]); TK_CE(a[7], a[11]); TK_CE(a[3], a[5]); TK_CE(a[7], a[9]); TK_CE(a[11], a[13]);
    TK_CE(a[1], a[2]); TK_CE(a[3], a[4]); TK_CE(a[5], a[6]); TK_CE(a[7], a[8]); TK_CE(a[9], a[10]); TK_CE(a[11], a[12]); TK_CE(a[13], a[14]);
}
__device__ __forceinline__ void tk_merge16(unsigned (&L)[16], const unsigned (&B)[16]) {
#pragma unroll
    for (int i = 0; i < 16; ++i) L[i] = max(L[i], B[15 - i]);
#pragma unroll
    for (int d = 8; d >= 1; d >>= 1)
#pragma unroll
        for (int i = 0; i < 16; ++i) if ((i & d) == 0) TK_CE(L[i], L[i + d]);
}
struct TopkArgs { const bf16* QP; const bf16* KEYS; unsigned short* IDX; float* GW; };
__device__ __forceinline__ void topk_unit(int tile, const TopkArgs& A, const bf16x8 (&kf)[4][4], char* lds) {
    const int tid = fresh_tid(), wid = tid >> 6, lane = tid & 63, r32 = lane & 31, hi = lane >> 5;
    float* sc = (float*)lds; unsigned* sci = (unsigned*)lds;
    const int t0 = tile * 64;
    for (int hp = 0; hp < 4; ++hp) {
        {
            const int combo = wid >> 1, head = 2 * hp + (wid >> 2), half = (wid >> 1) & 1, rtile = wid & 1;
            const bf16* qrow = A.QP + (size_t)(t0 + rtile * 32 + r32) * 1024 + head * 128 + half * 64 + hi * 8;
            bf16x8 af[4];
#pragma unroll
            for (int ks = 0; ks < 4; ++ks) af[ks] = *(const bf16x8*)(qrow + ks * 16);
#pragma unroll
            for (int ct = 0; ct < 4; ++ct) {
                f32x16 d = {};
#pragma unroll
                for (int ks = 0; ks < 4; ++ks) d = __builtin_amdgcn_mfma_f32_32x32x16_bf16(af[ks], kf[ct][ks], d, 0, 0, 0);
#pragma unroll
                for (int r = 0; r < 16; ++r) sc[(combo * 64 + rtile * 32 + crow16(r, hi)) * 132 + ct * 32 + r32] = d[r];
            }
        }
        __syncthreads();
        {
            const int row = tid >> 1, part = tid & 1;
            const float* rowp = sc + row * 132 + part * 64;
            unsigned L[16];
#pragma unroll
            for (int gq = 0; gq < 4; ++gq) {
                unsigned G[16];
#pragma unroll
                for (int i = 0; i < 4; ++i) {
                    const f32x4 v = *(const f32x4*)(rowp + 16 * gq + 4 * i);
#pragma unroll
                    for (int j = 0; j < 4; ++j) G[4 * i + j] = (mono_key(v[j]) & ~127u) | (127u - (unsigned)(part * 64 + 16 * gq + 4 * i + j));
                }
                tk_sort16(G);
                if (gq == 0) {
#pragma unroll
                    for (int q = 0; q < 16; ++q) L[q] = G[q];
                } else tk_merge16(L, G);
            }
            {
                unsigned P[16];
#pragma unroll
                for (int q = 0; q < 16; ++q) P[q] = __shfl_xor(L[q], 1);
                tk_merge16(L, P);
            }
            float vals[16]; unsigned ids[16];
#pragma unroll
            for (int q = 0; q < 16; ++q) { ids[q] = 127u - (L[q] & 127u); vals[q] = sc[row * 132 + ids[q]]; }
            asm volatile("s_waitcnt lgkmcnt(0)" ::: "memory");
            if (part == 0) {
#pragma unroll
                for (int q = 0; q < 16; ++q) { sc[row * 132 + q] = vals[q]; sci[row * 132 + 16 + q] = ids[q]; }
            }
        }
        __syncthreads();
        if (tid < 128) {
            const int tok = tid & 63, hh = tid >> 6;
            const int row1 = (hh * 2 + 0) * 64 + tok, row2 = (hh * 2 + 1) * 64 + tok;
            float v1[16], v2[16];
#pragma unroll
            for (int q = 0; q < 16; ++q) { v1[q] = sc[row1 * 132 + q]; v2[q] = sc[row2 * 132 + q]; }
            unsigned L[16];
#define TK_KEY2(i, j) ((mono_key(v1[i] + v2[j]) & ~255u) | (255u - (unsigned)((i) * 16 + (j))))
#pragma unroll
            for (int j = 0; j < 16; ++j) L[j] = TK_KEY2(0, j);
            tk_sort16(L);
            {
                unsigned G[16] = {TK_KEY2(1, 0), TK_KEY2(1, 1), TK_KEY2(1, 2), TK_KEY2(1, 3), TK_KEY2(1, 4), TK_KEY2(1, 5), TK_KEY2(1, 6), TK_KEY2(1, 7),
                                  TK_KEY2(2, 0), TK_KEY2(2, 1), TK_KEY2(2, 2), TK_KEY2(2, 3), TK_KEY2(2, 4), TK_KEY2(3, 0), TK_KEY2(3, 1), TK_KEY2(3, 2)};
                tk_sort16(G); tk_merge16(L, G);
            }
            {
                unsigned G[16] = {TK_KEY2(3, 3), TK_KEY2(4, 0), TK_KEY2(4, 1), TK_KEY2(4, 2), TK_KEY2(5, 0), TK_KEY2(5, 1), TK_KEY2(6, 0), TK_KEY2(6, 1),
                                  TK_KEY2(7, 0), TK_KEY2(7, 1), TK_KEY2(8, 0), TK_KEY2(9, 0), TK_KEY2(10, 0), TK_KEY2(11, 0), TK_KEY2(12, 0), TK_KEY2(13, 0)};
                tk_sort16(G); tk_merge16(L, G);
            }
            { unsigned k14 = TK_KEY2(14, 0), k15 = TK_KEY2(15, 0); TK_INS(L, k14); TK_INS(L, k15); }
#undef TK_KEY2
            float sv[16]; unsigned ev[16]; float mx = -3.0e38f;
#pragma unroll
            for (int q = 0; q < 16; ++q) {
                const unsigned pos = 255u - (L[q] & 255u), i = pos >> 4, j = pos & 15u;
                sv[q] = sc[row1 * 132 + i] + sc[row2 * 132 + j];
                ev[q] = sci[row1 * 132 + 16 + i] * 128u + sci[row2 * 132 + 16 + j];
                mx = fmaxf(mx, sv[q]);
            }
            float sum = 0.f;
#pragma unroll
            for (int q = 0; q < 16; ++q) { sv[q] = __expf(sv[q] - mx); sum += sv[q]; }
            const float inv = 1.0f / sum;
            const size_t ob = (size_t)(t0 + tok) * 128 + (2 * hp + hh) * 16;
#pragma unroll
            for (int q = 0; q < 16; ++q) { A.IDX[ob + q] = (unsigned short)ev[q]; A.GW[ob + q] = sv[q] * inv; }
        }
        __syncthreads();
    }
}

typedef float f32x2 __attribute__((ext_vector_type(2)));
constexpr float U8_SCALE = 64.0f, V8_SCALE = 16.0f;
struct PeerArgs { const unsigned short* IDX; const bf16* HB; const unsigned char* UT; const unsigned char* VT; float* PLOG; const float* ACT; bf16* H2B; float* SS2; };
#define PEER_EID(i0, i1, g) ((((g) & 1) ? (((g) >> 1) < 4 ? (i0)[((g) >> 1) & 3] : (i1)[((g) >> 1) & 3]) >> 16 : (((g) >> 1) < 4 ? (i0)[((g) >> 1) & 3] : (i1)[((g) >> 1) & 3]) & 0xffffu))
#define PEER_U4(A0, A1, A2, A3, XA, XB, XC, XD, W0a, W0b, W1a, W1b, W2a, W2b, W3a, W3b) do { f32x2 t0_, t1_, t2_, t3_; asm volatile( \
    "v_cvt_pk_f32_fp8_e32 %4, %12\n\tv_cvt_pk_f32_fp8_e32 %5, %14\n\tv_cvt_pk_f32_fp8_e32 %6, %16\n\tv_cvt_pk_f32_fp8_e32 %7, %18\n\t" \
    "v_pk_fma_f32 %0, %4, %8, %0\n\tv_pk_fma_f32 %1, %5, %8, %1\n\tv_pk_fma_f32 %2, %6, %8, %2\n\tv_pk_fma_f32 %3, %7, %8, %3\n\t" \
    "v_cvt_pk_f32_fp8_sdwa %4, %12 src0_sel:WORD_1\n\tv_cvt_pk_f32_fp8_sdwa %5, %14 src0_sel:WORD_1\n\tv_cvt_pk_f32_fp8_sdwa %6, %16 src0_sel:WORD_1\n\tv_cvt_pk_f32_fp8_sdwa %7, %18 src0_sel:WORD_1\n\t" \
    "v_pk_fma_f32 %0, %4, %9, %0\n\tv_pk_fma_f32 %1, %5, %9, %1\n\tv_pk_fma_f32 %2, %6, %9, %2\n\tv_pk_fma_f32 %3, %7, %9, %3\n\t" \
    "v_cvt_pk_f32_fp8_e32 %4, %13\n\tv_cvt_pk_f32_fp8_e32 %5, %15\n\tv_cvt_pk_f32_fp8_e32 %6, %17\n\tv_cvt_pk_f32_fp8_e32 %7, %19\n\t" \
    "v_pk_fma_f32 %0, %4, %10, %0\n\tv_pk_fma_f32 %1, %5, %10, %1\n\tv_pk_fma_f32 %2, %6, %10, %2\n\tv_pk_fma_f32 %3, %7, %10, %3\n\t" \
    "v_cvt_pk_f32_fp8_sdwa %4, %13 src0_sel:WORD_1\n\tv_cvt_pk_f32_fp8_sdwa %5, %15 src0_sel:WORD_1\n\tv_cvt_pk_f32_fp8_sdwa %6, %17 src0_sel:WORD_1\n\tv_cvt_pk_f32_fp8_sdwa %7, %19 src0_sel:WORD_1\n\t" \
    "v_pk_fma_f32 %0, %4, %11, %0\n\tv_pk_fma_f32 %1, %5, %11, %1\n\tv_pk_fma_f32 %2, %6, %11, %2\n\tv_pk_fma_f32 %3, %7, %11, %3" \
    : "+v"(A0), "+v"(A1), "+v"(A2), "+v"(A3), "=&v"(t0_), "=&v"(t1_), "=&v"(t2_), "=&v"(t3_) \
    : "v"(XA), "v"(XB), "v"(XC), "v"(XD), "v"(W0a), "v"(W0b), "v"(W1a), "v"(W1b), "v"(W2a), "v"(W2b), "v"(W3a), "v"(W3b)); } while (0)
#define PEER_V4(C0, C1, C2, C3, AV2, Wa, Wb) do { f32x2 t0_, t1_, t2_, t3_; asm volatile( \
    "v_cvt_pk_f32_fp8_e32 %4, %9\n\tv_cvt_pk_f32_fp8_sdwa %5, %9 src0_sel:WORD_1\n\tv_cvt_pk_f32_fp8_e32 %6, %10\n\tv_cvt_pk_f32_fp8_sdwa %7, %10 src0_sel:WORD_1\n\t" \
    "v_pk_fma_f32 %0, %4, %8, %0\n\tv_pk_fma_f32 %1, %5, %8, %1\n\tv_pk_fma_f32 %2, %6, %8, %2\n\tv_pk_fma_f32 %3, %7, %8, %3" \
    : "+v"(C0), "+v"(C1), "+v"(C2), "+v"(C3), "=&v"(t0_), "=&v"(t1_), "=&v"(t2_), "=&v"(t3_) : "v"(AV2), "v"(Wa), "v"(Wb)); } while (0)
struct XPairs { f32x2 x0, x1, x2, x3, x4, x5, x6, x7; };
__device__ __forceinline__ XPairs peer_xpairs(const u32x4 xa, const u32x4 xb) {
    XPairs X; X.x0 = (f32x2){bflo(xa.x), bfhi(xa.x)}; X.x1 = (f32x2){bflo(xa.y), bfhi(xa.y)}; X.x2 = (f32x2){bflo(xa.z), bfhi(xa.z)}; X.x3 = (f32x2){bflo(xa.w), bfhi(xa.w)};
    X.x4 = (f32x2){bflo(xb.x), bfhi(xb.x)}; X.x5 = (f32x2){bflo(xb.y), bfhi(xb.y)}; X.x6 = (f32x2){bflo(xb.z), bfhi(xb.z)}; X.x7 = (f32x2){bflo(xb.w), bfhi(xb.w)}; return X;
}
__device__ __forceinline__ void peer_dots16(float (&p)[16], const XPairs& X, const u32x4 (&u)[16]) {
#pragma unroll
    for (int q = 0; q < 4; ++q) {
        f32x2 a0 = {0.f, 0.f}, a1 = a0, a2 = a0, a3 = a0;
        unsigned w0x = u[4 * q].x, w0y = u[4 * q].y, w0z = u[4 * q].z, w0w = u[4 * q].w, w1x = u[4 * q + 1].x, w1y = u[4 * q + 1].y, w1z = u[4 * q + 1].z, w1w = u[4 * q + 1].w;
        unsigned w2x = u[4 * q + 2].x, w2y = u[4 * q + 2].y, w2z = u[4 * q + 2].z, w2w = u[4 * q + 2].w, w3x = u[4 * q + 3].x, w3y = u[4 * q + 3].y, w3z = u[4 * q + 3].z, w3w = u[4 * q + 3].w;
        PEER_U4(a0, a1, a2, a3, X.x0, X.x1, X.x2, X.x3, w0x, w0y, w1x, w1y, w2x, w2y, w3x, w3y);
        PEER_U4(a0, a1, a2, a3, X.x4, X.x5, X.x6, X.x7, w0z, w0w, w1z, w1w, w2z, w2w, w3z, w3w);
        p[4 * q] = a0.x + a0.y; p[4 * q + 1] = a1.x + a1.y; p[4 * q + 2] = a2.x + a2.y; p[4 * q + 3] = a3.x + a3.y;
    }
}
__device__ __forceinline__ void peer_u_reduce_store(float (&p)[16], int c, float* po) {
#pragma unroll
    for (int i = 0; i < 8; ++i) { const bool up = (c & 4) != 0; const float give = up ? p[i] : p[i + 8]; const float keep = up ? p[i + 8] : p[i]; p[i] = keep + __shfl_xor(give, 4); }
#pragma unroll
    for (int i = 0; i < 4; ++i) { const bool up = (c & 2) != 0; const float give = up ? p[i] : p[i + 4]; const float keep = up ? p[i + 4] : p[i]; p[i] = keep + __shfl_xor(give, 2); }
#pragma unroll
    for (int i = 0; i < 2; ++i) { const bool up = (c & 1) != 0; const float give = up ? p[i] : p[i + 2]; const float keep = up ? p[i + 2] : p[i]; p[i] = keep + __shfl_xor(give, 1); }
    f32x2 o = {p[0] * (1.0f / U8_SCALE), p[1] * (1.0f / U8_SCALE)};
    *(f32x2*)po = o;
}
template <unsigned IDMASK, int MODE> __device__ __forceinline__ void peer_u_item(int tile, int s, const PeerArgs& A, char* lds) {
    const int tid = fresh_tid(), wid = tid >> 6, lane = tid & 63, e8 = lane >> 3, c = lane & 7;
    const int tb = tile * 128 + wid;
    const unsigned short* ip = A.IDX + (size_t)tb * 128 + e8 * 16;
    const bf16* xp = A.HB + (size_t)tb * 1024 + s * 128 + c * 16;
    const unsigned char* ut = A.UT + (size_t)s * (16384 * 128) + c * 16;
    float* pl = A.PLOG + ((size_t)s * T + tb) * 128 + e8 * 16 + 2 * c;
    u32x4 ia0 = *(const u32x4*)ip, ia1 = *(const u32x4*)(ip + 8), ib0 = *(const u32x4*)(ip + 8 * 128), ib1 = *(const u32x4*)(ip + 8 * 128 + 8);
    for (int jp = 0; jp < 8; ++jp) {
        u32x4 na0 = ia0, na1 = ia1, nb0 = ib0, nb1 = ib1;
        if (jp < 7) { const unsigned short* q = ip + (size_t)(jp + 1) * 16 * 128; na0 = *(const u32x4*)q; na1 = *(const u32x4*)(q + 8); nb0 = *(const u32x4*)(q + 8 * 128); nb1 = *(const u32x4*)(q + 8 * 128 + 8); }
        const bf16* xq = xp + (size_t)jp * 16 * 1024;
        const u32x4 xa0 = *(const u32x4*)xq, xa1 = *(const u32x4*)(xq + 8), xb0 = *(const u32x4*)(xq + 8 * 1024), xb1 = *(const u32x4*)(xq + 8 * 1024 + 8);
        u32x4 ua[16], ub[16];
#pragma unroll
        for (int g = 0; g < 16; ++g) ua[g] = *(const u32x4*)(ut + (size_t)(PEER_EID(ia0, ia1, g) & IDMASK) * 128);
#pragma unroll
        for (int g = 0; g < 16; ++g) ub[g] = *(const u32x4*)(ut + (size_t)(PEER_EID(ib0, ib1, g) & IDMASK) * 128);
        asm volatile("" ::: "memory"); __builtin_amdgcn_sched_barrier(0);
        float p[16];
        if (MODE == 0) { const XPairs X = peer_xpairs(xa0, xa1); peer_dots16(p, X, ua); }
        else { _Pragma("unroll") for (int g = 0; g < 16; ++g) p[g] = __uint_as_float((ua[g].x ^ ua[g].y) ^ (ua[g].z ^ ua[g].w) ^ xa0.x ^ xa1.x); }
        peer_u_reduce_store(p, c, pl + (size_t)jp * 16 * 128);
        if (MODE == 0) { const XPairs X = peer_xpairs(xb0, xb1); peer_dots16(p, X, ub); }
        else { _Pragma("unroll") for (int g = 0; g < 16; ++g) p[g] = __uint_as_float((ub[g].x ^ ub[g].y) ^ (ub[g].z ^ ub[g].w) ^ xb0.x ^ xb1.x); }
        peer_u_reduce_store(p, c, pl + (size_t)jp * 16 * 128 + 8 * 128);
        ia0 = na0; ia1 = na1; ib0 = nb0; ib1 = nb1;
    }
}
__device__ __forceinline__ void peer_v_accum(f32x2 (&acc)[8], const u32x4 (&vw)[16], const f32x4 a0, const f32x4 a1, const f32x4 a2, const f32x4 a3) {
#pragma unroll
    for (int j = 0; j < 8; ++j) acc[j] = (f32x2){0.f, 0.f};
#pragma unroll
    for (int g = 0; g < 16; ++g) {
        const float av = (g < 4) ? a0[g & 3] : (g < 8) ? a1[g & 3] : (g < 12) ? a2[g & 3] : a3[g & 3];
        const f32x2 av2 = {av, av};
        unsigned wx = vw[g].x, wy = vw[g].y, wz = vw[g].z, ww = vw[g].w;
        PEER_V4(acc[0], acc[1], acc[2], acc[3], av2, wx, wy);
        PEER_V4(acc[4], acc[5], acc[6], acc[7], av2, wz, ww);
    }
}
template <bool HMEM> __device__ __forceinline__ void peer_v_finish(const f32x2 (&acc)[8], float* red, int lane, int e8, int c, f32x4 hv, bf16* hbp, float* ssp, float vs) {
#pragma unroll
    for (int q = 0; q < 4; ++q) { const f32x4 v = {acc[2 * q].x, acc[2 * q].y, acc[2 * q + 1].x, acc[2 * q + 1].y}; *(f32x4*)(red + e8 * 128 + c * 16 + 4 * q) = v; }
    asm volatile("s_waitcnt lgkmcnt(0)" ::: "memory");
    float ssq = 0.f;
    if (lane < 32) {
        f32x4 sm = *(const f32x4*)(red + 4 * lane);
#pragma unroll
        for (int h = 1; h < 8; ++h) sm += *(const f32x4*)(red + h * 128 + 4 * lane);
        hv += sm * vs;
        u32x2 w = {pk2(hv[0], hv[1]), pk2(hv[2], hv[3])};
        if (HMEM) { *(u32x2*)(hbp + 4 * lane) = w; } else asm volatile("" :: "v"(hv), "v"(w));
        ssq = (hv[0] * hv[0] + hv[1] * hv[1]) + (hv[2] * hv[2] + hv[3] * hv[3]);
    }
    ssq += __shfl_xor(ssq, 1); ssq += __shfl_xor(ssq, 2); ssq += __shfl_xor(ssq, 4); ssq += __shfl_xor(ssq, 8); ssq += __shfl_xor(ssq, 16);
    if (HMEM) { if (lane == 0) *ssp = ssq; } else asm volatile("" :: "v"(ssq));
    asm volatile("s_waitcnt lgkmcnt(0)" ::: "memory");
}
template <bool HMEM, unsigned IDMASK> __device__ __forceinline__ void peer_v_item(int tile, int s, const PeerArgs& A, char* lds, float vscale) {
    const int tid = fresh_tid(), wid = tid >> 6, lane = tid & 63, e8 = lane >> 3, c = lane & 7;
    float* red = (float*)(lds + wid * 4096);
    const int tb = tile * 128 + wid;
    const unsigned short* ip = A.IDX + (size_t)tb * 128 + e8 * 16;
    const float* ap = A.ACT + (size_t)tb * 128 + e8 * 16;
    const unsigned char* vt = A.VT + (size_t)s * (16384 * 128) + c * 16;
    bf16* hbp = A.H2B + (size_t)tb * 1024 + s * 128; float* ssp = A.SS2 + (size_t)tb * 8 + s;
    const float vs = vscale * (1.0f / V8_SCALE);
    u32x4 ia0 = *(const u32x4*)ip, ia1 = *(const u32x4*)(ip + 8), ib0 = *(const u32x4*)(ip + 8 * 128), ib1 = *(const u32x4*)(ip + 8 * 128 + 8);
    for (int jp = 0; jp < 8; ++jp) {
        u32x4 na0 = ia0, na1 = ia1, nb0 = ib0, nb1 = ib1;
        if (jp < 7) { const unsigned short* q = ip + (size_t)(jp + 1) * 16 * 128; na0 = *(const u32x4*)q; na1 = *(const u32x4*)(q + 8); nb0 = *(const u32x4*)(q + 8 * 128); nb1 = *(const u32x4*)(q + 8 * 128 + 8); }
        const int l4 = (lane & 31) * 4;
        f32x4 hva = {0.f, 0.f, 0.f, 0.f}, hvb = hva; if (HMEM) { const u32x2 wa_ = *(const u32x2*)(hbp + (size_t)jp * 16 * 1024 + l4), wb_ = *(const u32x2*)(hbp + (size_t)(jp * 16 + 8) * 1024 + l4);
            hva = (f32x4){bflo(wa_.x), bfhi(wa_.x), bflo(wa_.y), bfhi(wa_.y)}; hvb = (f32x4){bflo(wb_.x), bfhi(wb_.x), bflo(wb_.y), bfhi(wb_.y)}; }
        const float* aq = ap + (size_t)jp * 16 * 128;
        const f32x4 aa0 = *(const f32x4*)aq, aa1 = *(const f32x4*)(aq + 4), aa2 = *(const f32x4*)(aq + 8), aa3 = *(const f32x4*)(aq + 12);
        const f32x4 ab0 = *(const f32x4*)(aq + 8 * 128), ab1 = *(const f32x4*)(aq + 8 * 128 + 4), ab2 = *(const f32x4*)(aq + 8 * 128 + 8), ab3 = *(const f32x4*)(aq + 8 * 128 + 12);
        u32x4 va[16], vb[16];
#pragma unroll
        for (int g = 0; g < 16; ++g) va[g] = *(const u32x4*)(vt + (size_t)(PEER_EID(ia0, ia1, g) & IDMASK) * 128);
#pragma unroll
        for (int g = 0; g < 16; ++g) vb[g] = *(const u32x4*)(vt + (size_t)(PEER_EID(ib0, ib1, g) & IDMASK) * 128);
        asm volatile("" ::: "memory"); __builtin_amdgcn_sched_barrier(0);
        f32x2 acc[8];
        peer_v_accum(acc, va, aa0, aa1, aa2, aa3);
        peer_v_finish<HMEM>(acc, red, lane, e8, c, hva, hbp + (size_t)jp * 16 * 1024, ssp + (size_t)jp * 16 * 8, vs);
        peer_v_accum(acc, vb, ab0, ab1, ab2, ab3);
        peer_v_finish<HMEM>(acc, red, lane, e8, c, hvb, hbp + (size_t)(jp * 16 + 8) * 1024, ssp + (size_t)(jp * 16 + 8) * 8, vs);
        ia0 = na0; ia1 = na1; ib0 = nb0; ib1 = nb1;
    }
}

#define XB_TMO      128
#define XB_XCNT(j)  (256  + 64 * (j))
#define XB_XSUB(j)  (1280 + 64 * (j))
#define XB_XGEN(j)  (2304 + 64 * (j))
#define XB_TOP      3328
#define XB_TOPGEN   3392
#define XCD_BAR_WORDS 3456
#define XB_SPIN_CAP (1u << 18)

__device__ __forceinline__ unsigned xb_ld(unsigned* p)              { return __hip_atomic_load(p, __ATOMIC_RELAXED, __HIP_MEMORY_SCOPE_AGENT); }
__device__ __forceinline__ unsigned xb_add(unsigned* p, unsigned v) { return __hip_atomic_fetch_add(p, v, __ATOMIC_RELAXED, __HIP_MEMORY_SCOPE_AGENT); }
__device__ __forceinline__ unsigned xb_xcc_id() { return (unsigned)__builtin_amdgcn_s_getreg((3 << 11) | 20) & 0xFu; }
#define XB_SPIN(cond, bar) do { unsigned _sp = 0; while (cond) { __builtin_amdgcn_s_sleep(1); \
    if ((++_sp & 255u) == 0u) { if (xb_ld(&(bar)[XB_TMO])) break; if (_sp > XB_SPIN_CAP) { atomicAdd(&(bar)[XB_TMO], 1u); break; } } } } while (0)

struct XcdBarrier {
    unsigned* bar; unsigned x;
    volatile LAS unsigned* st;
};

__device__ __forceinline__ XcdBarrier xcd_barrier_post(unsigned* bar, volatile LAS unsigned* st) {
    XcdBarrier b; b.bar = bar; b.x = xb_xcc_id(); b.st = st;
    if (threadIdx.x == 0) (void)xb_add(&bar[XB_XCNT(b.x)], 1u);
    return b;
}
__device__ __forceinline__ void xcd_barrier_complete(unsigned* bar, unsigned x, unsigned& nloc, unsigned& nx) {
    const unsigned G = gridDim.x * gridDim.y * gridDim.z;
    unsigned sum, cnt, mine, sp = 0u;
    for (;;) {
        sum = 0u; cnt = 0u; mine = 0u;
#pragma unroll
        for (unsigned j = 0; j < 16; ++j) { const unsigned c = xb_ld(&bar[XB_XCNT(j)]); sum += c; cnt += (c > 0u) ? 1u : 0u; mine = (j == x) ? c : mine; }
        if (sum == G) break;
        __builtin_amdgcn_s_sleep(1);
        if ((++sp & 255u) == 0u) { if (xb_ld(&bar[XB_TMO])) break; if (sp > XB_SPIN_CAP) { atomicAdd(&bar[XB_TMO], 1u); break; } }
    }
    nloc = mine > 0u ? mine : 1u; nx = cnt > 0u ? cnt : 1u;
}

__device__ __forceinline__ void xcd_barrier(const XcdBarrier& b) {
    asm volatile("s_waitcnt vmcnt(0)" ::: "memory");
    __syncthreads();
    if (threadIdx.x == 0) {
        unsigned* bar = b.bar;
        __builtin_amdgcn_s_waitcnt(0);
        unsigned nloc = b.st[0], nx = b.st[1];
        if (nloc == 0u) { xcd_barrier_complete(bar, b.x, nloc, nx); b.st[0] = nloc; b.st[1] = nx; }
        const unsigned old = xb_add(&bar[XB_XSUB(b.x)], 1u);
        const unsigned gen = old / nloc;
        if (old + 1u == (gen + 1u) * nloc) {
            __builtin_amdgcn_fence(__ATOMIC_RELEASE, "agent");
            asm volatile("s_waitcnt vmcnt(0)" ::: "memory");
            const unsigned og = xb_add(&bar[XB_TOP], 1u);
            const unsigned tg = og / nx;
            if (og + 1u == (tg + 1u) * nx) xb_add(&bar[XB_TOPGEN], 1u);
            else XB_SPIN(xb_ld(&bar[XB_TOPGEN]) == tg, bar);
            __builtin_amdgcn_fence(__ATOMIC_ACQUIRE, "agent");
            xb_add(&bar[XB_XGEN(b.x)], 1u);
            asm volatile("s_waitcnt vmcnt(0)" ::: "memory");
        } else {
            XB_SPIN(xb_ld(&bar[XB_XGEN(b.x)]) == gen, bar);
            __builtin_amdgcn_fence(__ATOMIC_ACQUIRE, "agent");
            asm volatile("s_waitcnt vmcnt(0)" ::: "memory");
        }
    }
    __syncthreads();
}
constexpr size_t MiB = (size_t)1 << 20;
constexpr size_t WS_CTL = 0, CTL_ZERO_BYTES = 1 * MiB;
constexpr size_t WS_WIN = 1 * MiB, WS_WOUT = 6 * MiB, WS_WQ = 8 * MiB, WS_WG = 10 * MiB, WS_WP = 12 * MiB;
constexpr size_t WS_KEYS = 12 * MiB + 512 * 1024, WS_LWT = 12 * MiB + 768 * 1024, WS_ROPE = 13 * MiB, WS_MISC = 15 * MiB;
constexpr size_t WS_SS1 = 16 * MiB, WS_SS2 = 18 * MiB, WS_SS3 = 20 * MiB;
constexpr size_t WS_IDX = 24 * MiB, WS_GW = 32 * MiB, WS_PB = 48 * MiB;
constexpr size_t WS_UT = 64 * MiB, WS_VT = 96 * MiB;
constexpr size_t WS_XN = 128 * MiB;
constexpr size_t WS_Q = 192 * MiB, WS_K = 224 * MiB, WS_V = 256 * MiB, WS_LIN = 288 * MiB, WS_LGATE = 320 * MiB;
constexpr size_t WS_QP = 192 * MiB;
constexpr size_t WS_MIXED = 352 * MiB, WS_HF = 416 * MiB, WS_HB = 448 * MiB;
constexpr size_t WS_PLOG = 352 * MiB;
constexpr size_t WS_ACT = 256 * MiB;
constexpr size_t WS_END = 480 * MiB;
constexpr int LDS_BYTES = 147456;

struct Args {
    const float* in[29]; float* out; unsigned char* ws; int ph_lo, ph_hi, coop, pad;
};
struct Frame { char* lds; int G, bid; const Args* a; unsigned char* ws; };


__device__ __forceinline__ void p0_transpose_item(const float* W, int K, int N, bf16* WT, const float* gk, float* scr, int item, int lane) {
    const int nblk = N / 32, kb = item / nblk, nb = item % nblk, k0 = 64 * kb, n0 = 32 * nb;
#pragma unroll 8
    for (int i = 0; i < 32; ++i) { const int kk = 2 * i + (lane >> 5); float w = W[(size_t)(k0 + kk) * N + n0 + (lane & 31)]; if (gk) w *= gk[k0 + kk]; scr[kk * 33 + (lane & 31)] = w; }
    asm volatile("s_waitcnt lgkmcnt(0)" ::: "memory");
    const int c = lane & 7;
#pragma unroll
    for (int j = 0; j < 4; ++j) { const int n = (lane >> 3) + 8 * j; const float* s = scr + (8 * c) * 33 + n;
        u32x4 o; o.x = pk2(s[0 * 33], s[1 * 33]); o.y = pk2(s[2 * 33], s[3 * 33]); o.z = pk2(s[4 * 33], s[5 * 33]); o.w = pk2(s[6 * 33], s[7 * 33]);
        *(u32x4*)(WT + (size_t)(n0 + n) * K + k0 + 8 * c) = o; }
    asm volatile("s_waitcnt lgkmcnt(0)" ::: "memory");
}
__device__ __forceinline__ void p0_prologue(Frame& F) {
    const int tid_ = fresh_tid(), lane_ = tid_ & 63, wave_ = __builtin_amdgcn_readfirstlane(tid_ >> 6);
    float* scr = (float*)(F.lds + wave_ * 16384);
    const int gw = F.bid * 8 + wave_, NGW = F.G * 8;
    const long gt = (long)F.bid * 512 + tid_, NGT = (long)F.G * 512;
    unsigned char* ws = F.ws;
    constexpr int I_IN = 16 * 80, I_SQ = 16 * 32, I_P = 4 * 32;
    for (int it = gw; it < I_IN + 3 * I_SQ + I_P; it += NGW) {
        int r = it;
        if (r < I_IN) { p0_transpose_item(F.a->in[4], 1024, 2560, (bf16*)(ws + WS_WIN), nullptr, scr, r, lane_); continue; } r -= I_IN;
        if (r < I_SQ) { p0_transpose_item(F.a->in[18], 1024, 1024, (bf16*)(ws + WS_WOUT), nullptr, scr, r, lane_); continue; } r -= I_SQ;
        if (r < I_SQ) { p0_transpose_item(F.a->in[20], 1024, 1024, (bf16*)(ws + WS_WQ), F.a->in[19], scr, r, lane_); continue; } r -= I_SQ;
        if (r < I_SQ) { p0_transpose_item(F.a->in[26], 1024, 1024, (bf16*)(ws + WS_WG), F.a->in[25], scr, r, lane_); continue; } r -= I_SQ;
        p0_transpose_item(F.a->in[27], 256, 1024, (bf16*)(ws + WS_WP), nullptr, scr, r, lane_);
    }
    for (int m = gw; m < T; m += NGW) {
        const f32x4* xr = (const f32x4*)(F.a->in[0] + (size_t)m * 1024) + lane_; const f32x4* gr = (const f32x4*)F.a->in[3] + lane_;
        f32x4 v[4]; float s = 0.f;
#pragma unroll
        for (int j = 0; j < 4; ++j) { v[j] = xr[64 * j]; s += (v[j][0] * v[j][0] + v[j][1] * v[j][1]) + (v[j][2] * v[j][2] + v[j][3] * v[j][3]); }
        const float rstd = 1.0f / sqrtf(wave_sum(s) * (1.0f / 1024.0f) + EPS);
        u32x2* o8 = (u32x2*)(ws + WS_XN + (size_t)m * 2048) + lane_;
#pragma unroll
        for (int j = 0; j < 4; ++j) { const f32x4 g = gr[64 * j]; u32x2 w = {pk2(v[j][0] * rstd * g[0], v[j][1] * rstd * g[1]), pk2(v[j][2] * rstd * g[2], v[j][3] * rstd * g[3])}; o8[64 * j] = w; }
    }
    for (long i = gt; i < (long)T * PLE / 8; i += NGT) {
        const f32x4 a = *(const f32x4*)(F.a->in[1] + i * 8), b = *(const f32x4*)(F.a->in[1] + i * 8 + 4);
        u32x4 w = {pk2(a[0], a[1]), pk2(a[2], a[3]), pk2(b[0], b[1]), pk2(b[2], b[3])}; *(u32x4*)(ws + WS_PB + i * 16) = w;
    }
    for (long i = gt; i < (long)16384 * 1024 / 16; i += NGT) {
        const int c0 = (int)((i * 16) & 1023);
        unsigned wu[4], wv[4];
#pragma unroll
        for (int q = 0; q < 4; ++q) {
            const f32x4 a = *(const f32x4*)(F.a->in[23] + i * 16 + 4 * q), g = *(const f32x4*)(F.a->in[19] + c0 + 4 * q), v = *(const f32x4*)(F.a->in[24] + i * 16 + 4 * q);
            int w = 0;
            w = __builtin_amdgcn_cvt_pk_fp8_f32(fminf(fmaxf(a[0] * g[0] * U8_SCALE, -448.f), 448.f), fminf(fmaxf(a[1] * g[1] * U8_SCALE, -448.f), 448.f), w, false);
            w = __builtin_amdgcn_cvt_pk_fp8_f32(fminf(fmaxf(a[2] * g[2] * U8_SCALE, -448.f), 448.f), fminf(fmaxf(a[3] * g[3] * U8_SCALE, -448.f), 448.f), w, true);
            wu[q] = (unsigned)w;
            int w2 = 0;
            w2 = __builtin_amdgcn_cvt_pk_fp8_f32(fminf(fmaxf(v[0] * V8_SCALE, -448.f), 448.f), fminf(fmaxf(v[1] * V8_SCALE, -448.f), 448.f), w2, false);
            w2 = __builtin_amdgcn_cvt_pk_fp8_f32(fminf(fmaxf(v[2] * V8_SCALE, -448.f), 448.f), fminf(fmaxf(v[3] * V8_SCALE, -448.f), 448.f), w2, true);
            wv[q] = (unsigned)w2;
        }
        u32x4 ou = {wu[0], wu[1], wu[2], wu[3]}, ov = {wv[0], wv[1], wv[2], wv[3]};
        { const size_t ee = (size_t)(i >> 6), sl = (size_t)((i >> 3) & 7), ch = (size_t)(i & 7), off = sl * (16384 * 128) + ee * 128 + ch * 16;
          *(u32x4*)(ws + WS_UT + off) = ou; *(u32x4*)(ws + WS_VT + off) = ov; }
    }
    for (long i = gt; i < (long)T * 8; i += NGT) {
        const int t = (int)(i >> 3), k = (int)(i & 7);
        const float invf[8] = {1.0f, 0.19392274474868576f, 0.03760603093086393f, 0.007292664737217109f, 0.001414213562373095f, 0.0002742481756762073f, 5.318295896944988e-05f, 1.031338537721246e-05f};
        float fr = 1.0f;
#pragma unroll
        for (int q = 0; q < 8; ++q) if (q == k) fr = invf[q];
        const float ang = (float)((const int*)F.a->in[2])[t] * fr; float sn, cs; sincosf(ang, &sn, &cs);
        float* rp = (float*)(ws + WS_ROPE) + (size_t)t * 16; rp[k] = cs; rp[8 + k] = sn;
    }
    for (long i = gt; i < 2 * 8192; i += NGT) { const float v = (i < 8192) ? F.a->in[21][i] : F.a->in[22][i - 8192]; ((bf16*)(ws + WS_KEYS))[i] = (bf16)f2bf(v); }
    for (long i = gt; i < 2 * 8 * 2 * 64 * 64; i += NGT) {
        const int c = (int)(i & 63), e = (int)((i >> 6) & 63), gate = (int)((i >> 12) & 1), n = (int)((i >> 13) & 7), dir = (int)(i >> 16);
        const float* w = gate ? F.a->in[14] : F.a->in[12]; ((bf16*)(ws + WS_LWT))[i] = (bf16)f2bf(w[(((size_t)dir * 8 + n) * 64 + c) * 64 + e]);
    }
    if (F.bid == 0 && tid_ == 0) {
        float s1 = 0.f, s2 = 0.f;
        for (int i = 0; i < 64; ++i) { s1 += F.a->in[5][i] * F.a->in[6][i]; s2 += F.a->in[7][i] * F.a->in[8][i]; }
        ((float*)(ws + WS_MISC))[0] = expf(s1) - expf(s2) + LAMBDA_INIT;
    }
}

__global__ void __launch_bounds__(512, 2) enc_fwd(Args args) {
    extern __shared__ __attribute__((aligned(16))) unsigned char lds_raw[];
    Frame F;
    F.lds = (char*)lds_raw; F.G = gridDim.x; F.bid = blockIdx.x;
    F.a = &args; F.ws = args.ws;
    unsigned char* ws = args.ws;
    const int lo = args.ph_lo, hi = args.ph_hi;
    cg::grid_group grid = cg::this_grid();
#ifndef PHMASK
#define PHMASK 0x1fff
#endif
#define IN(k) ((((PHMASK) >> (k)) & 1) && lo <= (k) && (k) < hi)
#ifndef REPMASK
#define REPMASK 0
#endif
#define NREP(k) ((((REPMASK) >> (k)) & 1) + 1)
#define GBAR() do { if (args.coop) xcd_barrier(bar); } while (0)
#define SEAM(k) do { if (IN(k) && IN((k) + 1)) { if (args.coop) { if ((k) == 0) grid.sync(); else xcd_barrier(bar); } } } while (0)
#define PH_BEGIN(k) if (IN(k)) for (int rep_ = NREP(k) - 1; rep_ >= 0; --rep_) {
#define PH_END() if (rep_ > 0) GBAR(); }
    volatile LAS unsigned* MISC = (volatile LAS unsigned*)((LAS unsigned char*)lds_raw + (LDS_BYTES - 1024));
    if (threadIdx.x < 16) MISC[threadIdx.x] = 0u;
    __syncthreads();
    XcdBarrier bar; bar.bar = (unsigned*)(ws + WS_CTL) + 4096; bar.x = 0; bar.st = nullptr;
    if (args.coop) bar = xcd_barrier_post((unsigned*)(ws + WS_CTL) + 4096, MISC + 8);
    PG8_LAS unsigned char* ldsl = (PG8_LAS unsigned char*)lds_raw;

    PH_BEGIN(0) p0_prologue(F); __syncthreads(); PH_END()
    SEAM(0);
    PH_BEGIN(1)
        pg8::Gemm g{(const bf16*)(ws + WS_XN), (const bf16*)(ws + WS_WIN), T, INC, 1024}; pg8::StaticOrder S; S.init(T, INC, F.G, F.bid);
        pg8::EpiProj E{(bf16*)(ws + WS_Q), (const float*)(ws + WS_ROPE)};
        pg8::gemm_phase<pg8::EpiProj, pg8::StaticOrder, true, true>(ldsl, g, S, E);
    PH_END()
    SEAM(1);
    PH_BEGIN(2)
        const float lam = ((const float*)(ws + WS_MISC))[0];
        for (int r2_ = 0; r2_ < NREP(13); ++r2_)
        for (int it = F.bid; it < 256; it += F.G) {
            const int b = it & 7, nd = it >> 3, n = nd & 7, dir = (nd >> 3) & 1, hh = nd >> 4;
            LruArgs A{(const bf16*)(ws + WS_LIN), F.a->in[10], F.a->in[11], (const bf16*)(ws + WS_LWT), F.a->in[13], F.a->in[15], F.a->in[16], (bf16*)(ws + (dir ? WS_HB : WS_HF))};
            lru_item(b, n, dir, hh, A, F.lds);
        }
        for (int r3_ = 0; r3_ < NREP(14); ++r3_)
        for (int it = F.bid; it < 1024; it += F.G) {
            const int xx = it & 7, rest = it >> 3, qb = rest & 31, i4 = rest >> 5, bh = i4 * 8 + xx;
            att::attn_unit(bh >> 2, bh & 3, qb, (const bf16*)(ws + WS_Q), (const bf16*)(ws + WS_K), (const bf16*)(ws + WS_V), (bf16*)(ws + WS_MIXED), F.a->in[9], lam, F.lds);
        }
    PH_END()
    SEAM(2);
    PH_BEGIN(3)
        const int tid_ = fresh_tid(), lane_ = tid_ & 63, wave_ = __builtin_amdgcn_readfirstlane(tid_ >> 6);
        const int gw = F.bid * 8 + wave_, NGW = F.G * 8;
        for (int t = gw; t < T; t += NGW) {
            const u32x4 a = *(const u32x4*)(ws + WS_HF + ((size_t)t * 512 + lane_ * 8) * 2), b = *(const u32x4*)(ws + WS_HB + ((size_t)t * 512 + lane_ * 8) * 2), gt = *(const u32x4*)(ws + WS_LGATE + ((size_t)t * 512 + lane_ * 8) * 2);
            float y[8];
            y[0] = (bflo(a.x) + bflo(b.x)) * gelu_tanh(bflo(gt.x)); y[1] = (bfhi(a.x) + bfhi(b.x)) * gelu_tanh(bfhi(gt.x));
            y[2] = (bflo(a.y) + bflo(b.y)) * gelu_tanh(bflo(gt.y)); y[3] = (bfhi(a.y) + bfhi(b.y)) * gelu_tanh(bfhi(gt.y));
            y[4] = (bflo(a.z) + bflo(b.z)) * gelu_tanh(bflo(gt.z)); y[5] = (bfhi(a.z) + bfhi(b.z)) * gelu_tanh(bfhi(gt.z));
            y[6] = (bflo(a.w) + bflo(b.w)) * gelu_tanh(bflo(gt.w)); y[7] = (bfhi(a.w) + bfhi(b.w)) * gelu_tanh(bfhi(gt.w));
            float s = 0.f;
#pragma unroll
            for (int j = 0; j < 8; ++j) s += y[j] * y[j];
            const float rstd = 1.0f / sqrtf(wave_sum(s) * (1.0f / 512.0f) + EPS);
            const f32x4 g0 = *(const f32x4*)(F.a->in[17] + lane_ * 8), g1 = *(const f32x4*)(F.a->in[17] + lane_ * 8 + 4);
            u32x4 w = {pk2(y[0] * rstd * g0[0], y[1] * rstd * g0[1]), pk2(y[2] * rstd * g0[2], y[3] * rstd * g0[3]), pk2(y[4] * rstd * g1[0], y[5] * rstd * g1[1]), pk2(y[6] * rstd * g1[2], y[7] * rstd * g1[3])};
            *(u32x4*)(ws + WS_MIXED + ((size_t)t * 1024 + 512 + lane_ * 8) * 2) = w;
        }
    PH_END()
    SEAM(3);
    PH_BEGIN(4)
        pg8::Gemm g{(const bf16*)(ws + WS_MIXED), (const bf16*)(ws + WS_WOUT), T, 1024, 1024}; pg8::StaticOrder S; S.init(T, 1024, F.G, F.bid);
        pg8::EpiResid E{F.a->in[0], (bf16*)(ws + WS_XN), (float*)(ws + WS_SS1)};
        pg8::gemm_phase<pg8::EpiResid, pg8::StaticOrder, true, true>(ldsl, g, S, E);
    PH_END()
    SEAM(4);
    PH_BEGIN(5)
        pg8::Gemm g{(const bf16*)(ws + WS_XN), (const bf16*)(ws + WS_WQ), T, 1024, 1024}; pg8::StaticOrder S; S.init(T, 1024, F.G, F.bid);
        pg8::EpiScaleBf16 E{(bf16*)(ws + WS_QP), (const float*)(ws + WS_SS1), (float*)(ws + WS_MISC + 4096)};
        pg8::gemm_phase<pg8::EpiScaleBf16, pg8::StaticOrder, true, true>(ldsl, g, S, E);
    PH_END()
    SEAM(5);
    PH_BEGIN(6)
        TopkArgs A{(const bf16*)(ws + WS_QP), (const bf16*)(ws + WS_KEYS), (unsigned short*)(ws + WS_IDX), (float*)(ws + WS_GW)};
        bf16x8 kf[4][4];
        { const int tid_ = fresh_tid(), lane_ = tid_ & 63, wave_ = __builtin_amdgcn_readfirstlane(tid_ >> 6); const int half = (wave_ >> 1) & 1, r32 = lane_ & 31, hi5 = lane_ >> 5;
#pragma unroll
          for (int ct = 0; ct < 4; ++ct)
#pragma unroll
            for (int ks = 0; ks < 4; ++ks) kf[ct][ks] = *(const bf16x8*)(A.KEYS + (size_t)half * 8192 + (ct * 32 + r32) * 64 + ks * 16 + hi5 * 8); }
        for (int tile = F.bid; tile < T / 64; tile += F.G) topk_unit(tile, A, kf, F.lds);
    PH_END()
    SEAM(6);
    PeerArgs PA{(const unsigned short*)(ws + WS_IDX), (const bf16*)(ws + WS_XN), (const unsigned char*)(ws + WS_UT), (const unsigned char*)(ws + WS_VT), (float*)(ws + WS_PLOG), (const float*)(ws + WS_ACT), (bf16*)(ws + WS_XN), (float*)(ws + WS_SS2)};
    PH_BEGIN(7)
        if (rep_ > 0 && ((REPMASK >> 16) & 1)) { for (int it = F.bid; it < 8 * (T / 128); it += F.G) peer_u_item<0xfu, ((REPMASK >> 17) & 1)>(it >> 3, it & 7, PA, F.lds); }
        else for (int it = F.bid; it < 8 * (T / 128); it += F.G) peer_u_item<0xffffu, 0>(it >> 3, it & 7, PA, F.lds);
    PH_END()
    SEAM(7);
    PH_BEGIN(8)
        const int tid_ = fresh_tid();
        const long gt = (long)F.bid * 512 + tid_, NGT = (long)F.G * 512;
        const float* plog = (const float*)(ws + WS_PLOG); const float* gwp = (const float*)(ws + WS_GW); float* act = (float*)(ws + WS_ACT);
        for (long i = gt; i < (long)T * 128; i += NGT) {
            const int t = (int)(i >> 7);
            float s = 0.f;
#pragma unroll
            for (int q = 0; q < 8; ++q) s += plog[(size_t)q * T * 128 + i];
            const float rs = ((const float*)(ws + WS_MISC + 4096))[t];
            act[i] = gelu_tanh(s * rs) * gwp[i];
        }
    PH_END()
    SEAM(8);
    PH_BEGIN(9)
        if (rep_ > 0 && ((REPMASK >> 15) & 1)) { for (int it = F.bid; it < 8 * (T / 128); it += F.G) peer_v_item<false, 0xfu>(it >> 3, it & 7, PA, F.lds, 0.0f); }
        else for (int it = F.bid; it < 8 * (T / 128); it += F.G) peer_v_item<true, 0xffffu>(it >> 3, it & 7, PA, F.lds, rep_ > 0 ? 0.0f : 1.0f);
    PH_END()
    SEAM(9);
    PH_BEGIN(10)
        pg8::Gemm g{(const bf16*)(ws + WS_PB), (const bf16*)(ws + WS_WP), T, 1024, 256}; pg8::StaticOrder S; S.init(T, 1024, F.G, F.bid);
        pg8::EpiScaleBf16 E{(bf16*)(ws + WS_QP), nullptr, nullptr};
        pg8::gemm_phase<pg8::EpiScaleBf16, pg8::StaticOrder, true, true>(ldsl, g, S, E);
    PH_END()
    SEAM(10);
    PH_BEGIN(11)
        pg8::Gemm g{(const bf16*)(ws + WS_XN), (const bf16*)(ws + WS_WG), T, 1024, 1024}; pg8::StaticOrder S; S.init(T, 1024, F.G, F.bid);
        pg8::EpiPle E{(const bf16*)(ws + WS_XN), (bf16*)(ws + WS_MIXED), (const bf16*)(ws + WS_QP), (const float*)(ws + WS_SS2), (float*)(ws + WS_SS3), rep_ > 0 ? 0.0f : 1.0f};
        pg8::gemm_phase<pg8::EpiPle, pg8::StaticOrder, true, true>(ldsl, g, S, E);
    PH_END()
    SEAM(11);
    PH_BEGIN(12)
        const int tid_ = fresh_tid(), lane_ = tid_ & 63, wave_ = __builtin_amdgcn_readfirstlane(tid_ >> 6);
        const int gw = F.bid * 8 + wave_, NGW = F.G * 8;
        for (int m = gw; m < T; m += NGW) {
            const float rs = pg8::rowscale16((const float*)(ws + WS_SS3), m);
            const u32x2* hb = (const u32x2*)(ws + WS_MIXED + (size_t)m * 2048) + lane_; const f32x4* gr = (const f32x4*)F.a->in[28] + lane_; f32x4* orow = (f32x4*)(F.a->out + (size_t)m * 1024) + lane_;
#pragma unroll
            for (int j = 0; j < 4; ++j) { const u32x2 w = hb[64 * j]; const f32x4 v = {bflo(w.x), bfhi(w.x), bflo(w.y), bfhi(w.y)}; orow[64 * j] = v * rs * gr[64 * j]; }
        }
    PH_END()
#undef IN
#undef SEAM
}

#ifndef MK_MULTI
#define MK_MULTI 0
#endif
constexpr int NPH = 13;
extern "C" void kernel_launch(void* const* d_in, const int* in_sizes, int n_in, void* d_out, int out_size, void* d_ws, size_t ws_size, hipStream_t stream) {
    static int grid = 0;
    if (grid == 0) {
        if (n_in != 29 || out_size != T * DM || ws_size < WS_END) { fprintf(stderr, "kernel_launch: unexpected shapes: n_in %d out %d ws %zu (need %zu)\n", n_in, out_size, ws_size, (size_t)WS_END); grid = -1; return; }
        int dev = 0, cus = 0, per_cu = 0;
        if (hipGetDevice(&dev) != hipSuccess || hipDeviceGetAttribute(&cus, hipDeviceAttributeMultiprocessorCount, dev) != hipSuccess) { grid = -1; return; }
        if (hipFuncSetAttribute((const void*)enc_fwd, hipFuncAttributeMaxDynamicSharedMemorySize, LDS_BYTES) != hipSuccess) { fprintf(stderr, "kernel_launch: hipFuncSetAttribute failed\n"); grid = -1; return; }
        if (hipOccupancyMaxActiveBlocksPerMultiprocessor(&per_cu, (const void*)enc_fwd, 512, LDS_BYTES) != hipSuccess || per_cu < 1) { fprintf(stderr, "kernel_launch: occupancy query says %d\n", per_cu); per_cu = 1; }
        (void)hipGetLastError();
        grid = cus * 1;
    }
    if (grid < 0) return;
    (void)hipMemsetAsync((char*)d_ws + WS_CTL, 0, CTL_ZERO_BYTES, stream);
    Args a{};
    for (int i = 0; i < 29; ++i) a.in[i] = (const float*)d_in[i];
    a.out = (float*)d_out; a.ws = (unsigned char*)d_ws;
#if MK_MULTI
    for (int ph = 0; ph < NPH; ++ph) { a.ph_lo = ph; a.ph_hi = ph + 1; a.coop = 0; hipLaunchKernelGGL(enc_fwd, dim3(grid), dim3(512), LDS_BYTES, stream, a); }
#else
    a.ph_lo = 0; a.ph_hi = NPH; a.coop = 1;
    void* kargs[] = {&a};
    hipError_t e = hipLaunchCooperativeKernel((const void*)enc_fwd, dim3(grid), dim3(512), kargs, LDS_BYTES, stream);
    if (e != hipSuccess) fprintf(stderr, "cooperative launch failed: %s (grid %d)\n", hipGetErrorString(e), grid);
#endif
}
```

```cpp
#include <hip/hip_runtime.h>
#include <hip/hip_cooperative_groups.h>
#include <cstdio>
#include <cstdint>
namespace cg = cooperative_groups;

#ifndef REPMASK
#define REPMASK 0
#endif
constexpr int NB = 8, SEQ = 4096, T = NB * SEQ, DM = 1024, INC = 2560, PLE = 256;
constexpr float EPS = 1e-6f;
constexpr float LAMBDA_INIT = 0.2f;

__device__ __forceinline__ int fresh_tid() { int t = threadIdx.x; asm volatile("" : "+v"(t)); return t; }

namespace pg8 {
#define PG8_LAS __attribute__((address_space(3)))
typedef unsigned short bf16_t;
typedef short bf16x8 __attribute__((ext_vector_type(8)));
typedef float f32x4 __attribute__((ext_vector_type(4)));
typedef unsigned u32x4 __attribute__((ext_vector_type(4)));
constexpr int BM = 256, BK = 64, HALF = 128, HTB = HALF * BK * 2  , STAGE_BYTES = 8 * HTB, NXCD = 8, WGM = 8;

__host__ __device__ __forceinline__ int lds_byte(int r, int c) { const int st = (r >> 4) * 2 + (c >> 5), rr = r & 15, cc = c & 31, ob = rr * 64 + cc * 2; return st * 1024 + (ob ^ (((ob >> 9) & 1) << 5)); }
__host__ __device__ __forceinline__ void stage_rc(int b, int& R, int& C) { const int st = b / 1024, sb = b % 1024, swz = sb ^ (((sb >> 9) & 1) << 5); R = (st >> 1) * 16 + swz / 64; C = (st & 1) * 32 + (swz % 64) / 2; }
__host__ __device__ __forceinline__ int perm32(int rho) { const int n = rho >> 4, i = rho & 15; return 8 * (i >> 2) + 4 * n + (i & 3); }

struct Unit { int pm, pn; };
struct Gemm { const bf16_t* A; const bf16_t* Bt; int M, N, K; };

struct StaticOrder {
    int nM, nN, nwg, G, c;
    __host__ __device__ void init(int M, int N, int G_, int c_) { nM = M / BM; nN = N / BM; nwg = nM * nN; G = G_; c = c_; }
    __host__ __device__ bool next(int i, Unit& u) const {
        const long L = (long)i * G + c; if (L >= nwg) return false;
        int wgid = (int)L; { const int q = nwg / NXCD, r = nwg % NXCD, xcd = wgid % NXCD, off = wgid / NXCD; wgid = (xcd < r ? xcd * (q + 1) : r * (q + 1) + (xcd - r) * q) + off; }
        const int nig = WGM * nN, gid = wgid / nig, fm = gid * WGM, gsz = (nM - fm) < WGM ? (nM - fm) : WGM;
        u.pm = fm + ((wgid % nig) % gsz); u.pn = (wgid % nig) / gsz; return true;
    }
    __device__ __forceinline__ void a_ready(const Unit&) const {}
    __device__ __forceinline__ void done(const Unit&) const {}
};

__device__ __forceinline__ unsigned cvt_pk_bf16(float lo, float hi) { unsigned r; asm volatile("v_cvt_pk_bf16_f32 %0, %1, %2" : "=v"(r) : "v"(lo), "v"(hi)); return r; }
typedef float f32x2 __attribute__((ext_vector_type(2)));
typedef unsigned u32x2 __attribute__((ext_vector_type(2)));
__device__ __forceinline__ float fsigmoid(float z) { return __builtin_amdgcn_rcpf(1.0f + __expf(-z)); }
__device__ __forceinline__ float rowscale_n(const float* ss, int n) { float s = 0.f; for (int i = 0; i < n; ++i) s += ss[i]; return 1.0f / sqrtf(s * (1.0f / 1024.0f) + 1e-6f); }
__device__ __forceinline__ float rowscale16(const float* ss, int row) { const f32x4* p = (const f32x4*)(ss + (size_t)row * 16); const f32x4 a = p[0], b = p[1], c = p[2], d = p[3];
    const float s = ((a[0] + a[1]) + (a[2] + a[3])) + ((b[0] + b[1]) + (b[2] + b[3])) + ((c[0] + c[1]) + (c[2] + c[3])) + ((d[0] + d[1]) + (d[2] + d[3])); return 1.0f / sqrtf(s * (1.0f / 1024.0f) + 1e-6f); }
__device__ __forceinline__ float rowscale8(const float* ss, int row) { const f32x4* p = (const f32x4*)(ss + (size_t)row * 8); const f32x4 a = p[0], b = p[1];
    const float s = ((a[0] + a[1]) + (a[2] + a[3])) + ((b[0] + b[1]) + (b[2] + b[3])); return 1.0f / sqrtf(s * (1.0f / 1024.0f) + 1e-6f); }
__device__ __forceinline__ u32x4 pack8(f32x4 v0, f32x4 v1) { u32x4 w; w.x = cvt_pk_bf16(v0[0], v0[1]); w.y = cvt_pk_bf16(v0[2], v0[3]); w.z = cvt_pk_bf16(v1[0], v1[1]); w.w = cvt_pk_bf16(v1[2], v1[3]); return w; }
__device__ __forceinline__ float bf_lo(unsigned w) { return __uint_as_float(w << 16); }
__device__ __forceinline__ float bf_hi(unsigned w) { return __uint_as_float(w & 0xffff0000u); }

struct EpiProj {
    static constexpr bool PERM = true, AFTER_DRAIN = false;
    bf16_t* base; const float* rope; unsigned* kmx;
    __device__ __forceinline__ void operator()(const f32x4 (&acc)[2][2][4][2], const Unit& u, int wr, int wc, int fr, int fq) const {
        const int region = u.pn >> 1;
        bf16_t* O = base + (size_t)region * ((size_t)32768 * 512);
        const int colb = (u.pn & 1) * 256 + wc * 32 + 8 * fq;
        const bool rot = (region < 2) && ((wc & 1) == 0);
        const float qs = (region == 0) ? 0.125f * 1.4426950408889634f : 1.0f;
        float kss0 = 0.f, kss1 = 0.f;
        const float sgn = (fq == 0) ? -1.0f : 1.0f;
#pragma unroll
        for (int ai = 0; ai < 2; ++ai)
#pragma unroll
            for (int m = 0; m < 4; ++m) {
                const int row = u.pm * BM + ai * HALF + wr * 64 + m * 16 + fr;
                f32x4 c0 = {1.f, 1.f, 1.f, 1.f}, c1 = c0, s0 = {0.f, 0.f, 0.f, 0.f}, s1 = s0;
                if (rot) { const f32x4* rp = (const f32x4*)(rope + (size_t)row * 16); c0 = rp[0]; c1 = rp[1]; s0 = rp[2]; s1 = rp[3]; }
#pragma unroll
                for (int bj = 0; bj < 2; ++bj) {
                    f32x4 v0 = acc[ai][bj][m][0], v1 = acc[ai][bj][m][1];
                    if (rot) {
                        f32x4 o0, o1;
#pragma unroll
                        for (int j = 0; j < 4; ++j) { o0[j] = __shfl_xor(v0[j], 16); o1[j] = __shfl_xor(v1[j], 16); }
                        if (fq < 2) { v0 = v0 * c0 + (o0 * s0) * sgn; v1 = v1 * c1 + (o1 * s1) * sgn; }
                    }
                    v0 = v0 * qs; v1 = v1 * qs;
                    if (region == 1) { float s = (v0[0] * v0[0] + v0[1] * v0[1]) + (v0[2] * v0[2] + v0[3] * v0[3]) + (v1[0] * v1[0] + v1[1] * v1[1]) + (v1[2] * v1[2] + v1[3] * v1[3]);
                        s += __shfl_xor(s, 16); s += __shfl_xor(s, 32); if (bj == 0) kss0 = fmaxf(kss0, s); else kss1 = fmaxf(kss1, s); }
                    *(u32x4*)(O + (size_t)row * 512 + colb + bj * HALF) = pack8(v0, v1);
                }
            }
        if (region == 1) {
#pragma unroll
            for (int o = 1; o < 16; o <<= 1) { kss0 = fmaxf(kss0, __shfl_xor(kss0, o)); kss1 = fmaxf(kss1, __shfl_xor(kss1, o)); }
            if (fr == 0 && fq == 0) {
                const int b = u.pm >> 4, mp = wc >> 1, half = wc & 1;
                atomicMax(kmx + (((b * 4 + ((u.pn & 1) * 2 + 0)) * 2 + mp) * 2 + half), __float_as_uint(kss0 * 1.02f));
                atomicMax(kmx + (((b * 4 + ((u.pn & 1) * 2 + 1)) * 2 + mp) * 2 + half), __float_as_uint(kss1 * 1.02f));
            }
        }
    }
};
struct EpiResid {
    static constexpr bool PERM = true, AFTER_DRAIN = false;
    const float* X; bf16_t* HB; float* SS;
    __device__ __forceinline__ void operator()(const f32x4 (&acc)[2][2][4][2], const Unit& u, int wr, int wc, int fr, int fq) const {
        const int col0 = u.pn * BM + wc * 32 + 8 * fq;
#pragma unroll
        for (int ai = 0; ai < 2; ++ai)
#pragma unroll
            for (int m = 0; m < 4; ++m) {
                const int row = u.pm * BM + ai * HALF + wr * 64 + m * 16 + fr; float ssq = 0.f;
#pragma unroll
                for (int bj = 0; bj < 2; ++bj) {
                    const size_t off = (size_t)row * 1024 + col0 + bj * HALF;
                    const f32x4 h0 = *(const f32x4*)(X + off) + acc[ai][bj][m][0], h1 = *(const f32x4*)(X + off + 4) + acc[ai][bj][m][1];
                    *(u32x4*)(HB + off) = pack8(h0, h1);
                    ssq += (h0[0] * h0[0] + h0[1] * h0[1]) + (h0[2] * h0[2] + h0[3] * h0[3]) + (h1[0] * h1[0] + h1[1] * h1[1]) + (h1[2] * h1[2] + h1[3] * h1[3]);
                }
                ssq += __shfl_xor(ssq, 16); ssq += __shfl_xor(ssq, 32);
                if (fq == 0) SS[(size_t)row * 16 + u.pn * 4 + wc] = ssq;
            }
    }
};
struct EpiScaleBf16 {
    static constexpr bool PERM = true, AFTER_DRAIN = false;
    bf16_t* O; const float* SS; float* RS;
    __device__ __forceinline__ void operator()(const f32x4 (&acc)[2][2][4][2], const Unit& u, int wr, int wc, int fr, int fq) const {
        const int col0 = u.pn * BM + wc * 32 + 8 * fq;
#pragma unroll
        for (int ai = 0; ai < 2; ++ai)
#pragma unroll
            for (int m = 0; m < 4; ++m) {
                const int row = u.pm * BM + ai * HALF + wr * 64 + m * 16 + fr;
                const float rs = SS ? rowscale16(SS, row) : 1.0f;
                if (RS && u.pn == 0 && wc == 0 && fq == 0) RS[row] = rs;
#pragma unroll
                for (int bj = 0; bj < 2; ++bj) *(u32x4*)(O + (size_t)row * 1024 + col0 + bj * HALF) = pack8(acc[ai][bj][m][0] * rs, acc[ai][bj][m][1] * rs);
            }
    }
};
struct EpiPle {
    static constexpr bool PERM = true, AFTER_DRAIN = false;
    const bf16_t* H2B; bf16_t* H3B; const bf16_t* PP; const float* SS2; float* SS3; float gsc;
    __device__ __forceinline__ void operator()(const f32x4 (&acc)[2][2][4][2], const Unit& u, int wr, int wc, int fr, int fq) const {
        const int col0 = u.pn * BM + wc * 32 + 8 * fq;
#pragma unroll
        for (int ai = 0; ai < 2; ++ai)
#pragma unroll
            for (int m = 0; m < 4; ++m) {
                const int row = u.pm * BM + ai * HALF + wr * 64 + m * 16 + fr; float ssq = 0.f;
                const float rs = rowscale8(SS2, row);
#pragma unroll
                for (int bj = 0; bj < 2; ++bj) {
                    const size_t off = (size_t)row * 1024 + col0 + bj * HALF;
                    const u32x4 pw = *(const u32x4*)(PP + off);
                    const f32x4 p0 = {bf_lo(pw.x), bf_hi(pw.x), bf_lo(pw.y), bf_hi(pw.y)}, p1 = {bf_lo(pw.z), bf_hi(pw.z), bf_lo(pw.w), bf_hi(pw.w)};
                    f32x4 g0, g1;
#pragma unroll
                    for (int j = 0; j < 4; ++j) { g0[j] = fsigmoid(acc[ai][bj][m][0][j] * rs); g1[j] = fsigmoid(acc[ai][bj][m][1][j] * rs); }
                    const u32x4 hw = *(const u32x4*)(H2B + off);
                    const f32x4 r0 = {bf_lo(hw.x), bf_hi(hw.x), bf_lo(hw.y), bf_hi(hw.y)}, r1 = {bf_lo(hw.z), bf_hi(hw.z), bf_lo(hw.w), bf_hi(hw.w)};
                    const f32x4 h0 = r0 + g0 * p0 * gsc, h1 = r1 + g1 * p1 * gsc;
                    *(u32x4*)(H3B + off) = pack8(h0, h1);
                    ssq += (h0[0] * h0[0] + h0[1] * h0[1]) + (h0[2] * h0[2] + h0[3] * h0[3]) + (h1[0] * h1[0] + h1[1] * h1[1]) + (h1[2] * h1[2] + h1[3] * h1[3]);
                }
                ssq += __shfl_xor(ssq, 16); ssq += __shfl_xor(ssq, 32);
                if (fq == 0) SS3[(size_t)row * 16 + u.pn * 4 + wc] = ssq;
            }
    }
};

template <class Epi, class Sched, bool ALIGN_EPI = false, bool SP2 = false>
__device__ __forceinline__ void gemm_phase(PG8_LAS unsigned char* lds, const Gemm g, const Sched& S, const Epi& E) {
    const int tid = fresh_tid(), wid = __builtin_amdgcn_readfirstlane(tid >> 6), lane = tid & 63, wr = wid >> 2, wc = wid & 3, fr = lane & 15, fq = lane >> 4;
    const int K = g.K, nt = K / BK;
    unsigned voffA[2], voffB[2];
#pragma unroll
    for (int i = 0; i < 2; ++i) { int R, C; stage_rc(tid * 16 + i * 8192, R, C); const int Rb = Epi::PERM ? ((R & ~31) + perm32(R & 31)) : R;
        voffA[i] = (unsigned)(R * K + C) * 2u; voffB[i] = (unsigned)(Rb * K + C) * 2u; }
    const size_t kstep = (size_t)(BK * 2);
    const size_t hstep = (size_t)HALF * K * 2;
    const size_t tstep = 2 * hstep;
    const unsigned ldsw = (unsigned)wid * 1024u;
    const int aoff = lds_byte(wr * 64 + fr, fq * 8), boff = lds_byte(wc * 32 + fr, fq * 8);
#define PG8_SA(b, h) (((b) * 2 + (h)) * HTB)
#define PG8_SB(b, h) ((4 + (b) * 2 + (h)) * HTB)
#define PG8_STAGE(bufoff, gbase, voff) do { _Pragma("unroll") for (int _i = 0; _i < 2; ++_i) \
        __builtin_amdgcn_global_load_lds((const unsigned*)((const char*)(gbase) + (voff)[_i]), (PG8_LAS unsigned*)(lds + (bufoff) + ldsw + _i * 8192), 16, 0, 0); } while (0)
#define PG8_LDA(dst, b, h) do { _Pragma("unroll") for (int m = 0; m < 4; ++m) _Pragma("unroll") for (int k = 0; k < 2; ++k) dst[m][k] = *(const PG8_LAS bf16x8*)(lds + PG8_SA(b, h) + aoff + m * 2048 + k * 1024); } while (0)
#define PG8_LDB(dst, b, h) do { _Pragma("unroll") for (int n = 0; n < 2; ++n) _Pragma("unroll") for (int k = 0; k < 2; ++k) dst[n][k] = *(const PG8_LAS bf16x8*)(lds + PG8_SB(b, h) + boff + n * 2048 + k * 1024); } while (0)
#define PG8_MMA(ai, bj, At, Bt) do { __builtin_amdgcn_s_setprio(1); _Pragma("unroll") for (int m = 0; m < 4; ++m) _Pragma("unroll") for (int n = 0; n < 2; ++n) _Pragma("unroll") for (int k = 0; k < 2; ++k) \
        acc[ai][bj][m][n] = __builtin_amdgcn_mfma_f32_16x16x32_bf16(Bt[n][k], At[m][k], acc[ai][bj][m][n], 0, 0, 0); __builtin_amdgcn_s_setprio(0); } while (0)
#define PG8_WAIT_V(n) asm volatile("s_waitcnt vmcnt(" #n ")" ::: "memory")
#define PG8_WAIT_L(n) asm volatile("s_waitcnt lgkmcnt(" #n ")" ::: "memory")
#define PG8_BAR __builtin_amdgcn_s_barrier()
#define PG8_SCHED __builtin_amdgcn_sched_barrier(0)
    Unit cur, nxt; int ui = 0;
    if (!S.next(0, cur)) return;
    f32x4 acc[2][2][4][2];
#pragma unroll
    for (int a = 0; a < 2; ++a)
#pragma unroll
        for (int b = 0; b < 2; ++b)
#pragma unroll
            for (int m = 0; m < 4; ++m)
#pragma unroll
                for (int n = 0; n < 2; ++n) acc[a][b][m][n] = (f32x4){0.f, 0.f, 0.f, 0.f};
    bf16x8 At[4][2], B0[2][2], B1[2][2];
    const char* cA = (const char*)g.A + (size_t)cur.pm * tstep; const char* cB = (const char*)g.Bt + (size_t)cur.pn * tstep;
    S.a_ready(cur);
    if constexpr (SP2) {
        PG8_STAGE(PG8_SB(0, 0), cB, voffB); PG8_STAGE(PG8_SB(0, 1), cB + hstep, voffB); PG8_STAGE(PG8_SA(0, 0), cA, voffA); PG8_STAGE(PG8_SA(0, 1), cA + hstep, voffA);
        if (wr == 1) PG8_BAR;
        PG8_WAIT_V(2); PG8_BAR;
        PG8_STAGE(PG8_SB(1, 0), cB + kstep, voffB); PG8_STAGE(PG8_SA(1, 0), cA + kstep, voffA); PG8_STAGE(PG8_SB(1, 1), cB + hstep + kstep, voffB);
        PG8_WAIT_V(6); PG8_BAR;
    } else {
        PG8_STAGE(PG8_SB(0, 0), cB, voffB); PG8_STAGE(PG8_SA(0, 0), cA, voffA); PG8_STAGE(PG8_SB(0, 1), cB + hstep, voffB); PG8_STAGE(PG8_SA(0, 1), cA + hstep, voffA);
        if (wr == 1) PG8_BAR;
        PG8_WAIT_V(4); PG8_BAR;
        PG8_STAGE(PG8_SB(1, 0), cB + kstep, voffB); PG8_STAGE(PG8_SA(1, 0), cA + kstep, voffA); PG8_STAGE(PG8_SB(1, 1), cB + hstep + kstep, voffB);
        PG8_WAIT_V(6); PG8_BAR;
    }
    for (;;) {
        const bool has_next = S.next(ui + 1, nxt);
        const char* nA = has_next ? (const char*)g.A + (size_t)nxt.pm * tstep : cA; const char* nB = has_next ? (const char*)g.Bt + (size_t)nxt.pn * tstep : cB;
        for (int t = 0; t < nt; t += 2) {
            const bool last = (t == nt - 2);
            const char* a1 = cA + (size_t)(t + 1) * kstep;
            const char* a2 = last ? nA : cA + (size_t)(t + 2) * kstep; const char* b2 = last ? nB : cB + (size_t)(t + 2) * kstep;
            const char* a3 = a2 + kstep; const char* b3 = b2 + kstep;
            if (last && has_next) S.a_ready(nxt);
            if constexpr (SP2) {
            PG8_LDB(B0, 0, 0); PG8_LDB(B1, 0, 1); PG8_SCHED; PG8_LDA(At, 0, 0); PG8_STAGE(PG8_SA(1, 1), a1 + hstep, voffA);
            PG8_WAIT_V(8); PG8_WAIT_L(0); PG8_BAR; PG8_MMA(0, 0, At, B0); PG8_MMA(0, 1, At, B1); PG8_BAR; PG8_SCHED;
            PG8_LDA(At, 0, 1); PG8_STAGE(PG8_SB(0, 0), b2, voffB); PG8_STAGE(PG8_SB(0, 1), b2 + hstep, voffB); PG8_STAGE(PG8_SA(0, 0), a2, voffA);
            PG8_WAIT_V(8); PG8_WAIT_L(0); PG8_BAR; PG8_MMA(1, 0, At, B0); PG8_MMA(1, 1, At, B1); PG8_BAR; PG8_SCHED;
            PG8_LDB(B0, 1, 0); PG8_LDB(B1, 1, 1); PG8_SCHED; PG8_LDA(At, 1, 0); PG8_STAGE(PG8_SA(0, 1), a2 + hstep, voffA);
            PG8_WAIT_V(8); PG8_WAIT_L(0); PG8_BAR; PG8_MMA(0, 0, At, B0); PG8_MMA(0, 1, At, B1); PG8_BAR; PG8_SCHED;
            PG8_LDA(At, 1, 1); PG8_STAGE(PG8_SB(1, 0), b3, voffB); PG8_STAGE(PG8_SB(1, 1), b3 + hstep, voffB); PG8_STAGE(PG8_SA(1, 0), a3, voffA);
            PG8_WAIT_V(8); PG8_WAIT_L(0); PG8_BAR; PG8_MMA(1, 0, At, B0); PG8_MMA(1, 1, At, B1); PG8_BAR; PG8_SCHED;
            } else {
            PG8_LDB(B0, 0, 0); PG8_SCHED; PG8_LDA(At, 0, 0); PG8_STAGE(PG8_SA(1, 1), a1 + hstep, voffA);
            PG8_WAIT_L(8); PG8_BAR; PG8_WAIT_L(0); PG8_MMA(0, 0, At, B0); PG8_BAR; PG8_SCHED;
            PG8_LDB(B1, 0, 1); PG8_STAGE(PG8_SB(0, 0), b2, voffB);
            PG8_BAR; PG8_WAIT_L(0); PG8_MMA(0, 1, At, B1); PG8_BAR;
            PG8_LDA(At, 0, 1); PG8_STAGE(PG8_SA(0, 0), a2, voffA);
            PG8_BAR; PG8_WAIT_L(0); PG8_MMA(1, 0, At, B0); PG8_BAR; PG8_SCHED;
            PG8_STAGE(PG8_SB(0, 1), b2 + hstep, voffB);
            PG8_WAIT_V(6); PG8_BAR; PG8_MMA(1, 1, At, B1); PG8_BAR;
            PG8_LDB(B0, 1, 0); PG8_SCHED; PG8_LDA(At, 1, 0); PG8_STAGE(PG8_SA(0, 1), a2 + hstep, voffA);
            PG8_WAIT_L(8); PG8_BAR; PG8_WAIT_L(0); PG8_MMA(0, 0, At, B0); PG8_BAR; PG8_SCHED;
            PG8_LDB(B1, 1, 1); PG8_STAGE(PG8_SB(1, 0), b3, voffB);
            PG8_BAR; PG8_WAIT_L(0); PG8_MMA(0, 1, At, B1); PG8_BAR;
            PG8_LDA(At, 1, 1); PG8_STAGE(PG8_SA(1, 0), a3, voffA);
            PG8_BAR; PG8_WAIT_L(0); PG8_MMA(1, 0, At, B0); PG8_BAR; PG8_SCHED;
            PG8_STAGE(PG8_SB(1, 1), b3 + hstep, voffB);
            PG8_WAIT_V(6); PG8_BAR; PG8_MMA(1, 1, At, B1); PG8_BAR;
            }
        }
        if constexpr (ALIGN_EPI) { if (wr == 0) PG8_BAR; }
        if constexpr (!Epi::AFTER_DRAIN) { E(acc, cur, wr, wc, fr, fq); S.done(cur); }
        if (!has_next) break;
#pragma unroll
        for (int a = 0; a < 2; ++a)
#pragma unroll
            for (int b = 0; b < 2; ++b)
#pragma unroll
                for (int m = 0; m < 4; ++m)
#pragma unroll
                    for (int n = 0; n < 2; ++n) acc[a][b][m][n] = (f32x4){0.f, 0.f, 0.f, 0.f};
        cur = nxt; cA = nA; cB = nB; ++ui;
        if constexpr (ALIGN_EPI) { if (wr == 1) PG8_BAR; }
    }
    PG8_WAIT_V(0);
    if constexpr (!ALIGN_EPI) { if (wr == 0) PG8_BAR; }
    PG8_BAR;
    if constexpr (Epi::AFTER_DRAIN) { E.fused(acc, cur, wr, wc, fr, fq, lds, wid, lane); S.done(cur); }
#undef PG8_SA
#undef PG8_SB
#undef PG8_STAGE
#undef PG8_LDA
#undef PG8_LDB
#undef PG8_MMA
#undef PG8_WAIT_V
#undef PG8_WAIT_L
#undef PG8_BAR
#undef PG8_SCHED
}
}
namespace att {
using bf16x8 = __attribute__((ext_vector_type(8))) short;
using s16x4  = __attribute__((ext_vector_type(4))) short;
using f32x16 = __attribute__((ext_vector_type(16))) float;
using f32x4  = __attribute__((ext_vector_type(4))) float;
using u32x4  = __attribute__((ext_vector_type(4))) unsigned;
constexpr int NW = 8, QBLK = 32, KVBLK = 64, LDK = 512;
constexpr float THR = 8.f;
constexpr size_t SHM_V = KVBLK * 128 * 2, SHM_K = KVBLK * 128 * 2;
constexpr int OST_LD = 132;
#define KSWZ(row, colB) ((row) * 256 + ((colB) ^ (((row) & 7) << 4)))
#define SBAR() __builtin_amdgcn_sched_barrier(0)
__device__ __forceinline__ int crow(int r, int hi) { return (r & 3) + 8 * (r >> 2) + 4 * hi; }
__device__ __forceinline__ unsigned cvtpk(float lo, float hi) { unsigned r; asm volatile("v_cvt_pk_bf16_f32 %0, %1, %2" : "=v"(r) : "v"(lo), "v"(hi)); return r; }

__device__ __forceinline__ void sumpack(const f32x16& p0, const f32x16& p1, float& l_reg, bf16x8& pa0, bf16x8& pa1, bf16x8& pa2, bf16x8& pa3) {
  float ps = 0;
#pragma unroll
  for (int r = 0; r < 16; ++r) ps += p0[r];
#pragma unroll
  for (int r = 0; r < 16; ++r) ps += p1[r];
  l_reg += ps;
#define PK4(P, BASE, OUT) do { unsigned a0 = cvtpk(P[BASE + 0], P[BASE + 1]), a1 = cvtpk(P[BASE + 2], P[BASE + 3]);   \
    unsigned b0 = cvtpk(P[BASE + 4], P[BASE + 5]), b1 = cvtpk(P[BASE + 6], P[BASE + 7]);                              \
    auto r0 = __builtin_amdgcn_permlane32_swap(a0, b0, false, false); auto r1 = __builtin_amdgcn_permlane32_swap(a1, b1, false, false); \
    u32x4 w = {r0[0], r1[0], r0[1], r1[1]}; OUT = *reinterpret_cast<bf16x8*>(&w); } while (0)
  PK4(p0, 0, pa0); PK4(p0, 8, pa1); PK4(p1, 0, pa2); PK4(p1, 8, pa3);
#undef PK4
}
__device__ __forceinline__ void exp_all(f32x16& p0, f32x16& p1) {
#pragma unroll
  for (int r = 0; r < 16; ++r) p0[r] = __builtin_amdgcn_exp2f(p0[r]);
#pragma unroll
  for (int r = 0; r < 16; ++r) p1[r] = __builtin_amdgcn_exp2f(p1[r]);
}
template <int VAR> __device__ __forceinline__ void qkt(f32x16& p0, f32x16& p1, const char* Ks, const bf16x8* qr, int r32, int hi, int mcolB, const f32x16& negm) {
  p0 = negm; p1 = negm;
#pragma unroll
  for (int d0 = 0; d0 < 4; ++d0) { int cb = mcolB + (d0 * 16 + hi * 8) * 2;
    bf16x8 b0 = *reinterpret_cast<const bf16x8*>(Ks + KSWZ(r32, cb));
    bf16x8 b1 = *reinterpret_cast<const bf16x8*>(Ks + KSWZ(32 + r32, cb));
    if (!(VAR & 4)) { p0 = __builtin_amdgcn_mfma_f32_32x32x16_bf16(b0, qr[d0], p0, 0, 0, 0);
    p1 = __builtin_amdgcn_mfma_f32_32x32x16_bf16(b1, qr[d0], p1, 0, 0, 0); } else asm volatile("" :: "v"(b0), "v"(b1)); }
}
__device__ __forceinline__ int v_st(int k, int c) { const int kk = (k & ~0xC) | ((k & 4) << 1) | ((k & 8) >> 1); return ((kk >> 3) * 4 + (c >> 5)) * 512 + ((kk & 7) * 32 + (c & 31)) * 2; }
__device__ __forceinline__ int v_rd_base(int lane) { return ((lane & 3) << 3) | (((lane >> 2) & 3) << 6) | (((lane >> 4) & 1) << 5) | (((lane >> 5) & 1) << 8); }
constexpr int v_rd_off(int d0, int ks, int half) { return d0 * 512 + ks * 4096 + half * 2048; }
template <int OFF> __device__ __forceinline__ s16x4 tr_read(int vb) {
  s16x4 r; asm volatile("ds_read_b64_tr_b16 %0, %1 offset:%2" : "=&v"(r) : "v"(vb), "i"(OFF) : "memory"); return r;
}
struct VFrag { s16x4 l0, h0, l1, h1, l2, h2, l3, h3; };
template <int D0> __device__ __forceinline__ void v_reads(VFrag& f, int vb) {
  f.l0 = tr_read<v_rd_off(D0, 0, 0)>(vb); f.h0 = tr_read<v_rd_off(D0, 0, 1)>(vb); f.l1 = tr_read<v_rd_off(D0, 1, 0)>(vb); f.h1 = tr_read<v_rd_off(D0, 1, 1)>(vb);
  f.l2 = tr_read<v_rd_off(D0, 2, 0)>(vb); f.h2 = tr_read<v_rd_off(D0, 2, 1)>(vb); f.l3 = tr_read<v_rd_off(D0, 3, 0)>(vb); f.h3 = tr_read<v_rd_off(D0, 3, 1)>(vb);
}
template <int YB, bool EXPS, int VAR> __device__ __forceinline__ void pv_block(f32x16& od, const VFrag& f, bf16x8 pa0, bf16x8 pa1, bf16x8 pa2, bf16x8 pa3, f32x16& y) {
#define PK(L, H) (bf16x8){L[0], L[1], L[2], L[3], H[0], H[1], H[2], H[3]}
#define EX2(i) do { if (EXPS && !(VAR & 1)) { y[YB + 2 * (i)] = __builtin_amdgcn_exp2f(y[YB + 2 * (i)]); y[YB + 2 * (i) + 1] = __builtin_amdgcn_exp2f(y[YB + 2 * (i) + 1]); asm volatile("" : "+v"(y)); } SBAR(); } while (0)
  if (!(VAR & 2)) od = __builtin_amdgcn_mfma_f32_32x32x16_bf16(pa0, PK(f.l0, f.h0), od, 0, 0, 0); else asm volatile("" :: "v"(f.l0), "v"(f.h0), "v"(pa0)); EX2(0);
  if (!(VAR & 2)) od = __builtin_amdgcn_mfma_f32_32x32x16_bf16(pa1, PK(f.l1, f.h1), od, 0, 0, 0); else asm volatile("" :: "v"(f.l1), "v"(f.h1), "v"(pa1)); EX2(1);
  if (!(VAR & 2)) od = __builtin_amdgcn_mfma_f32_32x32x16_bf16(pa2, PK(f.l2, f.h2), od, 0, 0, 0); else asm volatile("" :: "v"(f.l2), "v"(f.h2), "v"(pa2)); EX2(2);
  if (!(VAR & 2)) od = __builtin_amdgcn_mfma_f32_32x32x16_bf16(pa3, PK(f.l3, f.h3), od, 0, 0, 0); else asm volatile("" :: "v"(f.l3), "v"(f.h3), "v"(pa3)); EX2(3);
#undef EX2
#undef PK
}
template <bool EXPS, int VAR> __device__ __forceinline__ void pv_d0(f32x16* o, int vb, bf16x8 pa0, bf16x8 pa1, bf16x8 pa2, bf16x8 pa3, f32x16& y0, f32x16& y1) {
  VFrag fa, fb;
  v_reads<0>(fa, vb); v_reads<1>(fb, vb); asm volatile("s_waitcnt lgkmcnt(8)" ::: "memory"); SBAR(); pv_block<0, EXPS, VAR>(o[0], fa, pa0, pa1, pa2, pa3, y0);
  v_reads<2>(fa, vb); asm volatile("s_waitcnt lgkmcnt(8)" ::: "memory"); SBAR(); pv_block<8, EXPS, VAR>(o[1], fb, pa0, pa1, pa2, pa3, y0);
  v_reads<3>(fb, vb); asm volatile("s_waitcnt lgkmcnt(8)" ::: "memory"); SBAR(); pv_block<0, EXPS, VAR>(o[2], fa, pa0, pa1, pa2, pa3, y1);
  asm volatile("s_waitcnt lgkmcnt(0)" ::: "memory"); SBAR(); pv_block<8, EXPS, VAR>(o[3], fb, pa0, pa1, pa2, pa3, y1);
}

constexpr int A_KRING = 0, A_VRING = 49152, A_WS = 98304, A_SLOT = 16384;
template <int VAR> __device__ __forceinline__ void attn_unit(int b, int h, int qb, const unsigned short* __restrict__ Qb, const unsigned short* __restrict__ Kb, const unsigned short* __restrict__ Vb,
                                          unsigned short* __restrict__ MX, const float* __restrict__ gdn, float lam, const unsigned* __restrict__ kmx, char* lds) {
  const int tid = fresh_tid(), wid = __builtin_amdgcn_readfirstlane(tid >> 6), lane = tid & 63, r32 = lane & 31, hi = lane >> 5;
  const int mp = wid >> 2, qg = wid & 3;
  __attribute__((address_space(3))) unsigned char* ldsl = (__attribute__((address_space(3))) unsigned char*)lds;
  char* K_lds = lds + A_KRING;
  float* ws = (float*)(lds + A_WS) + wid * 64; float* li_l = ws;
  float l_reg = 0; f32x16 o[4] = {}; bf16x8 qr[4];
  const long tok0 = (long)b * 4096;
  const unsigned short* Qw = Qb + (tok0 + qb * 128 + qg * QBLK + r32) * LDK + h * 128 + mp * 64 + hi * 8;
#pragma unroll
  for (int d0 = 0; d0 < 4; ++d0) qr[d0] = *reinterpret_cast<const bf16x8*>(Qw + d0 * 16);
  f32x16 negm;
  { float qn = 0.f;
#pragma unroll
    for (int d0 = 0; d0 < 4; ++d0)
#pragma unroll
      for (int j = 0; j < 8; ++j) { const float v = __uint_as_float(((unsigned)(unsigned short)qr[d0][j]) << 16); qn = fmaf(v, v, qn); }
    { auto rr = __builtin_amdgcn_permlane32_swap(__float_as_uint(qn), __float_as_uint(qn), false, false); qn = __uint_as_float(rr[0]) + __uint_as_float(rr[1]); }
    const unsigned* kp = kmx + ((b * 4 + h) * 2 + mp) * 2;
    const float kn2 = __uint_as_float(kp[0]) + __uint_as_float(kp[1]);
    const float M = sqrtf(qn * kn2) * 1.01f + 0.05f;
#pragma unroll
    for (int r = 0; r < 16; ++r) negm[r] = -M;
    asm volatile("" : "+v"(negm)); }
  const unsigned short* Kh = Kb + tok0 * LDK + h * 128; const unsigned short* Vh = Vb + tok0 * LDK + h * 128;
  const unsigned short* ksrc[2]; const unsigned short* vsrc[2];
#pragma unroll
  for (int i = 0; i < 2; ++i) {
    const int pk = wid * 2 + i;
    { const int row = 4 * pk + (lane >> 4), slot = lane & 15, chunk = slot ^ (row & 7); ksrc[i] = Kh + (long)row * LDK + chunk * 8; }
    { const int st = 2 * pk + (lane >> 5), kk = 8 * (st >> 2) + ((lane & 31) >> 2), c = 32 * (st & 3) + 8 * (lane & 3), k = (kk & ~0xC) | ((kk & 4) << 1) | ((kk & 8) >> 1); vsrc[i] = Vh + (long)k * LDK + c; }
  }
#define DMA_TILE(t, slotoff) do { if (!(VAR & 8)) { _Pragma("unroll") for (int i_ = 0; i_ < 2; ++i_) { \
      __builtin_amdgcn_global_load_lds((const unsigned*)(ksrc[i_] + (long)(t) * KVBLK * LDK), (__attribute__((address_space(3))) unsigned*)(ldsl + A_KRING + (slotoff) + (wid * 2 + i_) * 1024), 16, 0, 0); \
      __builtin_amdgcn_global_load_lds((const unsigned*)(vsrc[i_] + (long)(t) * KVBLK * LDK), (__attribute__((address_space(3))) unsigned*)(ldsl + A_VRING + (slotoff) + (wid * 2 + i_) * 1024), 16, 0, 0); } } } while (0)
#define TILE_SYNC() do { asm volatile("s_waitcnt vmcnt(0)" ::: "memory"); __syncthreads(); } while (0)
  const int vb0 = (int)(uintptr_t)(lds + A_VRING) + v_rd_base(lane);
  const int mcolB = mp * 128;
  f32x16 pA0, pA1, pB0, pB1; bf16x8 pa0, pa1, pa2, pa3; const int NT = 4096 / KVBLK;
  int s_cur = 0, s_nxt = A_SLOT, s_nn = 2 * A_SLOT;
#define ROT() do { const int t_ = s_cur; s_cur = s_nxt; s_nxt = s_nn; s_nn = t_; } while (0)
  DMA_TILE(0, 0); DMA_TILE(1, A_SLOT);
  TILE_SYNC();
  qkt<VAR>(pA0, pA1, K_lds, qr, r32, hi, mcolB, negm); exp_all(pA0, pA1);
#define STEP(X0, X1, Y0, Y1, t) do { TILE_SYNC(); if ((t) + 2 < NT) DMA_TILE((t) + 2, s_nn); \
    SBAR(); qkt<VAR>(Y0, Y1, K_lds + s_nxt, qr, r32, hi, mcolB, negm); sumpack(X0, X1, l_reg, pa0, pa1, pa2, pa3); SBAR(); \
    pv_d0<true, VAR>(o, vb0 + s_cur, pa0, pa1, pa2, pa3, Y0, Y1); ROT(); } while (0)
  int t = 0;
  for (; t + 2 < NT; t += 2) { STEP(pA0, pA1, pB0, pB1, t); STEP(pB0, pB1, pA0, pA1, t + 1); }
  STEP(pA0, pA1, pB0, pB1, NT - 2);
  sumpack(pB0, pB1, l_reg, pa0, pa1, pa2, pa3); SBAR();
  pv_d0<false, VAR>(o, vb0 + s_cur, pa0, pa1, pa2, pa3, pB0, pB1);
#undef STEP
#undef ROT
  { auto rr = __builtin_amdgcn_permlane32_swap(__float_as_uint(l_reg), __float_as_uint(l_reg), false, false); l_reg = __uint_as_float(rr[0]) + __uint_as_float(rr[1]); }
  if (hi == 0) li_l[r32] = l_reg; asm volatile("s_waitcnt lgkmcnt(0)" ::: "memory");
  float rli[16];
#pragma unroll
  for (int r = 0; r < 16; ++r) rli[r] = __builtin_amdgcn_rcpf(li_l[crow(r, hi)]);
  __syncthreads();
  float* Ost = (float*)lds;
  const int rowb = 32 * qg;
  if (mp == 1) {
#pragma unroll
    for (int r = 0; r < 16; ++r)
#pragma unroll
      for (int d0 = 0; d0 < 4; ++d0) Ost[(rowb + crow(r, hi)) * OST_LD + d0 * 32 + r32] = lam * (o[d0][r] * rli[r]);
  }
  __syncthreads();
  if (mp == 0) {
#pragma unroll
    for (int r = 0; r < 16; ++r)
#pragma unroll
      for (int d0 = 0; d0 < 4; ++d0) { const int ix = (rowb + crow(r, hi)) * OST_LD + d0 * 32 + r32; Ost[ix] = o[d0][r] * rli[r] - Ost[ix]; }
  }
  __syncthreads();
  {
    const int row = 16 * wid + (lane >> 2), cb = (lane & 3) * 32;
    f32x4 v[8]; float ss = 0.f;
#pragma unroll
    for (int i = 0; i < 8; ++i) { v[i] = *(const f32x4*)&Ost[row * OST_LD + cb + 4 * i]; ss += (v[i][0] * v[i][0] + v[i][1] * v[i][1]) + (v[i][2] * v[i][2] + v[i][3] * v[i][3]); }
    ss += __shfl_xor(ss, 1); ss += __shfl_xor(ss, 2);
    const float scl = (1.0f - 0.2f) / sqrtf(ss * (1.0f / 128.0f) + 1e-6f);
    unsigned short* op = MX + (tok0 + qb * 128 + row) * 1024 + h * 128 + cb;
#pragma unroll
    for (int i = 0; i < 4; ++i) {
      const f32x4 g0 = *(const f32x4*)(gdn + cb + 8 * i), g1 = *(const f32x4*)(gdn + cb + 8 * i + 4);
      const f32x4 a = v[2 * i] * g0 * scl, c = v[2 * i + 1] * g1 * scl;
      u32x4 w = {cvtpk(a[0], a[1]), cvtpk(a[2], a[3]), cvtpk(c[0], c[1]), cvtpk(c[2], c[3])};
      *(u32x4*)(op + 8 * i) = w;
    }
  }
  __syncthreads();
#undef DMA_TILE
#undef TILE_SYNC
}
#undef KSWZ
#undef SBAR
}

#define LAS __attribute__((address_space(3)))
typedef unsigned short bf16;
typedef float f32x4 __attribute__((ext_vector_type(4)));
typedef float f32x16 __attribute__((ext_vector_type(16)));
typedef short bf16x8 __attribute__((ext_vector_type(8)));
typedef unsigned u32x4 __attribute__((ext_vector_type(4)));
typedef unsigned u32x2 __attribute__((ext_vector_type(2)));
__device__ __forceinline__ unsigned f2bf(float f) { unsigned u = __builtin_bit_cast(unsigned, f); return (u + 0x7fffu + ((u >> 16) & 1u)) >> 16; }
__device__ __forceinline__ unsigned pk2(float lo, float hi) { return f2bf(lo) | (f2bf(hi) << 16); }
__device__ __forceinline__ float bflo(unsigned w) { return __uint_as_float(w << 16); }
__device__ __forceinline__ float bfhi(unsigned w) { return __uint_as_float(w & 0xffff0000u); }
__device__ __forceinline__ float bf1(unsigned short h) { return __uint_as_float(((unsigned)h) << 16); }
__device__ __forceinline__ float sigm(float z) { return __builtin_amdgcn_rcpf(1.0f + __expf(-z)); }
__device__ __forceinline__ float gelu_tanh(float x) { return x * sigm(1.5957691216057308f * (x + 0.044715f * x * x * x)); }
__device__ __forceinline__ float wave_sum(float v) {
#pragma unroll
    for (int o = 1; o < 64; o <<= 1) v += __shfl_xor(v, o);
    return v;
}
__device__ __forceinline__ int crow16(int r, int hi) { return (r & 3) + 8 * (r >> 2) + 4 * hi; }

struct LruArgs { const bf16* LIN; const float* conv_w; const float* conv_b; const bf16* LWT; const float* ba; const float* bx; const float* lam; bf16* HOUT; };
__device__ __forceinline__ void lru_item(int b, int n, int dir, int hh, const LruArgs& A, char* lds) {
    const int tid = fresh_tid(), wid = tid >> 6, lane = tid & 63, r32 = lane & 31, hi = lane >> 5;
    bf16* ucs = (bf16*)lds; float* als = (float*)(lds + 18432); float* mls = (float*)(lds + 34816); float* ils = (float*)(lds + 51200);
    float* cA = (float*)(lds + 67584); float* cH = (float*)(lds + 69632); float* cw = (float*)(lds + 71680);
    const bool fwd = (dir == 0);
    if (tid < 256) cw[tid] = A.conv_w[(tid >> 6) * 512 + n * 64 + (tid & 63)];
    else if (tid < 320) cw[tid] = A.conv_b[n * 64 + (tid - 256)];
    const int rt = wid >> 1, gate = wid & 1;
    bf16x8 wf[4];
    {
        const bf16* wp = A.LWT + ((size_t)((dir * 8 + n) * 2 + gate) * 64 + hh * 32 + r32) * 64 + hi * 8;
#pragma unroll
        for (int ks = 0; ks < 4; ++ks) wf[ks] = *(const bf16x8*)(wp + ks * 16);
    }
    const int cg_ = hh * 32 + r32;
    const float bias = gate ? A.bx[dir * 512 + n * 64 + cg_] : A.ba[dir * 512 + n * 64 + cg_];
    const float spv = -8.0f * log1pf(__expf(-A.lam[dir * 512 + n * 64 + cg_]));
    float state = 0.f;
    const long tokb = (long)b * 4096;
    const int tt = tid >> 2, c0 = (tid & 3) * 16;
    u32x4 in0[4], in1[4];
#define LRU_LOAD(T0) do { _Pragma("unroll") for (int j = 0; j < 4; ++j) { const int s_ = (T0) + tt + j - 2; const bool ok_ = (s_ >= 0 && s_ < 4096); const int sc_ = ok_ ? s_ : 0; \
        in0[j] = *(const u32x4*)(A.LIN + (tokb + sc_) * 512 + n * 64 + c0); in1[j] = *(const u32x4*)(A.LIN + (tokb + sc_) * 512 + n * 64 + c0 + 8); \
        if (!ok_) { in0[j] = (u32x4){0u, 0u, 0u, 0u}; in1[j] = (u32x4){0u, 0u, 0u, 0u}; } } } while (0)
    LRU_LOAD((fwd ? 0 : 31) * 128);
    __syncthreads();
    for (int ci = 0; ci < 32; ++ci) {
        const int t0 = (fwd ? ci : 31 - ci) * 128;
        {
            float accv[16];
#pragma unroll
            for (int i = 0; i < 16; ++i) accv[i] = cw[256 + c0 + i];
#pragma unroll
            for (int j = 0; j < 4; ++j) {
                const u32x4 w0 = in0[j], w1 = in1[j];
                const float* cwj = cw + j * 64 + c0;
                accv[0] += bflo(w0.x) * cwj[0]; accv[1] += bfhi(w0.x) * cwj[1]; accv[2] += bflo(w0.y) * cwj[2]; accv[3] += bfhi(w0.y) * cwj[3];
                accv[4] += bflo(w0.z) * cwj[4]; accv[5] += bfhi(w0.z) * cwj[5]; accv[6] += bflo(w0.w) * cwj[6]; accv[7] += bfhi(w0.w) * cwj[7];
                accv[8] += bflo(w1.x) * cwj[8]; accv[9] += bfhi(w1.x) * cwj[9]; accv[10] += bflo(w1.y) * cwj[10]; accv[11] += bfhi(w1.y) * cwj[11];
                accv[12] += bflo(w1.z) * cwj[12]; accv[13] += bfhi(w1.z) * cwj[13]; accv[14] += bflo(w1.w) * cwj[14]; accv[15] += bfhi(w1.w) * cwj[15];
            }
            u32x4 o0 = {pk2(accv[0], accv[1]), pk2(accv[2], accv[3]), pk2(accv[4], accv[5]), pk2(accv[6], accv[7])};
            u32x4 o1 = {pk2(accv[8], accv[9]), pk2(accv[10], accv[11]), pk2(accv[12], accv[13]), pk2(accv[14], accv[15])};
            *(u32x4*)(ucs + tt * 72 + c0) = o0; *(u32x4*)(ucs + tt * 72 + c0 + 8) = o1;
        }
        if (ci < 31) LRU_LOAD((fwd ? ci + 1 : 30 - ci) * 128);
        __syncthreads();
        {
            f32x16 dg = {};
#pragma unroll
            for (int ks = 0; ks < 4; ++ks) {
                const bf16x8 af = *(const bf16x8*)(ucs + (rt * 32 + r32) * 72 + ks * 16 + hi * 8);
                dg = __builtin_amdgcn_mfma_f32_32x32x16_bf16(af, wf[ks], dg, 0, 0, 0);
            }
            if (gate == 0) {
#pragma unroll
                for (int r = 0; r < 16; ++r) { const int tk = rt * 32 + crow16(r, hi); const float rr = sigm(dg[r] + bias), av = __expf(spv * rr); als[tk * 32 + r32] = av; mls[tk * 32 + r32] = sqrtf(fmaxf(1.0f - av * av, 0.f)); }
            } else {
#pragma unroll
                for (int r = 0; r < 16; ++r) { const int tk = rt * 32 + crow16(r, hi); const float ii = sigm(dg[r] + bias); ils[tk * 32 + r32] = ii * bf1(ucs[tk * 72 + cg_]); }
            }
        }
        __syncthreads();
        {
            const int c = tid & 31, j = tid >> 5;
            float hl[8], Ac[8]; float hv = 0.f, AA = 1.f;
#pragma unroll
            for (int i = 0; i < 8; ++i) { const int p = j * 8 + i, tk = fwd ? p : 127 - p; const float av = als[tk * 32 + c], bv = mls[tk * 32 + c] * ils[tk * 32 + c]; hv = av * hv + bv; AA = AA * av; hl[i] = hv; Ac[i] = AA; }
            cA[j * 32 + c] = AA; cH[j * 32 + c] = hv;
            __syncthreads();
            float s = state, sin_ = state;
#pragma unroll
            for (int jj = 0; jj < 16; ++jj) { if (jj == j) sin_ = s; s = cA[jj * 32 + c] * s + cH[jj * 32 + c]; }
            state = s;
            bf16* outp = A.HOUT + (tokb + t0) * 512 + n * 64 + hh * 32 + c;
#pragma unroll
            for (int i = 0; i < 8; ++i) { const int p = j * 8 + i, tk = fwd ? p : 127 - p; outp[(long)tk * 512] = (bf16)f2bf(hl[i] + Ac[i] * sin_); }
        }
        __syncthreads();
    }
#undef LRU_LOAD
}

__device__ __forceinline__ unsigned mono_key(float f) { const unsigned b = __float_as_uint(f); return b ^ ((unsigned)((int)b >> 31) | 0x80000000u); }
#define TK_INS(L, xin) do { unsigned x_ = (xin); _Pragma("unroll") for (int q_ = 0; q_ < 16; ++q_) { const unsigned t_ = max(L[q_], x_); x_ = min(L[q_], x_); L[q_] = t_; } } while (0)
#define TK_CE(x, y) do { const unsigned h_ = max(x, y), l_ = min(x, y); x = h_; y = l_; } while (0)
__device__ __forceinline__ void tk_sort16(unsigned (&a)[16]) {
    TK_CE(a[0], a[1]); TK_CE(a[2], a[3]); TK_CE(a[0], a[2]); TK_CE(a[1], a[3]); TK_CE(a[1], a[2]); TK_CE(a[4], a[5]); TK_CE(a[6], a[7]); TK_CE(a[4], a[6]);
    TK_CE(a[5], a[7]); TK_CE(a[5], a[6]); TK_CE(a[0], a[4]); TK_CE(a[2], a[6]); TK_CE(a[2], a[4]); TK_CE(a[1], a[5]); TK_CE(a[3], a[7]); TK_CE(a[3], a[5]);
    TK_CE(a[1], a[2]); TK_CE(a[3], a[4]); TK_CE(a[5], a[6]); TK_CE(a[8], a[9]); TK_CE(a[10], a[11]); TK_CE(a[8], a[10]); TK_CE(a[9], a[11]); TK_CE(a[9], a[10]);
    TK_CE(a[12], a[13]); TK_CE(a[14], a[15]); TK_CE(a[12], a[14]); TK_CE(a[13], a[15]); TK_CE(a[13], a[14]); TK_CE(a[8], a[12]); TK_CE(a[10], a[14]); TK_CE(a[10], a[12]);
    TK_CE(a[9], a[13]); TK_CE(a[11], a[15]); TK_CE(a[11], a[13]); TK_CE(a[9], a[10]); TK_CE(a[11], a[12]); TK_CE(a[13], a[14]); TK_CE(a[0], a[8]); TK_CE(a[4], a[12]);
    TK_CE(a[4], a[8]); TK_CE(a[2], a[10]); TK_CE(a[6], a[14]); TK_CE(a[6], a[10]); TK_CE(a[2], a[4]); TK_CE(a[6], a[8]); TK_CE(a[10], a[12]); TK_CE(a[1], a[9]);
    TK_CE(a[5], a[13]); TK_CE(a[5], a[9]); TK_CE(a[3], a[11]); TK_CE(a[7], a[15]); TK_CE(a[7], a[11]); TK_CE(a[3], a[5]); TK_CE(a[7], a[9]); TK_CE(a[11], a[13]);
    TK_CE(a[1], a[2]); TK_CE(a[3], a[4]); TK_CE(a[5], a[6]); TK_CE(a[7], a[8]); TK_CE(a[9], a[10]); TK_CE(a[11], a[12]); TK_CE(a[13], a[14]);
}
__device__ __forceinline__ void tk_merge16(unsigned (&L)[16], const unsigned (&B)[16]) {
#pragma unroll
    for (int i = 0; i < 16; ++i) L[i] = max(L[i], B[15 - i]);
#pragma unroll
    for (int d = 8; d >= 1; d >>= 1)
#pragma unroll
        for (int i = 0; i < 16; ++i) if ((i & d) == 0) TK_CE(L[i], L[i + d]);
}
struct TopkArgs { const bf16* QP; const bf16* KEYS; unsigned short* IDX; float* GW; };
__device__ __forceinline__ void topk_unit(int tile, const TopkArgs& A, const bf16x8 (&kf)[4][4], char* lds) {
    const int tid = fresh_tid(), wid = tid >> 6, lane = tid & 63, r32 = lane & 31, hi = lane >> 5;
    float* sc = (float*)lds; unsigned* sci = (unsigned*)lds;
    const int t0 = tile * 64;
    for (int hp = 0; hp < 4; ++hp) {
        {
            const int combo = wid >> 1, head = 2 * hp + (wid >> 2), half = (wid >> 1) & 1, rtile = wid & 1;
            const bf16* qrow = A.QP + (size_t)(t0 + rtile * 32 + r32) * 1024 + head * 128 + half * 64 + hi * 8;
            bf16x8 af[4];
#pragma unroll
            for (int ks = 0; ks < 4; ++ks) af[ks] = *(const bf16x8*)(qrow + ks * 16);
#pragma unroll
            for (int ct = 0; ct < 4; ++ct) {
                f32x16 d = {};
#pragma unroll
                for (int ks = 0; ks < 4; ++ks) d = __builtin_amdgcn_mfma_f32_32x32x16_bf16(af[ks], kf[ct][ks], d, 0, 0, 0);
#pragma unroll
                for (int r = 0; r < 16; ++r) sc[(combo * 64 + rtile * 32 + crow16(r, hi)) * 132 + ct * 32 + r32] = d[r];
            }
        }
        __syncthreads();
        {
            const int row = tid >> 1, part = tid & 1;
            const float* rowp = sc + row * 132 + part * 64;
            unsigned L[16];
#pragma unroll
            for (int gq = 0; gq < 4; ++gq) {
                unsigned G[16];
#pragma unroll
                for (int i = 0; i < 4; ++i) {
                    const f32x4 v = *(const f32x4*)(rowp + 16 * gq + 4 * i);
#pragma unroll
                    for (int j = 0; j < 4; ++j) G[4 * i + j] = (mono_key(v[j]) & ~127u) | (127u - (unsigned)(part * 64 + 16 * gq + 4 * i + j));
                }
                tk_sort16(G);
                if (gq == 0) {
#pragma unroll
                    for (int q = 0; q < 16; ++q) L[q] = G[q];
                } else tk_merge16(L, G);
            }
            {
                unsigned P[16];
#pragma unroll
                for (int q = 0; q < 16; ++q) P[q] = __shfl_xor(L[q], 1);
                tk_merge16(L, P);
            }
            float vals[16]; unsigned ids[16];
#pragma unroll
            for (int q = 0; q < 16; ++q) { ids[q] = 127u - (L[q] & 127u); vals[q] = sc[row * 132 + ids[q]]; }
            asm volatile("s_waitcnt lgkmcnt(0)" ::: "memory");
            if (part == 0) {
#pragma unroll
                for (int q = 0; q < 16; ++q) { sc[row * 132 + q] = vals[q]; sci[row * 132 + 16 + q] = ids[q]; }
            }
        }
        __syncthreads();
        if (tid < 128) {
            const int tok = tid & 63, hh = tid >> 6;
            const int row1 = (hh * 2 + 0) * 64 + tok, row2 = (hh * 2 + 1) * 64 + tok;
            float v1[16], v2[16];
#pragma unroll
            for (int q = 0; q < 16; ++q) { v1[q] = sc[row1 * 132 + q]; v2[q] = sc[row2 * 132 + q]; }
            unsigned L[16];
#define TK_KEY2(i, j) ((mono_key(v1[i] + v2[j]) & ~255u) | (255u - (unsigned)((i) * 16 + (j))))
#pragma unroll
            for (int j = 0; j < 16; ++j) L[j] = TK_KEY2(0, j);
            tk_sort16(L);
            {
                unsigned G[16] = {TK_KEY2(1, 0), TK_KEY2(1, 1), TK_KEY2(1, 2), TK_KEY2(1, 3), TK_KEY2(1, 4), TK_KEY2(1, 5), TK_KEY2(1, 6), TK_KEY2(1, 7),
                                  TK_KEY2(2, 0), TK_KEY2(2, 1), TK_KEY2(2, 2), TK_KEY2(2, 3), TK_KEY2(2, 4), TK_KEY2(3, 0), TK_KEY2(3, 1), TK_KEY2(3, 2)};
                tk_sort16(G); tk_merge16(L, G);
            }
            {
                unsigned G[16] = {TK_KEY2(3, 3), TK_KEY2(4, 0), TK_KEY2(4, 1), TK_KEY2(4, 2), TK_KEY2(5, 0), TK_KEY2(5, 1), TK_KEY2(6, 0), TK_KEY2(6, 1),
                                  TK_KEY2(7, 0), TK_KEY2(7, 1), TK_KEY2(8, 0), TK_KEY2(9, 0), TK_KEY2(10, 0), TK_KEY2(11, 0), TK_KEY2(12, 0), TK_KEY2(13, 0)};
                tk_sort16(G); tk_merge16(L, G);
            }
            { unsigned k14 = TK_KEY2(14, 0), k15 = TK_KEY2(15, 0); TK_INS(L, k14); TK_INS(L, k15); }
#undef TK_KEY2
            float sv[16]; unsigned ev[16]; float mx = -3.0e38f;
#pragma unroll
            for (int q = 0; q < 16; ++q) {
                const unsigned pos = 255u - (L[q] & 255u), i = pos >> 4, j = pos & 15u;
                sv[q] = sc[row1 * 132 + i] + sc[row2 * 132 + j];
                ev[q] = sci[row1 * 132 + 16 + i] * 128u + sci[row2 * 132 + 16 + j];
                mx = fmaxf(mx, sv[q]);
            }
            float sum = 0.f;
#pragma unroll
            for (int q = 0; q < 16; ++q) { sv[q] = __expf(sv[q] - mx); sum += sv[q]; }
            const float inv = 1.0f / sum;
            const size_t ob = (size_t)(t0 + tok) * 128 + (2 * hp + hh) * 16;
#pragma unroll
            for (int q = 0; q < 16; ++q) { A.IDX[ob + q] = (unsigned short)ev[q]; A.GW[ob + q] = sv[q] * inv; }
        }
        __syncthreads();
    }
}

typedef float f32x2 __attribute__((ext_vector_type(2)));
constexpr float U8_SCALE = 64.0f, V8_SCALE = 16.0f;
struct PeerArgs { const unsigned short* IDX; const bf16* HB; const unsigned char* UT; const unsigned char* VT; float* PLOG; const float* ACT; bf16* H2B; float* SS2; };
#define PEER_EID(i0, i1, g) ((((g) & 1) ? (((g) >> 1) < 4 ? (i0)[((g) >> 1) & 3] : (i1)[((g) >> 1) & 3]) >> 16 : (((g) >> 1) < 4 ? (i0)[((g) >> 1) & 3] : (i1)[((g) >> 1) & 3]) & 0xffffu))
#define PEER_U4(A0, A1, A2, A3, XA, XB, XC, XD, W0a, W0b, W1a, W1b, W2a, W2b, W3a, W3b) do { f32x2 t0_, t1_, t2_, t3_; asm volatile( \
    "v_cvt_pk_f32_fp8_e32 %4, %12\n\tv_cvt_pk_f32_fp8_e32 %5, %14\n\tv_cvt_pk_f32_fp8_e32 %6, %16\n\tv_cvt_pk_f32_fp8_e32 %7, %18\n\t" \
    "v_pk_fma_f32 %0, %4, %8, %0\n\tv_pk_fma_f32 %1, %5, %8, %1\n\tv_pk_fma_f32 %2, %6, %8, %2\n\tv_pk_fma_f32 %3, %7, %8, %3\n\t" \
    "v_cvt_pk_f32_fp8_sdwa %4, %12 src0_sel:WORD_1\n\tv_cvt_pk_f32_fp8_sdwa %5, %14 src0_sel:WORD_1\n\tv_cvt_pk_f32_fp8_sdwa %6, %16 src0_sel:WORD_1\n\tv_cvt_pk_f32_fp8_sdwa %7, %18 src0_sel:WORD_1\n\t" \
    "v_pk_fma_f32 %0, %4, %9, %0\n\tv_pk_fma_f32 %1, %5, %9, %1\n\tv_pk_fma_f32 %2, %6, %9, %2\n\tv_pk_fma_f32 %3, %7, %9, %3\n\t" \
    "v_cvt_pk_f32_fp8_e32 %4, %13\n\tv_cvt_pk_f32_fp8_e32 %5, %15\n\tv_cvt_pk_f32_fp8_e32 %6, %17\n\tv_cvt_pk_f32_fp8_e32 %7, %19\n\t" \
    "v_pk_fma_f32 %0, %4, %10, %0\n\tv_pk_fma_f32 %1, %5, %10, %1\n\tv_pk_fma_f32 %2, %6, %10, %2\n\tv_pk_fma_f32 %3, %7, %10, %3\n\t" \
    "v_cvt_pk_f32_fp8_sdwa %4, %13 src0_sel:WORD_1\n\tv_cvt_pk_f32_fp8_sdwa %5, %15 src0_sel:WORD_1\n\tv_cvt_pk_f32_fp8_sdwa %6, %17 src0_sel:WORD_1\n\tv_cvt_pk_f32_fp8_sdwa %7, %19 src0_sel:WORD_1\n\t" \
    "v_pk_fma_f32 %0, %4, %11, %0\n\tv_pk_fma_f32 %1, %5, %11, %1\n\tv_pk_fma_f32 %2, %6, %11, %2\n\tv_pk_fma_f32 %3, %7, %11, %3" \
    : "+v"(A0), "+v"(A1), "+v"(A2), "+v"(A3), "=&v"(t0_), "=&v"(t1_), "=&v"(t2_), "=&v"(t3_) \
    : "v"(XA), "v"(XB), "v"(XC), "v"(XD), "v"(W0a), "v"(W0b), "v"(W1a), "v"(W1b), "v"(W2a), "v"(W2b), "v"(W3a), "v"(W3b)); } while (0)
#define PEER_V4(C0, C1, C2, C3, AV2, Wa, Wb) do { f32x2 t0_, t1_, t2_, t3_; asm volatile( \
    "v_cvt_pk_f32_fp8_e32 %4, %9\n\tv_cvt_pk_f32_fp8_sdwa %5, %9 src0_sel:WORD_1\n\tv_cvt_pk_f32_fp8_e32 %6, %10\n\tv_cvt_pk_f32_fp8_sdwa %7, %10 src0_sel:WORD_1\n\t" \
    "v_pk_fma_f32 %0, %4, %8, %0\n\tv_pk_fma_f32 %1, %5, %8, %1\n\tv_pk_fma_f32 %2, %6, %8, %2\n\tv_pk_fma_f32 %3, %7, %8, %3" \
    : "+v"(C0), "+v"(C1), "+v"(C2), "+v"(C3), "=&v"(t0_), "=&v"(t1_), "=&v"(t2_), "=&v"(t3_) : "v"(AV2), "v"(Wa), "v"(Wb)); } while (0)
struct XPairs { f32x2 x0, x1, x2, x3, x4, x5, x6, x7; };
__device__ __forceinline__ XPairs peer_xpairs(const u32x4 xa, const u32x4 xb) {
    XPairs X; X.x0 = (f32x2){bflo(xa.x), bfhi(xa.x)}; X.x1 = (f32x2){bflo(xa.y), bfhi(xa.y)}; X.x2 = (f32x2){bflo(xa.z), bfhi(xa.z)}; X.x3 = (f32x2){bflo(xa.w), bfhi(xa.w)};
    X.x4 = (f32x2){bflo(xb.x), bfhi(xb.x)}; X.x5 = (f32x2){bflo(xb.y), bfhi(xb.y)}; X.x6 = (f32x2){bflo(xb.z), bfhi(xb.z)}; X.x7 = (f32x2){bflo(xb.w), bfhi(xb.w)}; return X;
}
__device__ __forceinline__ void peer_dots16(float (&p)[16], const XPairs& X, const u32x4 (&u)[16]) {
#pragma unroll
    for (int q = 0; q < 4; ++q) {
        f32x2 a0 = {0.f, 0.f}, a1 = a0, a2 = a0, a3 = a0;
        unsigned w0x = u[4 * q].x, w0y = u[4 * q].y, w0z = u[4 * q].z, w0w = u[4 * q].w, w1x = u[4 * q + 1].x, w1y = u[4 * q + 1].y, w1z = u[4 * q + 1].z, w1w = u[4 * q + 1].w;
        unsigned w2x = u[4 * q + 2].x, w2y = u[4 * q + 2].y, w2z = u[4 * q + 2].z, w2w = u[4 * q + 2].w, w3x = u[4 * q + 3].x, w3y = u[4 * q + 3].y, w3z = u[4 * q + 3].z, w3w = u[4 * q + 3].w;
        PEER_U4(a0, a1, a2, a3, X.x0, X.x1, X.x2, X.x3, w0x, w0y, w1x, w1y, w2x, w2y, w3x, w3y);
        PEER_U4(a0, a1, a2, a3, X.x4, X.x5, X.x6, X.x7, w0z, w0w, w1z, w1w, w2z, w2w, w3z, w3w);
        p[4 * q] = a0.x + a0.y; p[4 * q + 1] = a1.x + a1.y; p[4 * q + 2] = a2.x + a2.y; p[4 * q + 3] = a3.x + a3.y;
    }
}
__device__ __forceinline__ void peer_u_reduce_store(float (&p)[16], int c, float* po) {
#pragma unroll
    for (int i = 0; i < 8; ++i) { const bool up = (c & 4) != 0; const float give = up ? p[i] : p[i + 8]; const float keep = up ? p[i + 8] : p[i]; p[i] = keep + __shfl_xor(give, 4); }
#pragma unroll
    for (int i = 0; i < 4; ++i) { const bool up = (c & 2) != 0; const float give = up ? p[i] : p[i + 4]; const float keep = up ? p[i + 4] : p[i]; p[i] = keep + __shfl_xor(give, 2); }
#pragma unroll
    for (int i = 0; i < 2; ++i) { const bool up = (c & 1) != 0; const float give = up ? p[i] : p[i + 2]; const float keep = up ? p[i + 2] : p[i]; p[i] = keep + __shfl_xor(give, 1); }
    f32x2 o = {p[0] * (1.0f / U8_SCALE), p[1] * (1.0f / U8_SCALE)};
    *(f32x2*)po = o;
}
template <unsigned IDMASK, int MODE> __device__ __forceinline__ void peer_u_item(int tile, int s, const PeerArgs& A, char* lds) {
    const int tid = fresh_tid(), wid = tid >> 6, lane = tid & 63, j8 = lane >> 3, c = lane & 7;
    const unsigned char* ut = A.UT + (size_t)s * (16384 * 128) + c * 16;
    for (int grp = 0; grp < 2; ++grp) {
        const int t = tile * 128 + wid * 16 + grp * 8 + j8;
        const unsigned short* ip = A.IDX + (size_t)t * 128;
        const bf16* xp = A.HB + (size_t)t * 1024 + s * 128 + c * 16;
        float* pl = A.PLOG + ((size_t)s * T + t) * 128 + 2 * c;
        const u32x4 xa = *(const u32x4*)xp, xb = *(const u32x4*)(xp + 8);
        const XPairs X = peer_xpairs(xa, xb);
        u32x4 i0 = *(const u32x4*)ip, i1 = *(const u32x4*)(ip + 8);
#pragma unroll 1
        for (int hd = 0; hd < 8; ++hd) {
            u32x4 n0 = i0, n1 = i1;
            if (hd < 7) { n0 = *(const u32x4*)(ip + (hd + 1) * 16); n1 = *(const u32x4*)(ip + (hd + 1) * 16 + 8); }
            u32x4 uw[16];
#pragma unroll
            for (int g = 0; g < 16; ++g) uw[g] = *(const u32x4*)(ut + (size_t)(PEER_EID(i0, i1, g) & IDMASK) * 128);
            asm volatile("" ::: "memory"); __builtin_amdgcn_sched_barrier(0);
            float p[16];
            if (MODE == 0) peer_dots16(p, X, uw);
            else { _Pragma("unroll") for (int g = 0; g < 16; ++g) p[g] = __uint_as_float((uw[g].x ^ uw[g].y) ^ (uw[g].z ^ uw[g].w) ^ xa.x ^ xb.x); }
            peer_u_reduce_store(p, c, pl + hd * 16);
            i0 = n0; i1 = n1;
        }
    }
}
__device__ __forceinline__ void peer_v_accum(f32x2 (&acc)[8], const u32x4 (&vw)[16], const f32x4 a0, const f32x4 a1, const f32x4 a2, const f32x4 a3) {
#pragma unroll
    for (int j = 0; j < 8; ++j) acc[j] = (f32x2){0.f, 0.f};
#pragma unroll
    for (int g = 0; g < 16; ++g) {
        const float av = (g < 4) ? a0[g & 3] : (g < 8) ? a1[g & 3] : (g < 12) ? a2[g & 3] : a3[g & 3];
        const f32x2 av2 = {av, av};
        unsigned wx = vw[g].x, wy = vw[g].y, wz = vw[g].z, ww = vw[g].w;
        PEER_V4(acc[0], acc[1], acc[2], acc[3], av2, wx, wy);
        PEER_V4(acc[4], acc[5], acc[6], acc[7], av2, wz, ww);
    }
}
template <bool HMEM, unsigned IDMASK, int VMODE> __device__ __forceinline__ void peer_v_item(int tile, int s, const PeerArgs& A, char* lds, float vscale) {
    const int tid = fresh_tid(), wid = tid >> 6, lane = tid & 63, j8 = lane >> 3, c = lane & 7;
    const unsigned char* vt = A.VT + (size_t)s * (16384 * 128) + c * 16;
    const float vs = vscale * (1.0f / V8_SCALE);
    for (int grp = 0; grp < 2; ++grp) {
        const int t = tile * 128 + wid * 16 + grp * 8 + j8;
        const unsigned short* ip = A.IDX + (size_t)t * 128;
        const float* ap = A.ACT + (size_t)t * 128;
        bf16* hbp = A.H2B + (size_t)t * 1024 + s * 128 + c * 16;
        const u32x4 hw0 = *(const u32x4*)hbp, hw1 = *(const u32x4*)(hbp + 8);
        f32x2 acc[8];
#pragma unroll
        for (int j = 0; j < 8; ++j) acc[j] = (f32x2){0.f, 0.f};
        u32x4 i0 = *(const u32x4*)ip, i1 = *(const u32x4*)(ip + 8);
#pragma unroll 1
        for (int hd = 0; hd < 8; ++hd) {
            u32x4 n0 = i0, n1 = i1;
            if (hd < 7) { n0 = *(const u32x4*)(ip + (hd + 1) * 16); n1 = *(const u32x4*)(ip + (hd + 1) * 16 + 8); }
            const f32x4 a0 = *(const f32x4*)(ap + hd * 16), a1 = *(const f32x4*)(ap + hd * 16 + 4), a2 = *(const f32x4*)(ap + hd * 16 + 8), a3 = *(const f32x4*)(ap + hd * 16 + 12);
            u32x4 vw[16];
#pragma unroll
            for (int g = 0; g < 16; ++g) vw[g] = *(const u32x4*)(vt + (size_t)(PEER_EID(i0, i1, g) & IDMASK) * 128);
            asm volatile("" ::: "memory"); __builtin_amdgcn_sched_barrier(0);
#pragma unroll
            for (int g = 0; g < 16; ++g) {
                const float av = (g < 4) ? a0[g & 3] : (g < 8) ? a1[g & 3] : (g < 12) ? a2[g & 3] : a3[g & 3];
                const f32x2 av2 = {av, av};
                unsigned wx = vw[g].x, wy = vw[g].y, wz = vw[g].z, ww = vw[g].w;
                PEER_V4(acc[0], acc[1], acc[2], acc[3], av2, wx, wy);
                PEER_V4(acc[4], acc[5], acc[6], acc[7], av2, wz, ww);
            }
            i0 = n0; i1 = n1;
        }
        f32x4 h[4];
        h[0] = (f32x4){bflo(hw0.x), bfhi(hw0.x), bflo(hw0.y), bfhi(hw0.y)}; h[1] = (f32x4){bflo(hw0.z), bfhi(hw0.z), bflo(hw0.w), bfhi(hw0.w)};
        h[2] = (f32x4){bflo(hw1.x), bfhi(hw1.x), bflo(hw1.y), bfhi(hw1.y)}; h[3] = (f32x4){bflo(hw1.z), bfhi(hw1.z), bflo(hw1.w), bfhi(hw1.w)};
        float ssq = 0.f;
#pragma unroll
        for (int q = 0; q < 4; ++q) { h[q][0] += vs * acc[2 * q].x; h[q][1] += vs * acc[2 * q].y; h[q][2] += vs * acc[2 * q + 1].x; h[q][3] += vs * acc[2 * q + 1].y;
            ssq += (h[q][0] * h[q][0] + h[q][1] * h[q][1]) + (h[q][2] * h[q][2] + h[q][3] * h[q][3]); }
        const u32x4 w0 = {pk2(h[0][0], h[0][1]), pk2(h[0][2], h[0][3]), pk2(h[1][0], h[1][1]), pk2(h[1][2], h[1][3])}, w1 = {pk2(h[2][0], h[2][1]), pk2(h[2][2], h[2][3]), pk2(h[3][0], h[3][1]), pk2(h[3][2], h[3][3])};
        *(u32x4*)hbp = w0; *(u32x4*)(hbp + 8) = w1;
        ssq += __shfl_xor(ssq, 1); ssq += __shfl_xor(ssq, 2); ssq += __shfl_xor(ssq, 4);
        if (c == 0) A.SS2[(size_t)t * 8 + s] = ssq;
    }
}

#define XB_TMO      128
#define XB_XCNT(j)  (256  + 64 * (j))
#define XB_XSUB(j)  (1280 + 64 * (j))
#define XB_XGEN(j)  (2304 + 64 * (j))
#define XB_TOP      3328
#define XB_TOPGEN   3392
#define XCD_BAR_WORDS 3456
#define XB_SPIN_CAP (1u << 18)

__device__ __forceinline__ unsigned xb_ld(unsigned* p)              { return __hip_atomic_load(p, __ATOMIC_RELAXED, __HIP_MEMORY_SCOPE_AGENT); }
__device__ __forceinline__ unsigned xb_add(unsigned* p, unsigned v) { return __hip_atomic_fetch_add(p, v, __ATOMIC_RELAXED, __HIP_MEMORY_SCOPE_AGENT); }
__device__ __forceinline__ unsigned xb_xcc_id() { return (unsigned)__builtin_amdgcn_s_getreg((3 << 11) | 20) & 0xFu; }
#define XB_SPIN(cond, bar) do { unsigned _sp = 0; while (cond) { __builtin_amdgcn_s_sleep(1); \
    if ((++_sp & 255u) == 0u) { if (xb_ld(&(bar)[XB_TMO])) break; if (_sp > XB_SPIN_CAP) { atomicAdd(&(bar)[XB_TMO], 1u); break; } } } } while (0)

struct XcdBarrier {
    unsigned* bar; unsigned x;
    volatile LAS unsigned* st;
};

__device__ __forceinline__ XcdBarrier xcd_barrier_post(unsigned* bar, volatile LAS unsigned* st) {
    XcdBarrier b; b.bar = bar; b.x = xb_xcc_id(); b.st = st;
    if (threadIdx.x == 0) (void)xb_add(&bar[XB_XCNT(b.x)], 1u);
    return b;
}
__device__ __forceinline__ void xcd_barrier_complete(unsigned* bar, unsigned x, unsigned& nloc, unsigned& nx) {
    const unsigned G = gridDim.x * gridDim.y * gridDim.z;
    unsigned sum, cnt, mine, sp = 0u;
    for (;;) {
        sum = 0u; cnt = 0u; mine = 0u;
#pragma unroll
        for (unsigned j = 0; j < 16; ++j) { const unsigned c = xb_ld(&bar[XB_XCNT(j)]); sum += c; cnt += (c > 0u) ? 1u : 0u; mine = (j == x) ? c : mine; }
        if (sum == G) break;
        __builtin_amdgcn_s_sleep(1);
        if ((++sp & 255u) == 0u) { if (xb_ld(&bar[XB_TMO])) break; if (sp > XB_SPIN_CAP) { atomicAdd(&bar[XB_TMO], 1u); break; } }
    }
    nloc = mine > 0u ? mine : 1u; nx = cnt > 0u ? cnt : 1u;
}

__device__ __forceinline__ void xcd_barrier(const XcdBarrier& b) {
    asm volatile("s_waitcnt vmcnt(0)" ::: "memory");
    __syncthreads();
    if (threadIdx.x == 0) {
        unsigned* bar = b.bar;
        __builtin_amdgcn_s_waitcnt(0);
        unsigned nloc = b.st[0], nx = b.st[1];
        if (nloc == 0u) { xcd_barrier_complete(bar, b.x, nloc, nx); b.st[0] = nloc; b.st[1] = nx; }
        const unsigned old = xb_add(&bar[XB_XSUB(b.x)], 1u);
        const unsigned gen = old / nloc;
        if (old + 1u == (gen + 1u) * nloc) {
            __builtin_amdgcn_fence(__ATOMIC_RELEASE, "agent");
            asm volatile("s_waitcnt vmcnt(0)" ::: "memory");
            const unsigned og = xb_add(&bar[XB_TOP], 1u);
            const unsigned tg = og / nx;
            if (og + 1u == (tg + 1u) * nx) xb_add(&bar[XB_TOPGEN], 1u);
            else XB_SPIN(xb_ld(&bar[XB_TOPGEN]) == tg, bar);
            __builtin_amdgcn_fence(__ATOMIC_ACQUIRE, "agent");
            xb_add(&bar[XB_XGEN(b.x)], 1u);
            asm volatile("s_waitcnt vmcnt(0)" ::: "memory");
        } else {
            XB_SPIN(xb_ld(&bar[XB_XGEN(b.x)]) == gen, bar);
            __builtin_amdgcn_fence(__ATOMIC_ACQUIRE, "agent");
            asm volatile("s_waitcnt vmcnt(0)" ::: "memory");
        }
    }
    __syncthreads();
}
#ifndef ATTVAR
#define ATTVAR 0
#endif
constexpr size_t MiB = (size_t)1 << 20;
constexpr size_t WS_CTL = 0, CTL_ZERO_BYTES = 1 * MiB;
constexpr size_t WS_WIN = 1 * MiB, WS_WOUT = 6 * MiB, WS_WQ = 8 * MiB, WS_WG = 10 * MiB, WS_WP = 12 * MiB;
constexpr size_t WS_KEYS = 12 * MiB + 512 * 1024, WS_LWT = 12 * MiB + 768 * 1024, WS_ROPE = 13 * MiB, WS_MISC = 15 * MiB;
constexpr size_t WS_SS1 = 16 * MiB, WS_SS2 = 18 * MiB, WS_SS3 = 20 * MiB;
constexpr size_t WS_IDX = 24 * MiB, WS_GW = 32 * MiB, WS_PB = 48 * MiB;
constexpr size_t WS_UT = 64 * MiB, WS_VT = 96 * MiB;
constexpr size_t WS_XN = 128 * MiB;
constexpr size_t WS_Q = 192 * MiB, WS_K = 224 * MiB, WS_V = 256 * MiB, WS_LIN = 288 * MiB, WS_LGATE = 320 * MiB;
constexpr size_t WS_QP = 192 * MiB;
constexpr size_t WS_MIXED = 352 * MiB, WS_HF = 416 * MiB, WS_HB = 448 * MiB;
constexpr size_t WS_PLOG = 352 * MiB;
constexpr size_t WS_ACT = 256 * MiB;
constexpr size_t WS_END = 480 * MiB;
constexpr int LDS_BYTES = 147456;

struct Args {
    const float* in[29]; float* out; unsigned char* ws; int ph_lo, ph_hi, coop, pad;
};
struct Frame { char* lds; int G, bid; const Args* a; unsigned char* ws; };


__device__ __forceinline__ void p0_transpose_item(const float* W, int K, int N, bf16* WT, const float* gk, float* scr, int item, int lane) {
    const int nblk = N / 32, kb = item / nblk, nb = item % nblk, k0 = 64 * kb, n0 = 32 * nb;
#pragma unroll 8
    for (int i = 0; i < 32; ++i) { const int kk = 2 * i + (lane >> 5); float w = W[(size_t)(k0 + kk) * N + n0 + (lane & 31)]; if (gk) w *= gk[k0 + kk]; scr[kk * 33 + (lane & 31)] = w; }
    asm volatile("s_waitcnt lgkmcnt(0)" ::: "memory");
    const int c = lane & 7;
#pragma unroll
    for (int j = 0; j < 4; ++j) { const int n = (lane >> 3) + 8 * j; const float* s = scr + (8 * c) * 33 + n;
        u32x4 o; o.x = pk2(s[0 * 33], s[1 * 33]); o.y = pk2(s[2 * 33], s[3 * 33]); o.z = pk2(s[4 * 33], s[5 * 33]); o.w = pk2(s[6 * 33], s[7 * 33]);
        *(u32x4*)(WT + (size_t)(n0 + n) * K + k0 + 8 * c) = o; }
    asm volatile("s_waitcnt lgkmcnt(0)" ::: "memory");
}
__device__ __forceinline__ void p0_prologue(Frame& F) {
    const int tid_ = fresh_tid(), lane_ = tid_ & 63, wave_ = __builtin_amdgcn_readfirstlane(tid_ >> 6);
    float* scr = (float*)(F.lds + wave_ * 16384);
    const int gw = F.bid * 8 + wave_, NGW = F.G * 8;
    const long gt = (long)F.bid * 512 + tid_, NGT = (long)F.G * 512;
    unsigned char* ws = F.ws;
    constexpr int I_IN = 16 * 80, I_SQ = 16 * 32, I_P = 4 * 32;
    for (int it = gw; it < I_IN + 3 * I_SQ + I_P; it += NGW) {
        int r = it;
        if (r < I_IN) { p0_transpose_item(F.a->in[4], 1024, 2560, (bf16*)(ws + WS_WIN), nullptr, scr, r, lane_); continue; } r -= I_IN;
        if (r < I_SQ) { p0_transpose_item(F.a->in[18], 1024, 1024, (bf16*)(ws + WS_WOUT), nullptr, scr, r, lane_); continue; } r -= I_SQ;
        if (r < I_SQ) { p0_transpose_item(F.a->in[20], 1024, 1024, (bf16*)(ws + WS_WQ), F.a->in[19], scr, r, lane_); continue; } r -= I_SQ;
        if (r < I_SQ) { p0_transpose_item(F.a->in[26], 1024, 1024, (bf16*)(ws + WS_WG), F.a->in[25], scr, r, lane_); continue; } r -= I_SQ;
        p0_transpose_item(F.a->in[27], 256, 1024, (bf16*)(ws + WS_WP), nullptr, scr, r, lane_);
    }
    for (int m = gw; m < T; m += NGW) {
        const f32x4* xr = (const f32x4*)(F.a->in[0] + (size_t)m * 1024) + lane_; const f32x4* gr = (const f32x4*)F.a->in[3] + lane_;
        f32x4 v[4]; float s = 0.f;
#pragma unroll
        for (int j = 0; j < 4; ++j) { v[j] = xr[64 * j]; s += (v[j][0] * v[j][0] + v[j][1] * v[j][1]) + (v[j][2] * v[j][2] + v[j][3] * v[j][3]); }
        const float rstd = 1.0f / sqrtf(wave_sum(s) * (1.0f / 1024.0f) + EPS);
        u32x2* o8 = (u32x2*)(ws + WS_XN + (size_t)m * 2048) + lane_;
#pragma unroll
        for (int j = 0; j < 4; ++j) { const f32x4 g = gr[64 * j]; u32x2 w = {pk2(v[j][0] * rstd * g[0], v[j][1] * rstd * g[1]), pk2(v[j][2] * rstd * g[2], v[j][3] * rstd * g[3])}; o8[64 * j] = w; }
    }
    for (long i = gt; i < (long)T * PLE / 8; i += NGT) {
        const f32x4 a = *(const f32x4*)(F.a->in[1] + i * 8), b = *(const f32x4*)(F.a->in[1] + i * 8 + 4);
        u32x4 w = {pk2(a[0], a[1]), pk2(a[2], a[3]), pk2(b[0], b[1]), pk2(b[2], b[3])}; *(u32x4*)(ws + WS_PB + i * 16) = w;
    }
    for (long i = gt; i < (long)16384 * 1024 / 16; i += NGT) {
        const int c0 = (int)((i * 16) & 1023);
        unsigned wu[4], wv[4];
#pragma unroll
        for (int q = 0; q < 4; ++q) {
            const f32x4 a = *(const f32x4*)(F.a->in[23] + i * 16 + 4 * q), g = *(const f32x4*)(F.a->in[19] + c0 + 4 * q), v = *(const f32x4*)(F.a->in[24] + i * 16 + 4 * q);
            int w = 0;
            w = __builtin_amdgcn_cvt_pk_fp8_f32(fminf(fmaxf(a[0] * g[0] * U8_SCALE, -448.f), 448.f), fminf(fmaxf(a[1] * g[1] * U8_SCALE, -448.f), 448.f), w, false);
            w = __builtin_amdgcn_cvt_pk_fp8_f32(fminf(fmaxf(a[2] * g[2] * U8_SCALE, -448.f), 448.f), fminf(fmaxf(a[3] * g[3] * U8_SCALE, -448.f), 448.f), w, true);
            wu[q] = (unsigned)w;
            int w2 = 0;
            w2 = __builtin_amdgcn_cvt_pk_fp8_f32(fminf(fmaxf(v[0] * V8_SCALE, -448.f), 448.f), fminf(fmaxf(v[1] * V8_SCALE, -448.f), 448.f), w2, false);
            w2 = __builtin_amdgcn_cvt_pk_fp8_f32(fminf(fmaxf(v[2] * V8_SCALE, -448.f), 448.f), fminf(fmaxf(v[3] * V8_SCALE, -448.f), 448.f), w2, true);
            wv[q] = (unsigned)w2;
        }
        u32x4 ou = {wu[0], wu[1], wu[2], wu[3]}, ov = {wv[0], wv[1], wv[2], wv[3]};
        { const size_t ee = (size_t)(i >> 6), sl = (size_t)((i >> 3) & 7), ch = (size_t)(i & 7), off = sl * (16384 * 128) + ee * 128 + ch * 16;
          *(u32x4*)(ws + WS_UT + off) = ou; *(u32x4*)(ws + WS_VT + off) = ov; }
    }
    for (long i = gt; i < (long)T * 8; i += NGT) {
        const int t = (int)(i >> 3), k = (int)(i & 7);
        const float invf[8] = {1.0f, 0.19392274474868576f, 0.03760603093086393f, 0.007292664737217109f, 0.001414213562373095f, 0.0002742481756762073f, 5.318295896944988e-05f, 1.031338537721246e-05f};
        float fr = 1.0f;
#pragma unroll
        for (int q = 0; q < 8; ++q) if (q == k) fr = invf[q];
        const float ang = (float)((const int*)F.a->in[2])[t] * fr; float sn, cs; sincosf(ang, &sn, &cs);
        float* rp = (float*)(ws + WS_ROPE) + (size_t)t * 16; rp[k] = cs; rp[8 + k] = sn;
    }
    for (long i = gt; i < 2 * 8192; i += NGT) { const float v = (i < 8192) ? F.a->in[21][i] : F.a->in[22][i - 8192]; ((bf16*)(ws + WS_KEYS))[i] = (bf16)f2bf(v); }
    for (long i = gt; i < 2 * 8 * 2 * 64 * 64; i += NGT) {
        const int c = (int)(i & 63), e = (int)((i >> 6) & 63), gate = (int)((i >> 12) & 1), n = (int)((i >> 13) & 7), dir = (int)(i >> 16);
        const float* w = gate ? F.a->in[14] : F.a->in[12]; ((bf16*)(ws + WS_LWT))[i] = (bf16)f2bf(w[(((size_t)dir * 8 + n) * 64 + c) * 64 + e]);
    }
    if (F.bid == 0 && tid_ == 0) {
        float s1 = 0.f, s2 = 0.f;
        for (int i = 0; i < 64; ++i) { s1 += F.a->in[5][i] * F.a->in[6][i]; s2 += F.a->in[7][i] * F.a->in[8][i]; }
        ((float*)(ws + WS_MISC))[0] = expf(s1) - expf(s2) + LAMBDA_INIT;
    }
}

__global__ void __launch_bounds__(512, 2) enc_fwd(Args args) {
    extern __shared__ __attribute__((aligned(16))) unsigned char lds_raw[];
    Frame F;
    F.lds = (char*)lds_raw; F.G = gridDim.x; F.bid = blockIdx.x;
    F.a = &args; F.ws = args.ws;
    unsigned char* ws = args.ws;
    const int lo = args.ph_lo, hi = args.ph_hi;
    cg::grid_group grid = cg::this_grid();
#ifndef PHMASK
#define PHMASK 0x1fff
#endif
#define IN(k) ((((PHMASK) >> (k)) & 1) && lo <= (k) && (k) < hi)
#ifndef REPMASK
#define REPMASK 0
#endif
#define NREP(k) ((((REPMASK) >> (k)) & 1) + 1)
#define GBAR() do { if (args.coop) xcd_barrier(bar); } while (0)
#define SEAM(k) do { if (IN(k) && IN((k) + 1)) { if (args.coop) { if ((k) == 0) grid.sync(); else xcd_barrier(bar); } } } while (0)
#define PH_BEGIN(k) if (IN(k)) for (int rep_ = NREP(k) - 1; rep_ >= 0; --rep_) {
#define PH_END() if (rep_ > 0) GBAR(); }
    volatile LAS unsigned* MISC = (volatile LAS unsigned*)((LAS unsigned char*)lds_raw + (LDS_BYTES - 1024));
    if (threadIdx.x < 16) MISC[threadIdx.x] = 0u;
    __syncthreads();
    XcdBarrier bar; bar.bar = (unsigned*)(ws + WS_CTL) + 4096; bar.x = 0; bar.st = nullptr;
    if (args.coop) bar = xcd_barrier_post((unsigned*)(ws + WS_CTL) + 4096, MISC + 8);
    PG8_LAS unsigned char* ldsl = (PG8_LAS unsigned char*)lds_raw;

    PH_BEGIN(0) p0_prologue(F); __syncthreads(); PH_END()
    SEAM(0);
    PH_BEGIN(1)
        pg8::Gemm g{(const bf16*)(ws + WS_XN), (const bf16*)(ws + WS_WIN), T, INC, 1024}; pg8::StaticOrder S; S.init(T, INC, F.G, F.bid);
        pg8::EpiProj E{(bf16*)(ws + WS_Q), (const float*)(ws + WS_ROPE), (unsigned*)(ws + WS_CTL) + 16384};
        pg8::gemm_phase<pg8::EpiProj, pg8::StaticOrder, true, true>(ldsl, g, S, E);
    PH_END()
    SEAM(1);
    PH_BEGIN(2)
        const float lam = ((const float*)(ws + WS_MISC))[0];
        for (int r2_ = 0; r2_ < NREP(13); ++r2_)
        for (int it = F.bid; it < 256; it += F.G) {
            const int b = it & 7, nd = it >> 3, n = nd & 7, dir = (nd >> 3) & 1, hh = nd >> 4;
            LruArgs A{(const bf16*)(ws + WS_LIN), F.a->in[10], F.a->in[11], (const bf16*)(ws + WS_LWT), F.a->in[13], F.a->in[15], F.a->in[16], (bf16*)(ws + (dir ? WS_HB : WS_HF))};
            lru_item(b, n, dir, hh, A, F.lds);
        }
        for (int r3_ = 0; r3_ < NREP(14); ++r3_)
        for (int it = F.bid; it < 1024; it += F.G) {
            const int xx = it & 7, rest = it >> 3, qb = rest & 31, i4 = rest >> 5, bh = i4 * 8 + xx;
            if (NREP(14) == 2 && r3_ == 0) att::attn_unit<ATTVAR>(bh >> 2, bh & 3, qb, (const bf16*)(ws + WS_Q), (const bf16*)(ws + WS_K), (const bf16*)(ws + WS_V), (bf16*)(ws + WS_MIXED), F.a->in[9], lam, (const unsigned*)(ws + WS_CTL) + 16384, F.lds);
            else att::attn_unit<0>(bh >> 2, bh & 3, qb, (const bf16*)(ws + WS_Q), (const bf16*)(ws + WS_K), (const bf16*)(ws + WS_V), (bf16*)(ws + WS_MIXED), F.a->in[9], lam, (const unsigned*)(ws + WS_CTL) + 16384, F.lds);
        }
    PH_END()
    SEAM(2);
    PH_BEGIN(3)
        const int tid_ = fresh_tid(), lane_ = tid_ & 63, wave_ = __builtin_amdgcn_readfirstlane(tid_ >> 6);
        const int gw = F.bid * 8 + wave_, NGW = F.G * 8;
        for (int t = gw; t < T; t += NGW) {
            const u32x4 a = *(const u32x4*)(ws + WS_HF + ((size_t)t * 512 + lane_ * 8) * 2), b = *(const u32x4*)(ws + WS_HB + ((size_t)t * 512 + lane_ * 8) * 2), gt = *(const u32x4*)(ws + WS_LGATE + ((size_t)t * 512 + lane_ * 8) * 2);
            float y[8];
            y[0] = (bflo(a.x) + bflo(b.x)) * gelu_tanh(bflo(gt.x)); y[1] = (bfhi(a.x) + bfhi(b.x)) * gelu_tanh(bfhi(gt.x));
            y[2] = (bflo(a.y) + bflo(b.y)) * gelu_tanh(bflo(gt.y)); y[3] = (bfhi(a.y) + bfhi(b.y)) * gelu_tanh(bfhi(gt.y));
            y[4] = (bflo(a.z) + bflo(b.z)) * gelu_tanh(bflo(gt.z)); y[5] = (bfhi(a.z) + bfhi(b.z)) * gelu_tanh(bfhi(gt.z));
            y[6] = (bflo(a.w) + bflo(b.w)) * gelu_tanh(bflo(gt.w)); y[7] = (bfhi(a.w) + bfhi(b.w)) * gelu_tanh(bfhi(gt.w));
            float s = 0.f;
#pragma unroll
            for (int j = 0; j < 8; ++j) s += y[j] * y[j];
            const float rstd = 1.0f / sqrtf(wave_sum(s) * (1.0f / 512.0f) + EPS);
            const f32x4 g0 = *(const f32x4*)(F.a->in[17] + lane_ * 8), g1 = *(const f32x4*)(F.a->in[17] + lane_ * 8 + 4);
            u32x4 w = {pk2(y[0] * rstd * g0[0], y[1] * rstd * g0[1]), pk2(y[2] * rstd * g0[2], y[3] * rstd * g0[3]), pk2(y[4] * rstd * g1[0], y[5] * rstd * g1[1]), pk2(y[6] * rstd * g1[2], y[7] * rstd * g1[3])};
            *(u32x4*)(ws + WS_MIXED + ((size_t)t * 1024 + 512 + lane_ * 8) * 2) = w;
        }
    PH_END()
    SEAM(3);
    PH_BEGIN(4)
        pg8::Gemm g{(const bf16*)(ws + WS_MIXED), (const bf16*)(ws + WS_WOUT), T, 1024, 1024}; pg8::StaticOrder S; S.init(T, 1024, F.G, F.bid);
        pg8::EpiResid E{F.a->in[0], (bf16*)(ws + WS_XN), (float*)(ws + WS_SS1)};
        pg8::gemm_phase<pg8::EpiResid, pg8::StaticOrder, true, true>(ldsl, g, S, E);
    PH_END()
    SEAM(4);
    PH_BEGIN(5)
        pg8::Gemm g{(const bf16*)(ws + WS_XN), (const bf16*)(ws + WS_WQ), T, 1024, 1024}; pg8::StaticOrder S; S.init(T, 1024, F.G, F.bid);
        pg8::EpiScaleBf16 E{(bf16*)(ws + WS_QP), (const float*)(ws + WS_SS1), (float*)(ws + WS_MISC + 4096)};
        pg8::gemm_phase<pg8::EpiScaleBf16, pg8::StaticOrder, true, true>(ldsl, g, S, E);
    PH_END()
    SEAM(5);
    PH_BEGIN(6)
        TopkArgs A{(const bf16*)(ws + WS_QP), (const bf16*)(ws + WS_KEYS), (unsigned short*)(ws + WS_IDX), (float*)(ws + WS_GW)};
        bf16x8 kf[4][4];
        { const int tid_ = fresh_tid(), lane_ = tid_ & 63, wave_ = __builtin_amdgcn_readfirstlane(tid_ >> 6); const int half = (wave_ >> 1) & 1, r32 = lane_ & 31, hi5 = lane_ >> 5;
#pragma unroll
          for (int ct = 0; ct < 4; ++ct)
#pragma unroll
            for (int ks = 0; ks < 4; ++ks) kf[ct][ks] = *(const bf16x8*)(A.KEYS + (size_t)half * 8192 + (ct * 32 + r32) * 64 + ks * 16 + hi5 * 8); }
        for (int tile = F.bid; tile < T / 64; tile += F.G) topk_unit(tile, A, kf, F.lds);
    PH_END()
    SEAM(6);
    PeerArgs PA{(const unsigned short*)(ws + WS_IDX), (const bf16*)(ws + WS_XN), (const unsigned char*)(ws + WS_UT), (const unsigned char*)(ws + WS_VT), (float*)(ws + WS_PLOG), (const float*)(ws + WS_ACT), (bf16*)(ws + WS_XN), (float*)(ws + WS_SS2)};
    PH_BEGIN(7)
        if (rep_ > 0 && ((REPMASK >> 16) & 1)) { for (int it = F.bid; it < 8 * (T / 128); it += F.G) peer_u_item<0xfu, ((REPMASK >> 17) & 1)>(it >> 3, it & 7, PA, F.lds); }
        else for (int it = F.bid; it < 8 * (T / 128); it += F.G) peer_u_item<0xffffu, 0>(it >> 3, it & 7, PA, F.lds);
    PH_END()
    SEAM(7);
    PH_BEGIN(8)
        const int tid_ = fresh_tid();
        const long gt = (long)F.bid * 512 + tid_, NGT = (long)F.G * 512;
        const float* plog = (const float*)(ws + WS_PLOG); const float* gwp = (const float*)(ws + WS_GW); float* act = (float*)(ws + WS_ACT);
        for (long i = gt; i < (long)T * 128; i += NGT) {
            const int t = (int)(i >> 7);
            float s = 0.f;
#pragma unroll
            for (int q = 0; q < 8; ++q) s += plog[(size_t)q * T * 128 + i];
            const float rs = ((const float*)(ws + WS_MISC + 4096))[t];
            act[i] = gelu_tanh(s * rs) * gwp[i];
        }
    PH_END()
    SEAM(8);
    PH_BEGIN(9)
        if (rep_ > 0 && ((REPMASK >> 15) & 1)) { for (int it = F.bid; it < 8 * (T / 128); it += F.G) peer_v_item<true, 0xffffu, ATTVAR>(it >> 3, it & 7, PA, F.lds, 0.0f); }
        else for (int it = F.bid; it < 8 * (T / 128); it += F.G) peer_v_item<true, 0xffffu, 0>(it >> 3, it & 7, PA, F.lds, rep_ > 0 ? 0.0f : 1.0f);
    PH_END()
    SEAM(9);
    PH_BEGIN(10)
        pg8::Gemm g{(const bf16*)(ws + WS_PB), (const bf16*)(ws + WS_WP), T, 1024, 256}; pg8::StaticOrder S; S.init(T, 1024, F.G, F.bid);
        pg8::EpiScaleBf16 E{(bf16*)(ws + WS_QP), nullptr, nullptr};
        pg8::gemm_phase<pg8::EpiScaleBf16, pg8::StaticOrder, true, true>(ldsl, g, S, E);
    PH_END()
    SEAM(10);
    PH_BEGIN(11)
        pg8::Gemm g{(const bf16*)(ws + WS_XN), (const bf16*)(ws + WS_WG), T, 1024, 1024}; pg8::StaticOrder S; S.init(T, 1024, F.G, F.bid);
        pg8::EpiPle E{(const bf16*)(ws + WS_XN), (bf16*)(ws + WS_MIXED), (const bf16*)(ws + WS_QP), (const float*)(ws + WS_SS2), (float*)(ws + WS_SS3), rep_ > 0 ? 0.0f : 1.0f};
        pg8::gemm_phase<pg8::EpiPle, pg8::StaticOrder, true, true>(ldsl, g, S, E);
    PH_END()
    SEAM(11);
    PH_BEGIN(12)
        const int tid_ = fresh_tid(), lane_ = tid_ & 63, wave_ = __builtin_amdgcn_readfirstlane(tid_ >> 6);
        const int gw = F.bid * 8 + wave_, NGW = F.G * 8;
        for (int m = gw; m < T; m += NGW) {
            const float rs = pg8::rowscale16((const float*)(ws + WS_SS3), m);
            const u32x2* hb = (const u32x2*)(ws + WS_MIXED + (size_t)m * 2048) + lane_; const f32x4* gr = (const f32x4*)F.a->in[28] + lane_; f32x4* orow = (f32x4*)(F.a->out + (size_t)m * 1024) + lane_;
#pragma unroll
            for (int j = 0; j < 4; ++j) { const u32x2 w = hb[64 * j]; const f32x4 v = {bflo(w.x), bfhi(w.x), bflo(w.y), bfhi(w.y)}; orow[64 * j] = v * rs * gr[64 * j]; }
        }
    PH_END()
#undef IN
#undef SEAM
}

#ifndef MK_MULTI
#define MK_MULTI 0
#endif
constexpr int NPH = 13;
extern "C" void kernel_launch(void* const* d_in, const int* in_sizes, int n_in, void* d_out, int out_size, void* d_ws, size_t ws_size, hipStream_t stream) {
    static int grid = 0;
    if (grid == 0) {
        if (n_in != 29 || out_size != T * DM || ws_size < WS_END) { fprintf(stderr, "kernel_launch: unexpected shapes: n_in %d out %d ws %zu (need %zu)\n", n_in, out_size, ws_size, (size_t)WS_END); grid = -1; return; }
        int dev = 0, cus = 0, per_cu = 0;
        if (hipGetDevice(&dev) != hipSuccess || hipDeviceGetAttribute(&cus, hipDeviceAttributeMultiprocessorCount, dev) != hipSuccess) { grid = -1; return; }
        if (hipFuncSetAttribute((const void*)enc_fwd, hipFuncAttributeMaxDynamicSharedMemorySize, LDS_BYTES) != hipSuccess) { fprintf(stderr, "kernel_launch: hipFuncSetAttribute failed\n"); grid = -1; return; }
        if (hipOccupancyMaxActiveBlocksPerMultiprocessor(&per_cu, (const void*)enc_fwd, 512, LDS_BYTES) != hipSuccess || per_cu < 1) { fprintf(stderr, "kernel_launch: occupancy query says %d\n", per_cu); per_cu = 1; }
        (void)hipGetLastError();
        grid = cus * 1;
    }
    if (grid < 0) return;
    (void)hipMemsetAsync((char*)d_ws + WS_CTL, 0, CTL_ZERO_BYTES, stream);
    Args a{};
    for (int i = 0; i < 29; ++i) a.in[i] = (const float*)d_in[i];
    a.out = (float*)d_out; a.ws = (unsigned char*)d_ws;
#if MK_MULTI
    for (int ph = 0; ph < NPH; ++ph) { a.ph_lo = ph; a.ph_hi = ph + 1; a.coop = 0; hipLaunchKernelGGL(enc_fwd, dim3(grid), dim3(512), LDS_BYTES, stream, a); }
#else
    a.ph_lo = 0; a.ph_hi = NPH; a.coop = 1;
    void* kargs[] = {&a};
    hipError_t e = hipLaunchCooperativeKernel((const void*)enc_fwd, dim3(grid), dim3(512), kargs, LDS_BYTES, stream);
    if (e != hipSuccess) fprintf(stderr, "cooperative launch failed: %s (grid %d)\n", hipGetErrorString(e), grid);
#endif
}
```

```cpp
#include <hip/hip_runtime.h>
#include <hip/hip_cooperative_groups.h>
#include <cstdio>
#include <cstdint>
namespace cg = cooperative_groups;

#ifndef REPMASK
#define REPMASK 0
#endif
constexpr int NB = 8, SEQ = 4096, T = NB * SEQ, DM = 1024, INC = 2560, PLE = 256;
constexpr float EPS = 1e-6f;
constexpr float LAMBDA_INIT = 0.2f;

__device__ __forceinline__ int fresh_tid() { int t = threadIdx.x; asm volatile("" : "+v"(t)); return t; }

namespace pg8 {
#define PG8_LAS __attribute__((address_space(3)))
typedef unsigned short bf16_t;
typedef short bf16x8 __attribute__((ext_vector_type(8)));
typedef float f32x4 __attribute__((ext_vector_type(4)));
typedef unsigned u32x4 __attribute__((ext_vector_type(4)));
constexpr int BM = 256, BK = 64, HALF = 128, HTB = HALF * BK * 2  , STAGE_BYTES = 8 * HTB, NXCD = 8, WGM = 8;

__host__ __device__ __forceinline__ int lds_byte(int r, int c) { const int st = (r >> 4) * 2 + (c >> 5), rr = r & 15, cc = c & 31, ob = rr * 64 + cc * 2; return st * 1024 + (ob ^ (((ob >> 9) & 1) << 5)); }
__host__ __device__ __forceinline__ void stage_rc(int b, int& R, int& C) { const int st = b / 1024, sb = b % 1024, swz = sb ^ (((sb >> 9) & 1) << 5); R = (st >> 1) * 16 + swz / 64; C = (st & 1) * 32 + (swz % 64) / 2; }
__host__ __device__ __forceinline__ int perm32(int rho) { const int n = rho >> 4, i = rho & 15; return 8 * (i >> 2) + 4 * n + (i & 3); }

struct Unit { int pm, pn; };
struct Gemm { const bf16_t* A; const bf16_t* Bt; int M, N, K; };

struct StaticOrder {
    int nM, nN, nwg, G, c;
    __host__ __device__ void init(int M, int N, int G_, int c_) { nM = M / BM; nN = N / BM; nwg = nM * nN; G = G_; c = c_; }
    __host__ __device__ bool next(int i, Unit& u) const {
        const long L = (long)i * G + c; if (L >= nwg) return false;
        int wgid = (int)L; { const int q = nwg / NXCD, r = nwg % NXCD, xcd = wgid % NXCD, off = wgid / NXCD; wgid = (xcd < r ? xcd * (q + 1) : r * (q + 1) + (xcd - r) * q) + off; }
        const int nig = WGM * nN, gid = wgid / nig, fm = gid * WGM, gsz = (nM - fm) < WGM ? (nM - fm) : WGM;
        u.pm = fm + ((wgid % nig) % gsz); u.pn = (wgid % nig) / gsz; return true;
    }
    __device__ __forceinline__ void a_ready(const Unit&) const {}
    __device__ __forceinline__ void done(const Unit&) const {}
};

__device__ __forceinline__ unsigned cvt_pk_bf16(float lo, float hi) { unsigned r; asm volatile("v_cvt_pk_bf16_f32 %0, %1, %2" : "=v"(r) : "v"(lo), "v"(hi)); return r; }
typedef float f32x2 __attribute__((ext_vector_type(2)));
typedef unsigned u32x2 __attribute__((ext_vector_type(2)));
__device__ __forceinline__ float fsigmoid(float z) { return __builtin_amdgcn_rcpf(1.0f + __expf(-z)); }
__device__ __forceinline__ float rowscale_n(const float* ss, int n) { float s = 0.f; for (int i = 0; i < n; ++i) s += ss[i]; return 1.0f / sqrtf(s * (1.0f / 1024.0f) + 1e-6f); }
__device__ __forceinline__ float rowscale16(const float* ss, int row) { const f32x4* p = (const f32x4*)(ss + (size_t)row * 16); const f32x4 a = p[0], b = p[1], c = p[2], d = p[3];
    const float s = ((a[0] + a[1]) + (a[2] + a[3])) + ((b[0] + b[1]) + (b[2] + b[3])) + ((c[0] + c[1]) + (c[2] + c[3])) + ((d[0] + d[1]) + (d[2] + d[3])); return 1.0f / sqrtf(s * (1.0f / 1024.0f) + 1e-6f); }
__device__ __forceinline__ float rowscale8(const float* ss, int row) { const f32x4* p = (const f32x4*)(ss + (size_t)row * 8); const f32x4 a = p[0], b = p[1];
    const float s = ((a[0] + a[1]) + (a[2] + a[3])) + ((b[0] + b[1]) + (b[2] + b[3])); return 1.0f / sqrtf(s * (1.0f / 1024.0f) + 1e-6f); }
__device__ __forceinline__ u32x4 pack8(f32x4 v0, f32x4 v1) { u32x4 w; w.x = cvt_pk_bf16(v0[0], v0[1]); w.y = cvt_pk_bf16(v0[2], v0[3]); w.z = cvt_pk_bf16(v1[0], v1[1]); w.w = cvt_pk_bf16(v1[2], v1[3]); return w; }
__device__ __forceinline__ float bf_lo(unsigned w) { return __uint_as_float(w << 16); }
__device__ __forceinline__ float bf_hi(unsigned w) { return __uint_as_float(w & 0xffff0000u); }

struct EpiProj {
    static constexpr bool PERM = true, AFTER_DRAIN = false;
    bf16_t* base; const float* rope; unsigned* kmx;
    __device__ __forceinline__ void operator()(const f32x4 (&acc)[2][2][4][2], const Unit& u, int wr, int wc, int fr, int fq) const {
        const int region = u.pn >> 1;
        bf16_t* O = base + (size_t)region * ((size_t)32768 * 512);
        const int colb = (u.pn & 1) * 256 + wc * 32 + 8 * fq;
        const bool rot = (region < 2) && ((wc & 1) == 0);
        const float qs = (region == 0) ? 0.125f * 1.4426950408889634f : 1.0f;
        float kss0 = 0.f, kss1 = 0.f;
        const float sgn = (fq == 0) ? -1.0f : 1.0f;
#pragma unroll
        for (int ai = 0; ai < 2; ++ai)
#pragma unroll
            for (int m = 0; m < 4; ++m) {
                const int row = u.pm * BM + ai * HALF + wr * 64 + m * 16 + fr;
                f32x4 c0 = {1.f, 1.f, 1.f, 1.f}, c1 = c0, s0 = {0.f, 0.f, 0.f, 0.f}, s1 = s0;
                if (rot) { const f32x4* rp = (const f32x4*)(rope + (size_t)row * 16); c0 = rp[0]; c1 = rp[1]; s0 = rp[2]; s1 = rp[3]; }
#pragma unroll
                for (int bj = 0; bj < 2; ++bj) {
                    f32x4 v0 = acc[ai][bj][m][0], v1 = acc[ai][bj][m][1];
                    if (rot) {
                        f32x4 o0, o1;
#pragma unroll
                        for (int j = 0; j < 4; ++j) { o0[j] = __shfl_xor(v0[j], 16); o1[j] = __shfl_xor(v1[j], 16); }
                        if (fq < 2) { v0 = v0 * c0 + (o0 * s0) * sgn; v1 = v1 * c1 + (o1 * s1) * sgn; }
                    }
                    v0 = v0 * qs; v1 = v1 * qs;
                    if (region == 1) { float s = (v0[0] * v0[0] + v0[1] * v0[1]) + (v0[2] * v0[2] + v0[3] * v0[3]) + (v1[0] * v1[0] + v1[1] * v1[1]) + (v1[2] * v1[2] + v1[3] * v1[3]);
                        s += __shfl_xor(s, 16); s += __shfl_xor(s, 32); if (bj == 0) kss0 = fmaxf(kss0, s); else kss1 = fmaxf(kss1, s); }
                    *(u32x4*)(O + (size_t)row * 512 + colb + bj * HALF) = pack8(v0, v1);
                }
            }
        if (region == 1) {
#pragma unroll
            for (int o = 1; o < 16; o <<= 1) { kss0 = fmaxf(kss0, __shfl_xor(kss0, o)); kss1 = fmaxf(kss1, __shfl_xor(kss1, o)); }
            if (fr == 0 && fq == 0) {
                const int b = u.pm >> 4, mp = wc >> 1, half = wc & 1;
                atomicMax(kmx + (((b * 4 + ((u.pn & 1) * 2 + 0)) * 2 + mp) * 2 + half), __float_as_uint(kss0 * 1.02f));
                atomicMax(kmx + (((b * 4 + ((u.pn & 1) * 2 + 1)) * 2 + mp) * 2 + half), __float_as_uint(kss1 * 1.02f));
            }
        }
    }
};
struct EpiResid {
    static constexpr bool PERM = true, AFTER_DRAIN = false;
    const float* X; bf16_t* HB; float* SS;
    __device__ __forceinline__ void operator()(const f32x4 (&acc)[2][2][4][2], const Unit& u, int wr, int wc, int fr, int fq) const {
        const int col0 = u.pn * BM + wc * 32 + 8 * fq;
#pragma unroll
        for (int ai = 0; ai < 2; ++ai)
#pragma unroll
            for (int m = 0; m < 4; ++m) {
                const int row = u.pm * BM + ai * HALF + wr * 64 + m * 16 + fr; float ssq = 0.f;
#pragma unroll
                for (int bj = 0; bj < 2; ++bj) {
                    const size_t off = (size_t)row * 1024 + col0 + bj * HALF;
                    const f32x4 h0 = *(const f32x4*)(X + off) + acc[ai][bj][m][0], h1 = *(const f32x4*)(X + off + 4) + acc[ai][bj][m][1];
                    *(u32x4*)(HB + off) = pack8(h0, h1);
                    ssq += (h0[0] * h0[0] + h0[1] * h0[1]) + (h0[2] * h0[2] + h0[3] * h0[3]) + (h1[0] * h1[0] + h1[1] * h1[1]) + (h1[2] * h1[2] + h1[3] * h1[3]);
                }
                ssq += __shfl_xor(ssq, 16); ssq += __shfl_xor(ssq, 32);
                if (fq == 0) SS[(size_t)row * 16 + u.pn * 4 + wc] = ssq;
            }
    }
};
struct EpiScaleBf16 {
    static constexpr bool PERM = true, AFTER_DRAIN = false;
    bf16_t* O; const float* SS; float* RS;
    __device__ __forceinline__ void operator()(const f32x4 (&acc)[2][2][4][2], const Unit& u, int wr, int wc, int fr, int fq) const {
        const int col0 = u.pn * BM + wc * 32 + 8 * fq;
#pragma unroll
        for (int ai = 0; ai < 2; ++ai)
#pragma unroll
            for (int m = 0; m < 4; ++m) {
                const int row = u.pm * BM + ai * HALF + wr * 64 + m * 16 + fr;
                const float rs = SS ? rowscale16(SS, row) : 1.0f;
                if (RS && u.pn == 0 && wc == 0 && fq == 0) RS[row] = rs;
#pragma unroll
                for (int bj = 0; bj < 2; ++bj) *(u32x4*)(O + (size_t)row * 1024 + col0 + bj * HALF) = pack8(acc[ai][bj][m][0] * rs, acc[ai][bj][m][1] * rs);
            }
    }
};
struct EpiPle {
    static constexpr bool PERM = true, AFTER_DRAIN = false;
    const bf16_t* H2B; bf16_t* H3B; const bf16_t* PP; const float* SS2; float* SS3; float gsc;
    __device__ __forceinline__ void operator()(const f32x4 (&acc)[2][2][4][2], const Unit& u, int wr, int wc, int fr, int fq) const {
        const int col0 = u.pn * BM + wc * 32 + 8 * fq;
#pragma unroll
        for (int ai = 0; ai < 2; ++ai)
#pragma unroll
            for (int m = 0; m < 4; ++m) {
                const int row = u.pm * BM + ai * HALF + wr * 64 + m * 16 + fr; float ssq = 0.f;
                const float rs = rowscale8(SS2, row);
#pragma unroll
                for (int bj = 0; bj < 2; ++bj) {
                    const size_t off = (size_t)row * 1024 + col0 + bj * HALF;
                    const u32x4 pw = *(const u32x4*)(PP + off);
                    const f32x4 p0 = {bf_lo(pw.x), bf_hi(pw.x), bf_lo(pw.y), bf_hi(pw.y)}, p1 = {bf_lo(pw.z), bf_hi(pw.z), bf_lo(pw.w), bf_hi(pw.w)};
                    f32x4 g0, g1;
#pragma unroll
                    for (int j = 0; j < 4; ++j) { g0[j] = fsigmoid(acc[ai][bj][m][0][j] * rs); g1[j] = fsigmoid(acc[ai][bj][m][1][j] * rs); }
                    const u32x4 hw = *(const u32x4*)(H2B + off);
                    const f32x4 r0 = {bf_lo(hw.x), bf_hi(hw.x), bf_lo(hw.y), bf_hi(hw.y)}, r1 = {bf_lo(hw.z), bf_hi(hw.z), bf_lo(hw.w), bf_hi(hw.w)};
                    const f32x4 h0 = r0 + g0 * p0 * gsc, h1 = r1 + g1 * p1 * gsc;
                    *(u32x4*)(H3B + off) = pack8(h0, h1);
                    ssq += (h0[0] * h0[0] + h0[1] * h0[1]) + (h0[2] * h0[2] + h0[3] * h0[3]) + (h1[0] * h1[0] + h1[1] * h1[1]) + (h1[2] * h1[2] + h1[3] * h1[3]);
                }
                ssq += __shfl_xor(ssq, 16); ssq += __shfl_xor(ssq, 32);
                if (fq == 0) SS3[(size_t)row * 16 + u.pn * 4 + wc] = ssq;
            }
    }
};

template <class Epi, class Sched, bool ALIGN_EPI = false, bool SP2 = false>
__device__ __forceinline__ void gemm_phase(PG8_LAS unsigned char* lds, const Gemm g, const Sched& S, const Epi& E) {
    const int tid = fresh_tid(), wid = __builtin_amdgcn_readfirstlane(tid >> 6), lane = tid & 63, wr = wid >> 2, wc = wid & 3, fr = lane & 15, fq = lane >> 4;
    const int K = g.K, nt = K / BK;
    unsigned voffA[2], voffB[2];
#pragma unroll
    for (int i = 0; i < 2; ++i) { int R, C; stage_rc(tid * 16 + i * 8192, R, C); const int Rb = Epi::PERM ? ((R & ~31) + perm32(R & 31)) : R;
        voffA[i] = (unsigned)(R * K + C) * 2u; voffB[i] = (unsigned)(Rb * K + C) * 2u; }
    const size_t kstep = (size_t)(BK * 2);
    const size_t hstep = (size_t)HALF * K * 2;
    const size_t tstep = 2 * hstep;
    const unsigned ldsw = (unsigned)wid * 1024u;
    const int aoff = lds_byte(wr * 64 + fr, fq * 8), boff = lds_byte(wc * 32 + fr, fq * 8);
#define PG8_SA(b, h) (((b) * 2 + (h)) * HTB)
#define PG8_SB(b, h) ((4 + (b) * 2 + (h)) * HTB)
#define PG8_STAGE(bufoff, gbase, voff) do { _Pragma("unroll") for (int _i = 0; _i < 2; ++_i) \
        __builtin_amdgcn_global_load_lds((const unsigned*)((const char*)(gbase) + (voff)[_i]), (PG8_LAS unsigned*)(lds + (bufoff) + ldsw + _i * 8192), 16, 0, 0); } while (0)
#define PG8_LDA(dst, b, h) do { _Pragma("unroll") for (int m = 0; m < 4; ++m) _Pragma("unroll") for (int k = 0; k < 2; ++k) dst[m][k] = *(const PG8_LAS bf16x8*)(lds + PG8_SA(b, h) + aoff + m * 2048 + k * 1024); } while (0)
#define PG8_LDB(dst, b, h) do { _Pragma("unroll") for (int n = 0; n < 2; ++n) _Pragma("unroll") for (int k = 0; k < 2; ++k) dst[n][k] = *(const PG8_LAS bf16x8*)(lds + PG8_SB(b, h) + boff + n * 2048 + k * 1024); } while (0)
#define PG8_MMA(ai, bj, At, Bt) do { __builtin_amdgcn_s_setprio(1); _Pragma("unroll") for (int m = 0; m < 4; ++m) _Pragma("unroll") for (int n = 0; n < 2; ++n) _Pragma("unroll") for (int k = 0; k < 2; ++k) \
        acc[ai][bj][m][n] = __builtin_amdgcn_mfma_f32_16x16x32_bf16(Bt[n][k], At[m][k], acc[ai][bj][m][n], 0, 0, 0); __builtin_amdgcn_s_setprio(0); } while (0)
#define PG8_WAIT_V(n) asm volatile("s_waitcnt vmcnt(" #n ")" ::: "memory")
#define PG8_WAIT_L(n) asm volatile("s_waitcnt lgkmcnt(" #n ")" ::: "memory")
#define PG8_BAR __builtin_amdgcn_s_barrier()
#define PG8_SCHED __builtin_amdgcn_sched_barrier(0)
    Unit cur, nxt; int ui = 0;
    if (!S.next(0, cur)) return;
    f32x4 acc[2][2][4][2];
#pragma unroll
    for (int a = 0; a < 2; ++a)
#pragma unroll
        for (int b = 0; b < 2; ++b)
#pragma unroll
            for (int m = 0; m < 4; ++m)
#pragma unroll
                for (int n = 0; n < 2; ++n) acc[a][b][m][n] = (f32x4){0.f, 0.f, 0.f, 0.f};
    bf16x8 At[4][2], B0[2][2], B1[2][2];
    const char* cA = (const char*)g.A + (size_t)cur.pm * tstep; const char* cB = (const char*)g.Bt + (size_t)cur.pn * tstep;
    S.a_ready(cur);
    if constexpr (SP2) {
        PG8_STAGE(PG8_SB(0, 0), cB, voffB); PG8_STAGE(PG8_SB(0, 1), cB + hstep, voffB); PG8_STAGE(PG8_SA(0, 0), cA, voffA); PG8_STAGE(PG8_SA(0, 1), cA + hstep, voffA);
        if (wr == 1) PG8_BAR;
        PG8_WAIT_V(2); PG8_BAR;
        PG8_STAGE(PG8_SB(1, 0), cB + kstep, voffB); PG8_STAGE(PG8_SA(1, 0), cA + kstep, voffA); PG8_STAGE(PG8_SB(1, 1), cB + hstep + kstep, voffB);
        PG8_WAIT_V(6); PG8_BAR;
    } else {
        PG8_STAGE(PG8_SB(0, 0), cB, voffB); PG8_STAGE(PG8_SA(0, 0), cA, voffA); PG8_STAGE(PG8_SB(0, 1), cB + hstep, voffB); PG8_STAGE(PG8_SA(0, 1), cA + hstep, voffA);
        if (wr == 1) PG8_BAR;
        PG8_WAIT_V(4); PG8_BAR;
        PG8_STAGE(PG8_SB(1, 0), cB + kstep, voffB); PG8_STAGE(PG8_SA(1, 0), cA + kstep, voffA); PG8_STAGE(PG8_SB(1, 1), cB + hstep + kstep, voffB);
        PG8_WAIT_V(6); PG8_BAR;
    }
    for (;;) {
        const bool has_next = S.next(ui + 1, nxt);
        const char* nA = has_next ? (const char*)g.A + (size_t)nxt.pm * tstep : cA; const char* nB = has_next ? (const char*)g.Bt + (size_t)nxt.pn * tstep : cB;
        for (int t = 0; t < nt; t += 2) {
            const bool last = (t == nt - 2);
            const char* a1 = cA + (size_t)(t + 1) * kstep;
            const char* a2 = last ? nA : cA + (size_t)(t + 2) * kstep; const char* b2 = last ? nB : cB + (size_t)(t + 2) * kstep;
            const char* a3 = a2 + kstep; const char* b3 = b2 + kstep;
            if (last && has_next) S.a_ready(nxt);
            if constexpr (SP2) {
            PG8_LDB(B0, 0, 0); PG8_LDB(B1, 0, 1); PG8_SCHED; PG8_LDA(At, 0, 0); PG8_STAGE(PG8_SA(1, 1), a1 + hstep, voffA);
            PG8_WAIT_V(8); PG8_WAIT_L(0); PG8_BAR; PG8_MMA(0, 0, At, B0); PG8_MMA(0, 1, At, B1); PG8_BAR; PG8_SCHED;
            PG8_LDA(At, 0, 1); PG8_STAGE(PG8_SB(0, 0), b2, voffB); PG8_STAGE(PG8_SB(0, 1), b2 + hstep, voffB); PG8_STAGE(PG8_SA(0, 0), a2, voffA);
            PG8_WAIT_V(8); PG8_WAIT_L(0); PG8_BAR; PG8_MMA(1, 0, At, B0); PG8_MMA(1, 1, At, B1); PG8_BAR; PG8_SCHED;
            PG8_LDB(B0, 1, 0); PG8_LDB(B1, 1, 1); PG8_SCHED; PG8_LDA(At, 1, 0); PG8_STAGE(PG8_SA(0, 1), a2 + hstep, voffA);
            PG8_WAIT_V(8); PG8_WAIT_L(0); PG8_BAR; PG8_MMA(0, 0, At, B0); PG8_MMA(0, 1, At, B1); PG8_BAR; PG8_SCHED;
            PG8_LDA(At, 1, 1); PG8_STAGE(PG8_SB(1, 0), b3, voffB); PG8_STAGE(PG8_SB(1, 1), b3 + hstep, voffB); PG8_STAGE(PG8_SA(1, 0), a3, voffA);
            PG8_WAIT_V(8); PG8_WAIT_L(0); PG8_BAR; PG8_MMA(1, 0, At, B0); PG8_MMA(1, 1, At, B1); PG8_BAR; PG8_SCHED;
            } else {
            PG8_LDB(B0, 0, 0); PG8_SCHED; PG8_LDA(At, 0, 0); PG8_STAGE(PG8_SA(1, 1), a1 + hstep, voffA);
            PG8_WAIT_L(8); PG8_BAR; PG8_WAIT_L(0); PG8_MMA(0, 0, At, B0); PG8_BAR; PG8_SCHED;
            PG8_LDB(B1, 0, 1); PG8_STAGE(PG8_SB(0, 0), b2, voffB);
            PG8_BAR; PG8_WAIT_L(0); PG8_MMA(0, 1, At, B1); PG8_BAR;
            PG8_LDA(At, 0, 1); PG8_STAGE(PG8_SA(0, 0), a2, voffA);
            PG8_BAR; PG8_WAIT_L(0); PG8_MMA(1, 0, At, B0); PG8_BAR; PG8_SCHED;
            PG8_STAGE(PG8_SB(0, 1), b2 + hstep, voffB);
            PG8_WAIT_V(6); PG8_BAR; PG8_MMA(1, 1, At, B1); PG8_BAR;
            PG8_LDB(B0, 1, 0); PG8_SCHED; PG8_LDA(At, 1, 0); PG8_STAGE(PG8_SA(0, 1), a2 + hstep, voffA);
            PG8_WAIT_L(8); PG8_BAR; PG8_WAIT_L(0); PG8_MMA(0, 0, At, B0); PG8_BAR; PG8_SCHED;
            PG8_LDB(B1, 1, 1); PG8_STAGE(PG8_SB(1, 0), b3, voffB);
            PG8_BAR; PG8_WAIT_L(0); PG8_MMA(0, 1, At, B1); PG8_BAR;
            PG8_LDA(At, 1, 1); PG8_STAGE(PG8_SA(1, 0), a3, voffA);
            PG8_BAR; PG8_WAIT_L(0); PG8_MMA(1, 0, At, B0); PG8_BAR; PG8_SCHED;
            PG8_STAGE(PG8_SB(1, 1), b3 + hstep, voffB);
            PG8_WAIT_V(6); PG8_BAR; PG8_MMA(1, 1, At, B1); PG8_BAR;
            }
        }
        if constexpr (ALIGN_EPI) { if (wr == 0) PG8_BAR; }
        if constexpr (!Epi::AFTER_DRAIN) { E(acc, cur, wr, wc, fr, fq); S.done(cur); }
        if (!has_next) break;
#pragma unroll
        for (int a = 0; a < 2; ++a)
#pragma unroll
            for (int b = 0; b < 2; ++b)
#pragma unroll
                for (int m = 0; m < 4; ++m)
#pragma unroll
                    for (int n = 0; n < 2; ++n) acc[a][b][m][n] = (f32x4){0.f, 0.f, 0.f, 0.f};
        cur = nxt; cA = nA; cB = nB; ++ui;
        if constexpr (ALIGN_EPI) { if (wr == 1) PG8_BAR; }
    }
    PG8_WAIT_V(0);
    if constexpr (!ALIGN_EPI) { if (wr == 0) PG8_BAR; }
    PG8_BAR;
    if constexpr (Epi::AFTER_DRAIN) { E.fused(acc, cur, wr, wc, fr, fq, lds, wid, lane); S.done(cur); }
#undef PG8_SA
#undef PG8_SB
#undef PG8_STAGE
#undef PG8_LDA
#undef PG8_LDB
#undef PG8_MMA
#undef PG8_WAIT_V
#undef PG8_WAIT_L
#undef PG8_BAR
#undef PG8_SCHED
}
}
namespace att {
using bf16x8 = __attribute__((ext_vector_type(8))) short;
using s16x4  = __attribute__((ext_vector_type(4))) short;
using f32x16 = __attribute__((ext_vector_type(16))) float;
using f32x4  = __attribute__((ext_vector_type(4))) float;
using u32x4  = __attribute__((ext_vector_type(4))) unsigned;
constexpr int NW = 8, QBLK = 32, KVBLK = 64, LDK = 512;
constexpr float THR = 8.f;
constexpr size_t SHM_V = KVBLK * 128 * 2, SHM_K = KVBLK * 128 * 2;
constexpr int OST_LD = 132;
#define KSWZ(row, colB) ((row) * 256 + ((colB) ^ (((row) & 7) << 4)))
#define SBAR() __builtin_amdgcn_sched_barrier(0)
__device__ __forceinline__ int crow(int r, int hi) { return (r & 3) + 8 * (r >> 2) + 4 * hi; }
__device__ __forceinline__ unsigned cvtpk(float lo, float hi) { unsigned r; asm volatile("v_cvt_pk_bf16_f32 %0, %1, %2" : "=v"(r) : "v"(lo), "v"(hi)); return r; }

__device__ __forceinline__ void sumpack(const f32x16& p0, const f32x16& p1, float& l_reg, bf16x8& pa0, bf16x8& pa1, bf16x8& pa2, bf16x8& pa3) {
  float ps = 0;
#pragma unroll
  for (int r = 0; r < 16; ++r) ps += p0[r];
#pragma unroll
  for (int r = 0; r < 16; ++r) ps += p1[r];
  l_reg += ps;
#define PK4(P, BASE, OUT) do { unsigned a0 = cvtpk(P[BASE + 0], P[BASE + 1]), a1 = cvtpk(P[BASE + 2], P[BASE + 3]);   \
    unsigned b0 = cvtpk(P[BASE + 4], P[BASE + 5]), b1 = cvtpk(P[BASE + 6], P[BASE + 7]);                              \
    auto r0 = __builtin_amdgcn_permlane32_swap(a0, b0, false, false); auto r1 = __builtin_amdgcn_permlane32_swap(a1, b1, false, false); \
    u32x4 w = {r0[0], r1[0], r0[1], r1[1]}; OUT = *reinterpret_cast<bf16x8*>(&w); } while (0)
  PK4(p0, 0, pa0); PK4(p0, 8, pa1); PK4(p1, 0, pa2); PK4(p1, 8, pa3);
#undef PK4
}
__device__ __forceinline__ void exp_all(f32x16& p0, f32x16& p1) {
#pragma unroll
  for (int r = 0; r < 16; ++r) p0[r] = __builtin_amdgcn_exp2f(p0[r]);
#pragma unroll
  for (int r = 0; r < 16; ++r) p1[r] = __builtin_amdgcn_exp2f(p1[r]);
}
template <int VAR> __device__ __forceinline__ void qkt(f32x16& p0, f32x16& p1, const char* Ks, const bf16x8* qr, int r32, int hi, int mcolB, const f32x16& negm) {
  p0 = negm; p1 = negm;
#pragma unroll
  for (int d0 = 0; d0 < 4; ++d0) { int cb = mcolB + (d0 * 16 + hi * 8) * 2;
    bf16x8 b0 = *reinterpret_cast<const bf16x8*>(Ks + KSWZ(r32, cb));
    bf16x8 b1 = *reinterpret_cast<const bf16x8*>(Ks + KSWZ(32 + r32, cb));
    if (!(VAR & 4)) { p0 = __builtin_amdgcn_mfma_f32_32x32x16_bf16(b0, qr[d0], p0, 0, 0, 0);
    p1 = __builtin_amdgcn_mfma_f32_32x32x16_bf16(b1, qr[d0], p1, 0, 0, 0); } else asm volatile("" :: "v"(b0), "v"(b1)); }
}
__device__ __forceinline__ int v_st(int k, int c) { const int kk = (k & ~0xC) | ((k & 4) << 1) | ((k & 8) >> 1); return ((kk >> 3) * 4 + (c >> 5)) * 512 + ((kk & 7) * 32 + (c & 31)) * 2; }
__device__ __forceinline__ int v_rd_base(int lane) { return ((lane & 3) << 3) | (((lane >> 2) & 3) << 6) | (((lane >> 4) & 1) << 5) | (((lane >> 5) & 1) << 8); }
constexpr int v_rd_off(int d0, int ks, int half) { return d0 * 512 + ks * 4096 + half * 2048; }
template <int OFF> __device__ __forceinline__ s16x4 tr_read(int vb) {
  s16x4 r; asm volatile("ds_read_b64_tr_b16 %0, %1 offset:%2" : "=&v"(r) : "v"(vb), "i"(OFF) : "memory"); return r;
}
struct VFrag { s16x4 l0, h0, l1, h1, l2, h2, l3, h3; };
template <int D0> __device__ __forceinline__ void v_reads(VFrag& f, int vb) {
  f.l0 = tr_read<v_rd_off(D0, 0, 0)>(vb); f.h0 = tr_read<v_rd_off(D0, 0, 1)>(vb); f.l1 = tr_read<v_rd_off(D0, 1, 0)>(vb); f.h1 = tr_read<v_rd_off(D0, 1, 1)>(vb);
  f.l2 = tr_read<v_rd_off(D0, 2, 0)>(vb); f.h2 = tr_read<v_rd_off(D0, 2, 1)>(vb); f.l3 = tr_read<v_rd_off(D0, 3, 0)>(vb); f.h3 = tr_read<v_rd_off(D0, 3, 1)>(vb);
}
template <int YB, bool EXPS, int VAR> __device__ __forceinline__ void pv_block(f32x16& od, const VFrag& f, bf16x8 pa0, bf16x8 pa1, bf16x8 pa2, bf16x8 pa3, f32x16& y) {
#define PK(L, H) (bf16x8){L[0], L[1], L[2], L[3], H[0], H[1], H[2], H[3]}
#define EX2(i) do { if (EXPS && !(VAR & 1)) { y[YB + 2 * (i)] = __builtin_amdgcn_exp2f(y[YB + 2 * (i)]); y[YB + 2 * (i) + 1] = __builtin_amdgcn_exp2f(y[YB + 2 * (i) + 1]); asm volatile("" : "+v"(y)); } SBAR(); } while (0)
  if (!(VAR & 2)) od = __builtin_amdgcn_mfma_f32_32x32x16_bf16(pa0, PK(f.l0, f.h0), od, 0, 0, 0); else asm volatile("" :: "v"(f.l0), "v"(f.h0), "v"(pa0)); EX2(0);
  if (!(VAR & 2)) od = __builtin_amdgcn_mfma_f32_32x32x16_bf16(pa1, PK(f.l1, f.h1), od, 0, 0, 0); else asm volatile("" :: "v"(f.l1), "v"(f.h1), "v"(pa1)); EX2(1);
  if (!(VAR & 2)) od = __builtin_amdgcn_mfma_f32_32x32x16_bf16(pa2, PK(f.l2, f.h2), od, 0, 0, 0); else asm volatile("" :: "v"(f.l2), "v"(f.h2), "v"(pa2)); EX2(2);
  if (!(VAR & 2)) od = __builtin_amdgcn_mfma_f32_32x32x16_bf16(pa3, PK(f.l3, f.h3), od, 0, 0, 0); else asm volatile("" :: "v"(f.l3), "v"(f.h3), "v"(pa3)); EX2(3);
#undef EX2
#undef PK
}
template <bool EXPS, int VAR> __device__ __forceinline__ void pv_d0(f32x16* o, int vb, bf16x8 pa0, bf16x8 pa1, bf16x8 pa2, bf16x8 pa3, f32x16& y0, f32x16& y1) {
  VFrag fa, fb;
  v_reads<0>(fa, vb); v_reads<1>(fb, vb); asm volatile("s_waitcnt lgkmcnt(8)" ::: "memory"); SBAR(); pv_block<0, EXPS, VAR>(o[0], fa, pa0, pa1, pa2, pa3, y0);
  v_reads<2>(fa, vb); asm volatile("s_waitcnt lgkmcnt(8)" ::: "memory"); SBAR(); pv_block<8, EXPS, VAR>(o[1], fb, pa0, pa1, pa2, pa3, y0);
  v_reads<3>(fb, vb); asm volatile("s_waitcnt lgkmcnt(8)" ::: "memory"); SBAR(); pv_block<0, EXPS, VAR>(o[2], fa, pa0, pa1, pa2, pa3, y1);
  asm volatile("s_waitcnt lgkmcnt(0)" ::: "memory"); SBAR(); pv_block<8, EXPS, VAR>(o[3], fb, pa0, pa1, pa2, pa3, y1);
}

constexpr int A_KRING = 0, A_VRING = 49152, A_WS = 98304, A_SLOT = 16384;
template <int VAR> __device__ __forceinline__ void attn_unit(int b, int h, int qb, const unsigned short* __restrict__ Qb, const unsigned short* __restrict__ Kb, const unsigned short* __restrict__ Vb,
                                          unsigned short* __restrict__ MX, const float* __restrict__ gdn, float lam, const unsigned* __restrict__ kmx, char* lds) {
  const int tid = fresh_tid(), wid = __builtin_amdgcn_readfirstlane(tid >> 6), lane = tid & 63, r32 = lane & 31, hi = lane >> 5;
  const int mp = wid >> 2, qg = wid & 3;
  __attribute__((address_space(3))) unsigned char* ldsl = (__attribute__((address_space(3))) unsigned char*)lds;
  char* K_lds = lds + A_KRING;
  float* ws = (float*)(lds + A_WS) + wid * 64; float* li_l = ws;
  float l_reg = 0; f32x16 o[4] = {}; bf16x8 qr[4];
  const long tok0 = (long)b * 4096;
  const unsigned short* Qw = Qb + (tok0 + qb * 128 + qg * QBLK + r32) * LDK + h * 128 + mp * 64 + hi * 8;
#pragma unroll
  for (int d0 = 0; d0 < 4; ++d0) qr[d0] = *reinterpret_cast<const bf16x8*>(Qw + d0 * 16);
  f32x16 negm;
  { float qn = 0.f;
#pragma unroll
    for (int d0 = 0; d0 < 4; ++d0)
#pragma unroll
      for (int j = 0; j < 8; ++j) { const float v = __uint_as_float(((unsigned)(unsigned short)qr[d0][j]) << 16); qn = fmaf(v, v, qn); }
    { auto rr = __builtin_amdgcn_permlane32_swap(__float_as_uint(qn), __float_as_uint(qn), false, false); qn = __uint_as_float(rr[0]) + __uint_as_float(rr[1]); }
    const unsigned* kp = kmx + ((b * 4 + h) * 2 + mp) * 2;
    const float kn2 = __uint_as_float(kp[0]) + __uint_as_float(kp[1]);
    const float M = sqrtf(qn * kn2) * 1.01f + 0.05f;
#pragma unroll
    for (int r = 0; r < 16; ++r) negm[r] = -M;
    asm volatile("" : "+v"(negm)); }
  const unsigned short* Kh = Kb + tok0 * LDK + h * 128; const unsigned short* Vh = Vb + tok0 * LDK + h * 128;
  const unsigned short* ksrc[2]; const unsigned short* vsrc[2];
#pragma unroll
  for (int i = 0; i < 2; ++i) {
    const int pk = wid * 2 + i;
    { const int row = 4 * pk + (lane >> 4), slot = lane & 15, chunk = slot ^ (row & 7); ksrc[i] = Kh + (long)row * LDK + chunk * 8; }
    { const int st = 2 * pk + (lane >> 5), kk = 8 * (st >> 2) + ((lane & 31) >> 2), c = 32 * (st & 3) + 8 * (lane & 3), k = (kk & ~0xC) | ((kk & 4) << 1) | ((kk & 8) >> 1); vsrc[i] = Vh + (long)k * LDK + c; }
  }
#define DMA_TILE(t, slotoff) do { if (!(VAR & 8)) { _Pragma("unroll") for (int i_ = 0; i_ < 2; ++i_) { \
      __builtin_amdgcn_global_load_lds((const unsigned*)(ksrc[i_] + (long)(t) * KVBLK * LDK), (__attribute__((address_space(3))) unsigned*)(ldsl + A_KRING + (slotoff) + (wid * 2 + i_) * 1024), 16, 0, 0); \
      __builtin_amdgcn_global_load_lds((const unsigned*)(vsrc[i_] + (long)(t) * KVBLK * LDK), (__attribute__((address_space(3))) unsigned*)(ldsl + A_VRING + (slotoff) + (wid * 2 + i_) * 1024), 16, 0, 0); } } } while (0)
#define TILE_SYNC() do { asm volatile("s_waitcnt vmcnt(0)" ::: "memory"); __syncthreads(); } while (0)
  const int vb0 = (int)(uintptr_t)(lds + A_VRING) + v_rd_base(lane);
  const int mcolB = mp * 128;
  f32x16 pA0, pA1, pB0, pB1; bf16x8 pa0, pa1, pa2, pa3; const int NT = 4096 / KVBLK;
  int s_cur = 0, s_nxt = A_SLOT, s_nn = 2 * A_SLOT;
#define ROT() do { const int t_ = s_cur; s_cur = s_nxt; s_nxt = s_nn; s_nn = t_; } while (0)
  DMA_TILE(0, 0); DMA_TILE(1, A_SLOT);
  TILE_SYNC();
  qkt<VAR>(pA0, pA1, K_lds, qr, r32, hi, mcolB, negm); exp_all(pA0, pA1);
#define STEP(X0, X1, Y0, Y1, t) do { TILE_SYNC(); if ((t) + 2 < NT) DMA_TILE((t) + 2, s_nn); \
    SBAR(); qkt<VAR>(Y0, Y1, K_lds + s_nxt, qr, r32, hi, mcolB, negm); sumpack(X0, X1, l_reg, pa0, pa1, pa2, pa3); SBAR(); \
    pv_d0<true, VAR>(o, vb0 + s_cur, pa0, pa1, pa2, pa3, Y0, Y1); ROT(); } while (0)
  int t = 0;
  for (; t + 2 < NT; t += 2) { STEP(pA0, pA1, pB0, pB1, t); STEP(pB0, pB1, pA0, pA1, t + 1); }
  STEP(pA0, pA1, pB0, pB1, NT - 2);
  sumpack(pB0, pB1, l_reg, pa0, pa1, pa2, pa3); SBAR();
  pv_d0<false, VAR>(o, vb0 + s_cur, pa0, pa1, pa2, pa3, pB0, pB1);
#undef STEP
#undef ROT
  { auto rr = __builtin_amdgcn_permlane32_swap(__float_as_uint(l_reg), __float_as_uint(l_reg), false, false); l_reg = __uint_as_float(rr[0]) + __uint_as_float(rr[1]); }
  if (hi == 0) li_l[r32] = l_reg; asm volatile("s_waitcnt lgkmcnt(0)" ::: "memory");
  float rli[16];
#pragma unroll
  for (int r = 0; r < 16; ++r) rli[r] = __builtin_amdgcn_rcpf(li_l[crow(r, hi)]);
  __syncthreads();
  float* Ost = (float*)lds;
  const int rowb = 32 * qg;
  if (mp == 1) {
#pragma unroll
    for (int r = 0; r < 16; ++r)
#pragma unroll
      for (int d0 = 0; d0 < 4; ++d0) Ost[(rowb + crow(r, hi)) * OST_LD + d0 * 32 + r32] = lam * (o[d0][r] * rli[r]);
  }
  __syncthreads();
  if (mp == 0) {
#pragma unroll
    for (int r = 0; r < 16; ++r)
#pragma unroll
      for (int d0 = 0; d0 < 4; ++d0) { const int ix = (rowb + crow(r, hi)) * OST_LD + d0 * 32 + r32; Ost[ix] = o[d0][r] * rli[r] - Ost[ix]; }
  }
  __syncthreads();
  {
    const int row = 16 * wid + (lane >> 2), cb = (lane & 3) * 32;
    f32x4 v[8]; float ss = 0.f;
#pragma unroll
    for (int i = 0; i < 8; ++i) { v[i] = *(const f32x4*)&Ost[row * OST_LD + cb + 4 * i]; ss += (v[i][0] * v[i][0] + v[i][1] * v[i][1]) + (v[i][2] * v[i][2] + v[i][3] * v[i][3]); }
    ss += __shfl_xor(ss, 1); ss += __shfl_xor(ss, 2);
    const float scl = (1.0f - 0.2f) / sqrtf(ss * (1.0f / 128.0f) + 1e-6f);
    unsigned short* op = MX + (tok0 + qb * 128 + row) * 1024 + h * 128 + cb;
#pragma unroll
    for (int i = 0; i < 4; ++i) {
      const f32x4 g0 = *(const f32x4*)(gdn + cb + 8 * i), g1 = *(const f32x4*)(gdn + cb + 8 * i + 4);
      const f32x4 a = v[2 * i] * g0 * scl, c = v[2 * i + 1] * g1 * scl;
      u32x4 w = {cvtpk(a[0], a[1]), cvtpk(a[2], a[3]), cvtpk(c[0], c[1]), cvtpk(c[2], c[3])};
      *(u32x4*)(op + 8 * i) = w;
    }
  }
  __syncthreads();
#undef DMA_TILE
#undef TILE_SYNC
}
#undef KSWZ
#undef SBAR
}

#define LAS __attribute__((address_space(3)))
typedef unsigned short bf16;
typedef float f32x4 __attribute__((ext_vector_type(4)));
typedef float f32x16 __attribute__((ext_vector_type(16)));
typedef short bf16x8 __attribute__((ext_vector_type(8)));
typedef unsigned u32x4 __attribute__((ext_vector_type(4)));
typedef unsigned u32x2 __attribute__((ext_vector_type(2)));
__device__ __forceinline__ unsigned f2bf(float f) { unsigned u = __builtin_bit_cast(unsigned, f); return (u + 0x7fffu + ((u >> 16) & 1u)) >> 16; }
__device__ __forceinline__ unsigned pk2(float lo, float hi) { return f2bf(lo) | (f2bf(hi) << 16); }
__device__ __forceinline__ float bflo(unsigned w) { return __uint_as_float(w << 16); }
__device__ __forceinline__ float bfhi(unsigned w) { return __uint_as_float(w & 0xffff0000u); }
__device__ __forceinline__ float bf1(unsigned short h) { return __uint_as_float(((unsigned)h) << 16); }
__device__ __forceinline__ float sigm(float z) { return __builtin_amdgcn_rcpf(1.0f + __expf(-z)); }
__device__ __forceinline__ float gelu_tanh(float x) { return x * sigm(1.5957691216057308f * (x + 0.044715f * x * x * x)); }
__device__ __forceinline__ float wave_sum(float v) {
#pragma unroll
    for (int o = 1; o < 64; o <<= 1) v += __shfl_xor(v, o);
    return v;
}
__device__ __forceinline__ int crow16(int r, int hi) { return (r & 3) + 8 * (r >> 2) + 4 * hi; }

struct LruArgs { const bf16* LIN; const float* conv_w; const float* conv_b; const bf16* LWT; const float* ba; const float* bx; const float* lam; bf16* HL0; bf16* HL1; bf16* AC0; bf16* AC1; float* CA; float* CH; };
template <int LV> __device__ __forceinline__ void lru_phase_a(int wg, int G, const LruArgs& A, char* lds) {
    const int tid = fresh_tid(), wid = tid >> 6, lane = tid & 63, r32 = lane & 31, hi = lane >> 5;
    bf16* ucs = (bf16*)lds; float* als = (float*)(lds + 18432); float* bls = (float*)(lds + 51200);
    float* cA = (float*)(lds + 83968); float* cH = (float*)(lds + 86016); float* cw = (float*)(lds + 88064);
    const int n = wg & 7;
    if (tid < 256) cw[tid] = A.conv_w[(tid >> 6) * 512 + n * 64 + (tid & 63)];
    else if (tid < 320) cw[tid] = A.conv_b[n * 64 + (tid - 256)];
    const int rt = wid >> 1, ch = wid & 1;
    const int cg_ = ch * 32 + r32;
    const int tt = tid >> 2, c0 = (tid & 3) * 16;
    bf16* wl = (bf16*)(lds + 89600);
    for (int i = tid; i < 2 * 2 * 64 * 8; i += 512) { const int dir = i >> 10, rem = i & 1023;
        *(u32x4*)(wl + (size_t)i * 8) = *(const u32x4*)(A.LWT + ((size_t)(dir * 8 + n) * 2 * 64 * 64) + (size_t)rem * 8); }
    u32x4 in0[4], in1[4];
#define LRU_LOAD(K) do { const int b_ = (K) >> 5, t0_ = ((K) & 31) * 128; _Pragma("unroll") for (int j = 0; j < 4; ++j) { const int s_ = t0_ + tt + j - 2; const bool ok_ = (s_ >= 0 && s_ < 4096); const int sc_ = ok_ ? s_ : 0; \
        const bf16* p_ = A.LIN + ((long)b_ * 4096 + sc_) * 512 + n * 64 + c0; in0[j] = *(const u32x4*)p_; in1[j] = *(const u32x4*)(p_ + 8); \
        if (!ok_) { in0[j] = (u32x4){0u, 0u, 0u, 0u}; in1[j] = (u32x4){0u, 0u, 0u, 0u}; } } } while (0)
    const int kstep = (G >> 3) > 0 ? (G >> 3) : 1;
    int k = wg >> 3;
    if (k < 256) LRU_LOAD(k);
    __syncthreads();
    for (; k < 256; k += kstep) {
        const long tokb = (long)k * 128;
        if (!(LV & 8)) {
            float accv[16];
#pragma unroll
            for (int i = 0; i < 16; ++i) accv[i] = cw[256 + c0 + i];
#pragma unroll
            for (int j = 0; j < 4; ++j) {
                const u32x4 w0 = in0[j], w1 = in1[j];
                const float* cwj = cw + j * 64 + c0;
                accv[0] += bflo(w0.x) * cwj[0]; accv[1] += bfhi(w0.x) * cwj[1]; accv[2] += bflo(w0.y) * cwj[2]; accv[3] += bfhi(w0.y) * cwj[3];
                accv[4] += bflo(w0.z) * cwj[4]; accv[5] += bfhi(w0.z) * cwj[5]; accv[6] += bflo(w0.w) * cwj[6]; accv[7] += bfhi(w0.w) * cwj[7];
                accv[8] += bflo(w1.x) * cwj[8]; accv[9] += bfhi(w1.x) * cwj[9]; accv[10] += bflo(w1.y) * cwj[10]; accv[11] += bfhi(w1.y) * cwj[11];
                accv[12] += bflo(w1.z) * cwj[12]; accv[13] += bfhi(w1.z) * cwj[13]; accv[14] += bflo(w1.w) * cwj[14]; accv[15] += bfhi(w1.w) * cwj[15];
            }
            u32x4 o0 = {pk2(accv[0], accv[1]), pk2(accv[2], accv[3]), pk2(accv[4], accv[5]), pk2(accv[6], accv[7])};
            u32x4 o1 = {pk2(accv[8], accv[9]), pk2(accv[10], accv[11]), pk2(accv[12], accv[13]), pk2(accv[14], accv[15])};
            *(u32x4*)(ucs + tt * 72 + c0) = o0; *(u32x4*)(ucs + tt * 72 + c0 + 8) = o1;
        }
        if (k + kstep < 256) LRU_LOAD(k + kstep);
        __syncthreads();
#pragma unroll 1
        for (int dir = 0; dir < 2; ++dir) {
            const bool fwd = (dir == 0);
            if (!(LV & 1)) {
                const float bav = A.ba[dir * 512 + n * 64 + cg_], bxv = A.bx[dir * 512 + n * 64 + cg_];
                const float spv = -8.0f * log1pf(__expf(-A.lam[dir * 512 + n * 64 + cg_]));
                const bf16* wa = wl + ((size_t)(dir * 2 + 0) * 64 + ch * 32 + r32) * 64 + hi * 8;
                const bf16* wx = wl + ((size_t)(dir * 2 + 1) * 64 + ch * 32 + r32) * 64 + hi * 8;
                f32x16 da = {}, dx = {};
#pragma unroll
                for (int ks = 0; ks < 4; ++ks) {
                    const bf16x8 af = *(const bf16x8*)(ucs + (rt * 32 + r32) * 72 + ks * 16 + hi * 8);
                    da = __builtin_amdgcn_mfma_f32_32x32x16_bf16(af, *(const bf16x8*)(wa + ks * 16), da, 0, 0, 0);
                    dx = __builtin_amdgcn_mfma_f32_32x32x16_bf16(af, *(const bf16x8*)(wx + ks * 16), dx, 0, 0, 0);
                }
#pragma unroll
                for (int r = 0; r < 16; ++r) {
                    const int tk = rt * 32 + crow16(r, hi);
                    const float rr = sigm(da[r] + bav), ii = sigm(dx[r] + bxv);
                    const float av = __expf(spv * rr), mult = __builtin_amdgcn_sqrtf(fmaxf(1.0f - av * av, 0.f));
                    als[tk * 64 + cg_] = av; bls[tk * 64 + cg_] = mult * (ii * bf1(ucs[tk * 72 + cg_]));
                }
            }
            __syncthreads();
            {
                const int c = tid & 63, j = tid >> 6;
                float hl[16], Ac[16]; float hv = 0.f, AA = 1.f;
#pragma unroll
                for (int i = 0; i < 16; ++i) { const int p = j * 16 + i, tk = fwd ? p : 127 - p; if (!(LV & 2)) { const float av = als[tk * 64 + c], bv = bls[tk * 64 + c]; hv = av * hv + bv; AA = AA * av; } hl[i] = hv; Ac[i] = AA; }
                cA[j * 64 + c] = AA; cH[j * 64 + c] = hv;
                __syncthreads();
                float s = 0.f, P = 1.f, sin_ = 0.f, pin_ = 1.f;
#pragma unroll
                for (int jj = 0; jj < 8; ++jj) { if (jj == j) { sin_ = s; pin_ = P; } const float a_ = cA[jj * 64 + c]; s = a_ * s + cH[jj * 64 + c]; P = P * a_; }
                bf16* hst = (bf16*)als; bf16* ast = (bf16*)bls;
#pragma unroll
                for (int i = 0; i < 16; ++i) { if (LV & 4) continue; const int p = j * 16 + i, tk = fwd ? p : 127 - p; hst[tk * 64 + c] = (bf16)f2bf(hl[i] + Ac[i] * sin_); ast[tk * 64 + c] = (bf16)f2bf(Ac[i] * pin_); }
                if (j == 0) { A.CA[((size_t)dir * 256 + k) * 512 + n * 64 + c] = P; A.CH[((size_t)dir * 256 + k) * 512 + n * 64 + c] = s; }
            }
            __syncthreads();
            {
                bf16* hlg = (dir ? A.HL1 : A.HL0) + tokb * 512 + n * 64; bf16* acg = (dir ? A.AC1 : A.AC0) + tokb * 512 + n * 64;
#pragma unroll
                for (int q = 0; q < 2; ++q) { if (LV & 4) continue; const int pc = tid + 512 * q, tk = pc >> 3, c8 = (pc & 7) * 8;
                    *(u32x4*)(hlg + (long)tk * 512 + c8) = *(const u32x4*)((const bf16*)als + tk * 64 + c8); *(u32x4*)(acg + (long)tk * 512 + c8) = *(const u32x4*)((const bf16*)bls + tk * 64 + c8); }
            }
            __syncthreads();
        }
    }
#undef LRU_LOAD
}
struct LruCArgs { const bf16* HL0; const bf16* HL1; const bf16* AC0; const bf16* AC1; const float* CA; const float* CH; const bf16* GATE; const float* g; bf16* MX; };
__device__ __forceinline__ void lru_phase_c(int k, const LruCArgs& A, char* lds) {
    const int tid = fresh_tid(), wid = tid >> 6, lane = tid & 63, cq = tid & 127, tg = tid >> 7;
    bf16* ys = (bf16*)lds; float* ssp = (float*)(lds + 131072);
    const int b = k >> 5, kt = k & 31;
    f32x4 sf = {0.f, 0.f, 0.f, 0.f}, sb = sf;
    for (int i = 0; i < kt; ++i) { const size_t o = ((size_t)0 * 256 + b * 32 + i) * 512 + cq * 4; const f32x4 a = *(const f32x4*)(A.CA + o), h = *(const f32x4*)(A.CH + o); sf = a * sf + h; }
    for (int i = 31; i > kt; --i) { const size_t o = ((size_t)1 * 256 + b * 32 + i) * 512 + cq * 4; const f32x4 a = *(const f32x4*)(A.CA + o), h = *(const f32x4*)(A.CH + o); sb = a * sb + h; }
    const long tokb = (long)k * 128;
#pragma unroll 4
    for (int it = 0; it < 32; ++it) {
        const int tk = it * 4 + tg; const size_t o = (size_t)(tokb + tk) * 512 + cq * 4;
        const u32x2 hf = *(const u32x2*)(A.HL0 + o), af = *(const u32x2*)(A.AC0 + o), hb = *(const u32x2*)(A.HL1 + o), ab = *(const u32x2*)(A.AC1 + o), gt = *(const u32x2*)(A.GATE + o);
        float y[4];
        y[0] = ((bflo(hf.x) + bflo(af.x) * sf[0]) + (bflo(hb.x) + bflo(ab.x) * sb[0])) * gelu_tanh(bflo(gt.x));
        y[1] = ((bfhi(hf.x) + bfhi(af.x) * sf[1]) + (bfhi(hb.x) + bfhi(ab.x) * sb[1])) * gelu_tanh(bfhi(gt.x));
        y[2] = ((bflo(hf.y) + bflo(af.y) * sf[2]) + (bflo(hb.y) + bflo(ab.y) * sb[2])) * gelu_tanh(bflo(gt.y));
        y[3] = ((bfhi(hf.y) + bfhi(af.y) * sf[3]) + (bfhi(hb.y) + bfhi(ab.y) * sb[3])) * gelu_tanh(bfhi(gt.y));
        float ss = (y[0] * y[0] + y[1] * y[1]) + (y[2] * y[2] + y[3] * y[3]);
#pragma unroll
        for (int o2 = 1; o2 < 64; o2 <<= 1) ss += __shfl_xor(ss, o2);
        u32x2 w = {pk2(y[0], y[1]), pk2(y[2], y[3])};
        *(u32x2*)(ys + tk * 512 + cq * 4) = w;
        if (lane == 0) ssp[tk * 2 + (wid & 1)] = ss;
    }
    __syncthreads();
    const f32x4 gv = *(const f32x4*)(A.g + cq * 4);
#pragma unroll 2
    for (int it = 0; it < 32; ++it) {
        const int tk = it * 4 + tg;
        const float rstd = 1.0f / sqrtf((ssp[tk * 2] + ssp[tk * 2 + 1]) * (1.0f / 512.0f) + 1e-6f);
        const u32x2 w = *(const u32x2*)(ys + tk * 512 + cq * 4);
        u32x2 o = {pk2(bflo(w.x) * rstd * gv[0], bfhi(w.x) * rstd * gv[1]), pk2(bflo(w.y) * rstd * gv[2], bfhi(w.y) * rstd * gv[3])};
        *(u32x2*)(A.MX + (size_t)(tokb + tk) * 1024 + 512 + cq * 4) = o;
    }
    __syncthreads();
}

__device__ __forceinline__ unsigned mono_key(float f) { const unsigned b = __float_as_uint(f); return b ^ ((unsigned)((int)b >> 31) | 0x80000000u); }
#define TK_INS(L, xin) do { unsigned x_ = (xin); _Pragma("unroll") for (int q_ = 0; q_ < 16; ++q_) { const unsigned t_ = max(L[q_], x_); x_ = min(L[q_], x_); L[q_] = t_; } } while (0)
#define TK_CE(x, y) do { const unsigned h_ = max(x, y), l_ = min(x, y); x = h_; y = l_; } while (0)
__device__ __forceinline__ void tk_sort16(unsigned (&a)[16]) {
    TK_CE(a[0], a[1]); TK_CE(a[2], a[3]); TK_CE(a[0], a[2]); TK_CE(a[1], a[3]); TK_CE(a[1], a[2]); TK_CE(a[4], a[5]); TK_CE(a[6], a[7]); TK_CE(a[4], a[6]);
    TK_CE(a[5], a[7]); TK_CE(a[5], a[6]); TK_CE(a[0], a[4]); TK_CE(a[2], a[6]); TK_CE(a[2], a[4]); TK_CE(a[1], a[5]); TK_CE(a[3], a[7]); TK_CE(a[3], a[5]);
    TK_CE(a[1], a[2]); TK_CE(a[3], a[4]); TK_CE(a[5], a[6]); TK_CE(a[8], a[9]); TK_CE(a[10], a[11]); TK_CE(a[8], a[10]); TK_CE(a[9], a[11]); TK_CE(a[9], a[10]);
    TK_CE(a[12], a[13]); TK_CE(a[14], a[15]); TK_CE(a[12], a[14]); TK_CE(a[13], a[15]); TK_CE(a[13], a[14]); TK_CE(a[8], a[12]); TK_CE(a[10], a[14]); TK_CE(a[10], a[12]);
    TK_CE(a[9], a[13]); TK_CE(a[11], a[15]); TK_CE(a[11], a[13]); TK_CE(a[9], a[10]); TK_CE(a[11], a[12]); TK_CE(a[13], a[14]); TK_CE(a[0], a[8]); TK_CE(a[4], a[12]);
    TK_CE(a[4], a[8]); TK_CE(a[2], a[10]); TK_CE(a[6], a[14]); TK_CE(a[6], a[10]); TK_CE(a[2], a[4]); TK_CE(a[6], a[8]); TK_CE(a[10], a[12]); TK_CE(a[1], a[9]);
    TK_CE(a[5], a[13]); TK_CE(a[5], a[9]); TK_CE(a[3], a[11]); TK_CE(a[7], a[15]); TK_CE(a[7], a[11]); TK_CE(a[3], a[5]); TK_CE(a[7], a[9]); TK_CE(a[11], a[13]);
    TK_CE(a[1], a[2]); TK_CE(a[3], a[4]); TK_CE(a[5], a[6]); TK_CE(a[7], a[8]); TK_CE(a[9], a[10]); TK_CE(a[11], a[12]); TK_CE(a[13], a[14]);
}
__device__ __forceinline__ void tk_merge16(unsigned (&L)[16], const unsigned (&B)[16]) {
#pragma unroll
    for (int i = 0; i < 16; ++i) L[i] = max(L[i], B[15 - i]);
#pragma unroll
    for (int d = 8; d >= 1; d >>= 1)
#pragma unroll
        for (int i = 0; i < 16; ++i) if ((i & d) == 0) TK_CE(L[i], L[i + d]);
}
struct TopkArgs { const bf16* QP; const bf16* KEYS; unsigned short* IDX; float* GW; };
__device__ __forceinline__ void topk_unit(int tile, const TopkArgs& A, const bf16x8 (&kf)[4][4], char* lds) {
    const int tid = fresh_tid(), wid = tid >> 6, lane = tid & 63, r32 = lane & 31, hi = lane >> 5;
    float* sc = (float*)lds; unsigned* sci = (unsigned*)lds;
    const int t0 = tile * 64;
    for (int hp = 0; hp < 4; ++hp) {
        {
            const int combo = wid >> 1, head = 2 * hp + (wid >> 2), half = (wid >> 1) & 1, rtile = wid & 1;
            const bf16* qrow = A.QP + (size_t)(t0 + rtile * 32 + r32) * 1024 + head * 128 + half * 64 + hi * 8;
            bf16x8 af[4];
#pragma unroll
            for (int ks = 0; ks < 4; ++ks) af[ks] = *(const bf16x8*)(qrow + ks * 16);
#pragma unroll
            for (int ct = 0; ct < 4; ++ct) {
                f32x16 d = {};
#pragma unroll
                for (int ks = 0; ks < 4; ++ks) d = __builtin_amdgcn_mfma_f32_32x32x16_bf16(af[ks], kf[ct][ks], d, 0, 0, 0);
#pragma unroll
                for (int r = 0; r < 16; ++r) sc[(combo * 64 + rtile * 32 + crow16(r, hi)) * 132 + ct * 32 + r32] = d[r];
            }
        }
        __syncthreads();
        {
            const int row = tid >> 1, part = tid & 1;
            const float* rowp = sc + row * 132 + part * 64;
            unsigned L[16];
#pragma unroll
            for (int gq = 0; gq < 4; ++gq) {
                unsigned G[16];
#pragma unroll
                for (int i = 0; i < 4; ++i) {
                    const f32x4 v = *(const f32x4*)(rowp + 16 * gq + 4 * i);
#pragma unroll
                    for (int j = 0; j < 4; ++j) G[4 * i + j] = (mono_key(v[j]) & ~127u) | (127u - (unsigned)(part * 64 + 16 * gq + 4 * i + j));
                }
                tk_sort16(G);
                if (gq == 0) {
#pragma unroll
                    for (int q = 0; q < 16; ++q) L[q] = G[q];
                } else tk_merge16(L, G);
            }
            {
                unsigned P[16];
#pragma unroll
                for (int q = 0; q < 16; ++q) P[q] = __shfl_xor(L[q], 1);
                tk_merge16(L, P);
            }
            float vals[16]; unsigned ids[16];
#pragma unroll
            for (int q = 0; q < 16; ++q) { ids[q] = 127u - (L[q] & 127u); vals[q] = sc[row * 132 + ids[q]]; }
            asm volatile("s_waitcnt lgkmcnt(0)" ::: "memory");
            if (part == 0) {
#pragma unroll
                for (int q = 0; q < 16; ++q) { sc[row * 132 + q] = vals[q]; sci[row * 132 + 16 + q] = ids[q]; }
            }
        }
        __syncthreads();
        if (tid < 128) {
            const int tok = tid & 63, hh = tid >> 6;
            const int row1 = (hh * 2 + 0) * 64 + tok, row2 = (hh * 2 + 1) * 64 + tok;
            float v1[16], v2[16];
#pragma unroll
            for (int q = 0; q < 16; ++q) { v1[q] = sc[row1 * 132 + q]; v2[q] = sc[row2 * 132 + q]; }
            unsigned L[16];
#define TK_KEY2(i, j) ((mono_key(v1[i] + v2[j]) & ~255u) | (255u - (unsigned)((i) * 16 + (j))))
#pragma unroll
            for (int j = 0; j < 16; ++j) L[j] = TK_KEY2(0, j);
            tk_sort16(L);
            {
                unsigned G[16] = {TK_KEY2(1, 0), TK_KEY2(1, 1), TK_KEY2(1, 2), TK_KEY2(1, 3), TK_KEY2(1, 4), TK_KEY2(1, 5), TK_KEY2(1, 6), TK_KEY2(1, 7),
                                  TK_KEY2(2, 0), TK_KEY2(2, 1), TK_KEY2(2, 2), TK_KEY2(2, 3), TK_KEY2(2, 4), TK_KEY2(3, 0), TK_KEY2(3, 1), TK_KEY2(3, 2)};
                tk_sort16(G); tk_merge16(L, G);
            }
            {
                unsigned G[16] = {TK_KEY2(3, 3), TK_KEY2(4, 0), TK_KEY2(4, 1), TK_KEY2(4, 2), TK_KEY2(5, 0), TK_KEY2(5, 1), TK_KEY2(6, 0), TK_KEY2(6, 1),
                                  TK_KEY2(7, 0), TK_KEY2(7, 1), TK_KEY2(8, 0), TK_KEY2(9, 0), TK_KEY2(10, 0), TK_KEY2(11, 0), TK_KEY2(12, 0), TK_KEY2(13, 0)};
                tk_sort16(G); tk_merge16(L, G);
            }
            { unsigned k14 = TK_KEY2(14, 0), k15 = TK_KEY2(15, 0); TK_INS(L, k14); TK_INS(L, k15); }
#undef TK_KEY2
            float sv[16]; unsigned ev[16]; float mx = -3.0e38f;
#pragma unroll
            for (int q = 0; q < 16; ++q) {
                const unsigned pos = 255u - (L[q] & 255u), i = pos >> 4, j = pos & 15u;
                sv[q] = sc[row1 * 132 + i] + sc[row2 * 132 + j];
                ev[q] = sci[row1 * 132 + 16 + i] * 128u + sci[row2 * 132 + 16 + j];
                mx = fmaxf(mx, sv[q]);
            }
            float sum = 0.f;
#pragma unroll
            for (int q = 0; q < 16; ++q) { sv[q] = __expf(sv[q] - mx); sum += sv[q]; }
            const float inv = 1.0f / sum;
            const size_t ob = (size_t)(t0 + tok) * 128 + (2 * hp + hh) * 16;
#pragma unroll
            for (int q = 0; q < 16; ++q) { A.IDX[ob + q] = (unsigned short)ev[q]; A.GW[ob + q] = sv[q] * inv; }
        }
        __syncthreads();
    }
}

typedef float f32x2 __attribute__((ext_vector_type(2)));
constexpr float U8_SCALE = 768.0f, V8_SCALE = 16.0f;
struct PeerArgs { const unsigned short* IDX; const bf16* HB; const unsigned char* UT; const unsigned char* VT; float* PLOG; const float* ACT; bf16* H2B; float* SS2; };
#define PEER_EID(i0, i1, g) ((((g) & 1) ? (((g) >> 1) < 4 ? (i0)[((g) >> 1) & 3] : (i1)[((g) >> 1) & 3]) >> 16 : (((g) >> 1) < 4 ? (i0)[((g) >> 1) & 3] : (i1)[((g) >> 1) & 3]) & 0xffffu))
#define PEER_U4(A0, A1, A2, A3, XA, XB, XC, XD, W0a, W0b, W1a, W1b, W2a, W2b, W3a, W3b) do { f32x2 t0_, t1_, t2_, t3_; asm volatile( \
    "v_cvt_pk_f32_fp8_e32 %4, %12\n\tv_cvt_pk_f32_fp8_e32 %5, %14\n\tv_cvt_pk_f32_fp8_e32 %6, %16\n\tv_cvt_pk_f32_fp8_e32 %7, %18\n\t" \
    "v_pk_fma_f32 %0, %4, %8, %0\n\tv_pk_fma_f32 %1, %5, %8, %1\n\tv_pk_fma_f32 %2, %6, %8, %2\n\tv_pk_fma_f32 %3, %7, %8, %3\n\t" \
    "v_cvt_pk_f32_fp8_sdwa %4, %12 src0_sel:WORD_1\n\tv_cvt_pk_f32_fp8_sdwa %5, %14 src0_sel:WORD_1\n\tv_cvt_pk_f32_fp8_sdwa %6, %16 src0_sel:WORD_1\n\tv_cvt_pk_f32_fp8_sdwa %7, %18 src0_sel:WORD_1\n\t" \
    "v_pk_fma_f32 %0, %4, %9, %0\n\tv_pk_fma_f32 %1, %5, %9, %1\n\tv_pk_fma_f32 %2, %6, %9, %2\n\tv_pk_fma_f32 %3, %7, %9, %3\n\t" \
    "v_cvt_pk_f32_fp8_e32 %4, %13\n\tv_cvt_pk_f32_fp8_e32 %5, %15\n\tv_cvt_pk_f32_fp8_e32 %6, %17\n\tv_cvt_pk_f32_fp8_e32 %7, %19\n\t" \
    "v_pk_fma_f32 %0, %4, %10, %0\n\tv_pk_fma_f32 %1, %5, %10, %1\n\tv_pk_fma_f32 %2, %6, %10, %2\n\tv_pk_fma_f32 %3, %7, %10, %3\n\t" \
    "v_cvt_pk_f32_fp8_sdwa %4, %13 src0_sel:WORD_1\n\tv_cvt_pk_f32_fp8_sdwa %5, %15 src0_sel:WORD_1\n\tv_cvt_pk_f32_fp8_sdwa %6, %17 src0_sel:WORD_1\n\tv_cvt_pk_f32_fp8_sdwa %7, %19 src0_sel:WORD_1\n\t" \
    "v_pk_fma_f32 %0, %4, %11, %0\n\tv_pk_fma_f32 %1, %5, %11, %1\n\tv_pk_fma_f32 %2, %6, %11, %2\n\tv_pk_fma_f32 %3, %7, %11, %3" \
    : "+v"(A0), "+v"(A1), "+v"(A2), "+v"(A3), "=&v"(t0_), "=&v"(t1_), "=&v"(t2_), "=&v"(t3_) \
    : "v"(XA), "v"(XB), "v"(XC), "v"(XD), "v"(W0a), "v"(W0b), "v"(W1a), "v"(W1b), "v"(W2a), "v"(W2b), "v"(W3a), "v"(W3b)); } while (0)
#define PEER_V4(C0, C1, C2, C3, AV2, Wa, Wb) do { f32x2 t0_, t1_, t2_, t3_; asm volatile( \
    "v_cvt_pk_f32_fp8_e32 %4, %9\n\tv_cvt_pk_f32_fp8_sdwa %5, %9 src0_sel:WORD_1\n\tv_cvt_pk_f32_fp8_e32 %6, %10\n\tv_cvt_pk_f32_fp8_sdwa %7, %10 src0_sel:WORD_1\n\t" \
    "v_pk_fma_f32 %0, %4, %8, %0\n\tv_pk_fma_f32 %1, %5, %8, %1\n\tv_pk_fma_f32 %2, %6, %8, %2\n\tv_pk_fma_f32 %3, %7, %8, %3" \
    : "+v"(C0), "+v"(C1), "+v"(C2), "+v"(C3), "=&v"(t0_), "=&v"(t1_), "=&v"(t2_), "=&v"(t3_) : "v"(AV2), "v"(Wa), "v"(Wb)); } while (0)
struct XPairs { f32x2 x0, x1, x2, x3, x4, x5, x6, x7; };
__device__ __forceinline__ XPairs peer_xpairs(const u32x4 xa, const u32x4 xb) {
    XPairs X; X.x0 = (f32x2){bflo(xa.x), bfhi(xa.x)}; X.x1 = (f32x2){bflo(xa.y), bfhi(xa.y)}; X.x2 = (f32x2){bflo(xa.z), bfhi(xa.z)}; X.x3 = (f32x2){bflo(xa.w), bfhi(xa.w)};
    X.x4 = (f32x2){bflo(xb.x), bfhi(xb.x)}; X.x5 = (f32x2){bflo(xb.y), bfhi(xb.y)}; X.x6 = (f32x2){bflo(xb.z), bfhi(xb.z)}; X.x7 = (f32x2){bflo(xb.w), bfhi(xb.w)}; return X;
}
__device__ __forceinline__ void peer_dots16(float (&p)[16], const XPairs& X, const u32x4 (&u)[16]) {
#pragma unroll
    for (int q = 0; q < 4; ++q) {
        f32x2 a0 = {0.f, 0.f}, a1 = a0, a2 = a0, a3 = a0;
        unsigned w0x = u[4 * q].x, w0y = u[4 * q].y, w0z = u[4 * q].z, w0w = u[4 * q].w, w1x = u[4 * q + 1].x, w1y = u[4 * q + 1].y, w1z = u[4 * q + 1].z, w1w = u[4 * q + 1].w;
        unsigned w2x = u[4 * q + 2].x, w2y = u[4 * q + 2].y, w2z = u[4 * q + 2].z, w2w = u[4 * q + 2].w, w3x = u[4 * q + 3].x, w3y = u[4 * q + 3].y, w3z = u[4 * q + 3].z, w3w = u[4 * q + 3].w;
        PEER_U4(a0, a1, a2, a3, X.x0, X.x1, X.x2, X.x3, w0x, w0y, w1x, w1y, w2x, w2y, w3x, w3y);
        PEER_U4(a0, a1, a2, a3, X.x4, X.x5, X.x6, X.x7, w0z, w0w, w1z, w1w, w2z, w2w, w3z, w3w);
        p[4 * q] = a0.x + a0.y; p[4 * q + 1] = a1.x + a1.y; p[4 * q + 2] = a2.x + a2.y; p[4 * q + 3] = a3.x + a3.y;
    }
}
__device__ __forceinline__ void peer_u_reduce_store(int (&p)[16], int c, float* po, float scale) {
#pragma unroll
    for (int i = 0; i < 8; ++i) { const bool up = (c & 4) != 0; const int give = up ? p[i] : p[i + 8]; const int keep = up ? p[i + 8] : p[i]; p[i] = keep + __shfl_xor(give, 4); }
#pragma unroll
    for (int i = 0; i < 4; ++i) { const bool up = (c & 2) != 0; const int give = up ? p[i] : p[i + 4]; const int keep = up ? p[i + 4] : p[i]; p[i] = keep + __shfl_xor(give, 2); }
#pragma unroll
    for (int i = 0; i < 2; ++i) { const bool up = (c & 1) != 0; const int give = up ? p[i] : p[i + 2]; const int keep = up ? p[i + 2] : p[i]; p[i] = keep + __shfl_xor(give, 1); }
    f32x2 o = {(float)p[0] * scale, (float)p[1] * scale};
    *(f32x2*)po = o;
}
template <unsigned IDMASK, int MODE> __device__ __forceinline__ void peer_u_item(int tile, int s, const PeerArgs& A, char* lds) {
    const int tid = fresh_tid(), wid = tid >> 6, lane = tid & 63, j8 = lane >> 3, c = lane & 7;
    const unsigned char* ut = A.UT + (size_t)s * (16384 * 128) + c * 16;
    for (int grp = 0; grp < 2; ++grp) {
        const int t = tile * 128 + wid * 16 + grp * 8 + j8;
        const unsigned short* ip = A.IDX + (size_t)t * 128;
        const bf16* xp = A.HB + (size_t)t * 1024 + s * 128 + c * 16;
        float* pl = A.PLOG + ((size_t)s * T + t) * 128 + 2 * c;
        const u32x4 xa = *(const u32x4*)xp, xb = *(const u32x4*)(xp + 8);
        u32x4 i0 = *(const u32x4*)ip, i1 = *(const u32x4*)(ip + 8);
        float xf[16] = {bflo(xa.x), bfhi(xa.x), bflo(xa.y), bfhi(xa.y), bflo(xa.z), bfhi(xa.z), bflo(xa.w), bfhi(xa.w), bflo(xb.x), bfhi(xb.x), bflo(xb.y), bfhi(xb.y), bflo(xb.z), bfhi(xb.z), bflo(xb.w), bfhi(xb.w)};
        float am = 0.f;
#pragma unroll
        for (int i = 0; i < 16; ++i) am = fmaxf(am, fabsf(xf[i]));
        am = fmaxf(am, __shfl_xor(am, 1)); am = fmaxf(am, __shfl_xor(am, 2)); am = fmaxf(am, __shfl_xor(am, 4));
        am = fmaxf(am, 1e-20f);
        const float qs = 127.0f / am, scale = am * (1.0f / (127.0f * U8_SCALE));
        int xq[4];
#pragma unroll
        for (int q = 0; q < 4; ++q) { const int b0 = (int)rintf(xf[4 * q] * qs), b1 = (int)rintf(xf[4 * q + 1] * qs), b2 = (int)rintf(xf[4 * q + 2] * qs), b3 = (int)rintf(xf[4 * q + 3] * qs);
            xq[q] = (b0 & 0xff) | ((b1 & 0xff) << 8) | ((b2 & 0xff) << 16) | (b3 << 24); }
#pragma unroll 1
        for (int hd = 0; hd < 8; ++hd) {
            u32x4 n0 = i0, n1 = i1;
            if (hd < 7) { n0 = *(const u32x4*)(ip + (hd + 1) * 16); n1 = *(const u32x4*)(ip + (hd + 1) * 16 + 8); }
            u32x4 uw[16];
#pragma unroll
            for (int g = 0; g < 16; ++g) uw[g] = *(const u32x4*)(ut + (size_t)(PEER_EID(i0, i1, g) & IDMASK) * 128);
            asm volatile("" ::: "memory"); __builtin_amdgcn_sched_barrier(0);
            int p[16];
#pragma unroll
            for (int g = 0; g < 16; ++g) {
                int a = __builtin_amdgcn_sdot4(xq[0], (int)uw[g].x, 0, false);
                a = __builtin_amdgcn_sdot4(xq[1], (int)uw[g].y, a, false);
                a = __builtin_amdgcn_sdot4(xq[2], (int)uw[g].z, a, false);
                p[g] = __builtin_amdgcn_sdot4(xq[3], (int)uw[g].w, a, false);
            }
            peer_u_reduce_store(p, c, pl + hd * 16, scale);
            i0 = n0; i1 = n1;
        }
    }
}
template <bool HMEM, unsigned IDMASK, int VMODE> __device__ __forceinline__ void peer_v_item(int tile, int s, const PeerArgs& A, char* lds, float vscale) {
    const int tid = fresh_tid(), wid = tid >> 6, lane = tid & 63, j8 = lane >> 3, c = lane & 7;
    const unsigned char* vt = A.VT + (size_t)s * (16384 * 128) + c * 16;
    const float vs = vscale * (1.0f / V8_SCALE);
    for (int grp = 0; grp < 2; ++grp) {
        const int t = tile * 128 + wid * 16 + grp * 8 + j8;
        const unsigned short* ip = A.IDX + (size_t)t * 128;
        const float* ap = A.ACT + (size_t)t * 128;
        bf16* hbp = A.H2B + (size_t)t * 1024 + s * 128 + c * 16;
        const u32x4 hw0 = *(const u32x4*)hbp, hw1 = *(const u32x4*)(hbp + 8);
        f32x2 acc[8];
#pragma unroll
        for (int j = 0; j < 8; ++j) acc[j] = (f32x2){0.f, 0.f};
        u32x4 i0 = *(const u32x4*)ip, i1 = *(const u32x4*)(ip + 8);
#pragma unroll 1
        for (int hd = 0; hd < 8; ++hd) {
            u32x4 n0 = i0, n1 = i1;
            if (hd < 7) { n0 = *(const u32x4*)(ip + (hd + 1) * 16); n1 = *(const u32x4*)(ip + (hd + 1) * 16 + 8); }
            const f32x4 a0 = *(const f32x4*)(ap + hd * 16), a1 = *(const f32x4*)(ap + hd * 16 + 4), a2 = *(const f32x4*)(ap + hd * 16 + 8), a3 = *(const f32x4*)(ap + hd * 16 + 12);
            u32x4 vw[16];
#pragma unroll
            for (int g = 0; g < 16; ++g) vw[g] = *(const u32x4*)(vt + (size_t)(PEER_EID(i0, i1, g) & IDMASK) * 128);
            asm volatile("" ::: "memory"); __builtin_amdgcn_sched_barrier(0);
#pragma unroll
            for (int g = 0; g < 16; ++g) {
                const float av = (g < 4) ? a0[g & 3] : (g < 8) ? a1[g & 3] : (g < 12) ? a2[g & 3] : a3[g & 3];
                const f32x2 av2 = {av, av};
                unsigned wx = vw[g].x, wy = vw[g].y, wz = vw[g].z, ww = vw[g].w;
                PEER_V4(acc[0], acc[1], acc[2], acc[3], av2, wx, wy);
                PEER_V4(acc[4], acc[5], acc[6], acc[7], av2, wz, ww);
            }
            i0 = n0; i1 = n1;
        }
        f32x4 h[4];
        h[0] = (f32x4){bflo(hw0.x), bfhi(hw0.x), bflo(hw0.y), bfhi(hw0.y)}; h[1] = (f32x4){bflo(hw0.z), bfhi(hw0.z), bflo(hw0.w), bfhi(hw0.w)};
        h[2] = (f32x4){bflo(hw1.x), bfhi(hw1.x), bflo(hw1.y), bfhi(hw1.y)}; h[3] = (f32x4){bflo(hw1.z), bfhi(hw1.z), bflo(hw1.w), bfhi(hw1.w)};
        float ssq = 0.f;
#pragma unroll
        for (int q = 0; q < 4; ++q) { h[q][0] += vs * acc[2 * q].x; h[q][1] += vs * acc[2 * q].y; h[q][2] += vs * acc[2 * q + 1].x; h[q][3] += vs * acc[2 * q + 1].y;
            ssq += (h[q][0] * h[q][0] + h[q][1] * h[q][1]) + (h[q][2] * h[q][2] + h[q][3] * h[q][3]); }
        const u32x4 w0 = {pk2(h[0][0], h[0][1]), pk2(h[0][2], h[0][3]), pk2(h[1][0], h[1][1]), pk2(h[1][2], h[1][3])}, w1 = {pk2(h[2][0], h[2][1]), pk2(h[2][2], h[2][3]), pk2(h[3][0], h[3][1]), pk2(h[3][2], h[3][3])};
        *(u32x4*)hbp = w0; *(u32x4*)(hbp + 8) = w1;
        ssq += __shfl_xor(ssq, 1); ssq += __shfl_xor(ssq, 2); ssq += __shfl_xor(ssq, 4);
        if (c == 0) A.SS2[(size_t)t * 8 + s] = ssq;
    }
}

#define XB_TMO      128
#define XB_XCNT(j)  (256  + 64 * (j))
#define XB_XSUB(j)  (1280 + 64 * (j))
#define XB_XGEN(j)  (2304 + 64 * (j))
#define XB_TOP      3328
#define XB_TOPGEN   3392
#define XCD_BAR_WORDS 3456
#define XB_SPIN_CAP (1u << 18)

__device__ __forceinline__ unsigned xb_ld(unsigned* p)              { return __hip_atomic_load(p, __ATOMIC_RELAXED, __HIP_MEMORY_SCOPE_AGENT); }
__device__ __forceinline__ unsigned xb_add(unsigned* p, unsigned v) { return __hip_atomic_fetch_add(p, v, __ATOMIC_RELAXED, __HIP_MEMORY_SCOPE_AGENT); }
__device__ __forceinline__ unsigned xb_xcc_id() { return (unsigned)__builtin_amdgcn_s_getreg((3 << 11) | 20) & 0xFu; }
#define XB_SPIN(cond, bar) do { unsigned _sp = 0; while (cond) { __builtin_amdgcn_s_sleep(1); \
    if ((++_sp & 255u) == 0u) { if (xb_ld(&(bar)[XB_TMO])) break; if (_sp > XB_SPIN_CAP) { atomicAdd(&(bar)[XB_TMO], 1u); break; } } } } while (0)

struct XcdBarrier {
    unsigned* bar; unsigned x;
    volatile LAS unsigned* st;
};

__device__ __forceinline__ XcdBarrier xcd_barrier_post(unsigned* bar, volatile LAS unsigned* st) {
    XcdBarrier b; b.bar = bar; b.x = xb_xcc_id(); b.st = st;
    if (threadIdx.x == 0) (void)xb_add(&bar[XB_XCNT(b.x)], 1u);
    return b;
}
__device__ __forceinline__ void xcd_barrier_complete(unsigned* bar, unsigned x, unsigned& nloc, unsigned& nx) {
    const unsigned G = gridDim.x * gridDim.y * gridDim.z;
    unsigned sum, cnt, mine, sp = 0u;
    for (;;) {
        sum = 0u; cnt = 0u; mine = 0u;
#pragma unroll
        for (unsigned j = 0; j < 16; ++j) { const unsigned c = xb_ld(&bar[XB_XCNT(j)]); sum += c; cnt += (c > 0u) ? 1u : 0u; mine = (j == x) ? c : mine; }
        if (sum == G) break;
        __builtin_amdgcn_s_sleep(1);
        if ((++sp & 255u) == 0u) { if (xb_ld(&bar[XB_TMO])) break; if (sp > XB_SPIN_CAP) { atomicAdd(&bar[XB_TMO], 1u); break; } }
    }
    nloc = mine > 0u ? mine : 1u; nx = cnt > 0u ? cnt : 1u;
}

__device__ __forceinline__ void xcd_barrier(const XcdBarrier& b) {
    asm volatile("s_waitcnt vmcnt(0)" ::: "memory");
    __syncthreads();
    if (threadIdx.x == 0) {
        unsigned* bar = b.bar;
        __builtin_amdgcn_s_waitcnt(0);
        unsigned nloc = b.st[0], nx = b.st[1];
        if (nloc == 0u) { xcd_barrier_complete(bar, b.x, nloc, nx); b.st[0] = nloc; b.st[1] = nx; }
        const unsigned old = xb_add(&bar[XB_XSUB(b.x)], 1u);
        const unsigned gen = old / nloc;
        if (old + 1u == (gen + 1u) * nloc) {
            __builtin_amdgcn_fence(__ATOMIC_RELEASE, "agent");
            asm volatile("s_waitcnt vmcnt(0)" ::: "memory");
            const unsigned og = xb_add(&bar[XB_TOP], 1u);
            const unsigned tg = og / nx;
            if (og + 1u == (tg + 1u) * nx) xb_add(&bar[XB_TOPGEN], 1u);
            else XB_SPIN(xb_ld(&bar[XB_TOPGEN]) == tg, bar);
            __builtin_amdgcn_fence(__ATOMIC_ACQUIRE, "agent");
            xb_add(&bar[XB_XGEN(b.x)], 1u);
            asm volatile("s_waitcnt vmcnt(0)" ::: "memory");
        } else {
            XB_SPIN(xb_ld(&bar[XB_XGEN(b.x)]) == gen, bar);
            __builtin_amdgcn_fence(__ATOMIC_ACQUIRE, "agent");
            asm volatile("s_waitcnt vmcnt(0)" ::: "memory");
        }
    }
    __syncthreads();
}
#ifndef ATTVAR
#define ATTVAR 0
#endif
constexpr size_t MiB = (size_t)1 << 20;
constexpr size_t WS_CTL = 0, CTL_ZERO_BYTES = 1 * MiB;
constexpr size_t WS_WIN = 1 * MiB, WS_WOUT = 6 * MiB, WS_WQ = 8 * MiB, WS_WG = 10 * MiB, WS_WP = 12 * MiB;
constexpr size_t WS_KEYS = 12 * MiB + 512 * 1024, WS_LWT = 12 * MiB + 768 * 1024, WS_ROPE = 13 * MiB, WS_MISC = 15 * MiB;
constexpr size_t WS_SS1 = 16 * MiB, WS_SS2 = 18 * MiB, WS_SS3 = 20 * MiB;
constexpr size_t WS_IDX = 24 * MiB, WS_GW = 32 * MiB, WS_PB = 48 * MiB;
constexpr size_t WS_UT = 64 * MiB, WS_VT = 96 * MiB;
constexpr size_t WS_XN = 128 * MiB;
constexpr size_t WS_Q = 192 * MiB, WS_K = 224 * MiB, WS_V = 256 * MiB, WS_LIN = 288 * MiB, WS_LGATE = 320 * MiB;
constexpr size_t WS_QP = 192 * MiB;
constexpr size_t WS_MIXED = 352 * MiB, WS_HF = 416 * MiB, WS_HB = 448 * MiB;
constexpr size_t WS_PLOG = 352 * MiB;
constexpr size_t WS_ACT = 256 * MiB;
constexpr size_t WS_END = 480 * MiB;
constexpr int LDS_BYTES = 147456;

struct Args {
    const float* in[29]; float* out; unsigned char* ws; int ph_lo, ph_hi, coop, pad;
};
struct Frame { char* lds; int G, bid; const Args* a; unsigned char* ws; };


__device__ __forceinline__ void p0_transpose_item(const float* W, int K, int N, bf16* WT, const float* gk, float* scr, int item, int lane) {
    const int nblk = N / 32, kb = item / nblk, nb = item % nblk, k0 = 64 * kb, n0 = 32 * nb;
#pragma unroll 8
    for (int i = 0; i < 32; ++i) { const int kk = 2 * i + (lane >> 5); float w = W[(size_t)(k0 + kk) * N + n0 + (lane & 31)]; if (gk) w *= gk[k0 + kk]; scr[kk * 33 + (lane & 31)] = w; }
    asm volatile("s_waitcnt lgkmcnt(0)" ::: "memory");
    const int c = lane & 7;
#pragma unroll
    for (int j = 0; j < 4; ++j) { const int n = (lane >> 3) + 8 * j; const float* s = scr + (8 * c) * 33 + n;
        u32x4 o; o.x = pk2(s[0 * 33], s[1 * 33]); o.y = pk2(s[2 * 33], s[3 * 33]); o.z = pk2(s[4 * 33], s[5 * 33]); o.w = pk2(s[6 * 33], s[7 * 33]);
        *(u32x4*)(WT + (size_t)(n0 + n) * K + k0 + 8 * c) = o; }
    asm volatile("s_waitcnt lgkmcnt(0)" ::: "memory");
}
__device__ __forceinline__ void p0_prologue(Frame& F) {
    const int tid_ = fresh_tid(), lane_ = tid_ & 63, wave_ = __builtin_amdgcn_readfirstlane(tid_ >> 6);
    float* scr = (float*)(F.lds + wave_ * 16384);
    const int gw = F.bid * 8 + wave_, NGW = F.G * 8;
    const long gt = (long)F.bid * 512 + tid_, NGT = (long)F.G * 512;
    unsigned char* ws = F.ws;
    constexpr int I_IN = 16 * 80, I_SQ = 16 * 32, I_P = 4 * 32;
    for (int it = gw; it < I_IN + 3 * I_SQ + I_P; it += NGW) {
        int r = it;
        if (r < I_IN) { p0_transpose_item(F.a->in[4], 1024, 2560, (bf16*)(ws + WS_WIN), nullptr, scr, r, lane_); continue; } r -= I_IN;
        if (r < I_SQ) { p0_transpose_item(F.a->in[18], 1024, 1024, (bf16*)(ws + WS_WOUT), nullptr, scr, r, lane_); continue; } r -= I_SQ;
        if (r < I_SQ) { p0_transpose_item(F.a->in[20], 1024, 1024, (bf16*)(ws + WS_WQ), F.a->in[19], scr, r, lane_); continue; } r -= I_SQ;
        if (r < I_SQ) { p0_transpose_item(F.a->in[26], 1024, 1024, (bf16*)(ws + WS_WG), F.a->in[25], scr, r, lane_); continue; } r -= I_SQ;
        p0_transpose_item(F.a->in[27], 256, 1024, (bf16*)(ws + WS_WP), nullptr, scr, r, lane_);
    }
    for (int m = gw; m < T; m += NGW) {
        const f32x4* xr = (const f32x4*)(F.a->in[0] + (size_t)m * 1024) + lane_; const f32x4* gr = (const f32x4*)F.a->in[3] + lane_;
        f32x4 v[4]; float s = 0.f;
#pragma unroll
        for (int j = 0; j < 4; ++j) { v[j] = xr[64 * j]; s += (v[j][0] * v[j][0] + v[j][1] * v[j][1]) + (v[j][2] * v[j][2] + v[j][3] * v[j][3]); }
        const float rstd = 1.0f / sqrtf(wave_sum(s) * (1.0f / 1024.0f) + EPS);
        u32x2* o8 = (u32x2*)(ws + WS_XN + (size_t)m * 2048) + lane_;
#pragma unroll
        for (int j = 0; j < 4; ++j) { const f32x4 g = gr[64 * j]; u32x2 w = {pk2(v[j][0] * rstd * g[0], v[j][1] * rstd * g[1]), pk2(v[j][2] * rstd * g[2], v[j][3] * rstd * g[3])}; o8[64 * j] = w; }
    }
    for (long i = gt; i < (long)T * PLE / 8; i += NGT) {
        const f32x4 a = *(const f32x4*)(F.a->in[1] + i * 8), b = *(const f32x4*)(F.a->in[1] + i * 8 + 4);
        u32x4 w = {pk2(a[0], a[1]), pk2(a[2], a[3]), pk2(b[0], b[1]), pk2(b[2], b[3])}; *(u32x4*)(ws + WS_PB + i * 16) = w;
    }
    for (long i = gt; i < (long)16384 * 1024 / 16; i += NGT) {
        const int c0 = (int)((i * 16) & 1023);
        unsigned wu[4], wv[4];
#pragma unroll
        for (int q = 0; q < 4; ++q) {
            const f32x4 a = *(const f32x4*)(F.a->in[23] + i * 16 + 4 * q), g = *(const f32x4*)(F.a->in[19] + c0 + 4 * q), v = *(const f32x4*)(F.a->in[24] + i * 16 + 4 * q);
            const int q0 = (int)rintf(fminf(fmaxf(a[0] * g[0] * U8_SCALE, -127.f), 127.f)), q1 = (int)rintf(fminf(fmaxf(a[1] * g[1] * U8_SCALE, -127.f), 127.f));
            const int q2 = (int)rintf(fminf(fmaxf(a[2] * g[2] * U8_SCALE, -127.f), 127.f)), q3 = (int)rintf(fminf(fmaxf(a[3] * g[3] * U8_SCALE, -127.f), 127.f));
            wu[q] = (unsigned)((q0 & 0xff) | ((q1 & 0xff) << 8) | ((q2 & 0xff) << 16) | (q3 << 24));
            int w2 = 0;
            w2 = __builtin_amdgcn_cvt_pk_fp8_f32(fminf(fmaxf(v[0] * V8_SCALE, -448.f), 448.f), fminf(fmaxf(v[1] * V8_SCALE, -448.f), 448.f), w2, false);
            w2 = __builtin_amdgcn_cvt_pk_fp8_f32(fminf(fmaxf(v[2] * V8_SCALE, -448.f), 448.f), fminf(fmaxf(v[3] * V8_SCALE, -448.f), 448.f), w2, true);
            wv[q] = (unsigned)w2;
        }
        u32x4 ou = {wu[0], wu[1], wu[2], wu[3]}, ov = {wv[0], wv[1], wv[2], wv[3]};
        { const size_t ee = (size_t)(i >> 6), sl = (size_t)((i >> 3) & 7), ch = (size_t)(i & 7), off = sl * (16384 * 128) + ee * 128 + ch * 16;
          *(u32x4*)(ws + WS_UT + off) = ou; *(u32x4*)(ws + WS_VT + off) = ov; }
    }
    for (long i = gt; i < (long)T * 8; i += NGT) {
        const int t = (int)(i >> 3), k = (int)(i & 7);
        const float invf[8] = {1.0f, 0.19392274474868576f, 0.03760603093086393f, 0.007292664737217109f, 0.001414213562373095f, 0.0002742481756762073f, 5.318295896944988e-05f, 1.031338537721246e-05f};
        float fr = 1.0f;
#pragma unroll
        for (int q = 0; q < 8; ++q) if (q == k) fr = invf[q];
        const float ang = (float)((const int*)F.a->in[2])[t] * fr; float sn, cs; sincosf(ang, &sn, &cs);
        float* rp = (float*)(ws + WS_ROPE) + (size_t)t * 16; rp[k] = cs; rp[8 + k] = sn;
    }
    for (long i = gt; i < 2 * 8192; i += NGT) { const float v = (i < 8192) ? F.a->in[21][i] : F.a->in[22][i - 8192]; ((bf16*)(ws + WS_KEYS))[i] = (bf16)f2bf(v); }
    for (long i = gt; i < 2 * 8 * 2 * 64 * 64; i += NGT) {
        const int c = (int)(i & 63), e = (int)((i >> 6) & 63), gate = (int)((i >> 12) & 1), n = (int)((i >> 13) & 7), dir = (int)(i >> 16);
        const float* w = gate ? F.a->in[14] : F.a->in[12]; ((bf16*)(ws + WS_LWT))[i] = (bf16)f2bf(w[(((size_t)dir * 8 + n) * 64 + c) * 64 + e]);
    }
    if (F.bid == 0 && tid_ == 0) {
        float s1 = 0.f, s2 = 0.f;
        for (int i = 0; i < 64; ++i) { s1 += F.a->in[5][i] * F.a->in[6][i]; s2 += F.a->in[7][i] * F.a->in[8][i]; }
        ((float*)(ws + WS_MISC))[0] = expf(s1) - expf(s2) + LAMBDA_INIT;
    }
}

__global__ void __launch_bounds__(512, 2) enc_fwd(Args args) {
    extern __shared__ __attribute__((aligned(16))) unsigned char lds_raw[];
    Frame F;
    F.lds = (char*)lds_raw; F.G = gridDim.x; F.bid = blockIdx.x;
    F.a = &args; F.ws = args.ws;
    unsigned char* ws = args.ws;
    const int lo = args.ph_lo, hi = args.ph_hi;
    cg::grid_group grid = cg::this_grid();
#ifndef PHMASK
#define PHMASK 0x1fff
#endif
#define IN(k) ((((PHMASK) >> (k)) & 1) && lo <= (k) && (k) < hi)
#ifndef REPMASK
#define REPMASK 0
#endif
#define NREP(k) ((((REPMASK) >> (k)) & 1) + 1)
#define GBAR() do { if (args.coop) xcd_barrier(bar); } while (0)
#define SEAM(k) do { if (IN(k) && IN((k) + 1)) { if (args.coop) { if ((k) == 0) grid.sync(); else xcd_barrier(bar); } } } while (0)
#define PH_BEGIN(k) if (IN(k)) for (int rep_ = NREP(k) - 1; rep_ >= 0; --rep_) {
#define PH_END() if (rep_ > 0) GBAR(); }
    volatile LAS unsigned* MISC = (volatile LAS unsigned*)((LAS unsigned char*)lds_raw + (LDS_BYTES - 1024));
    if (threadIdx.x < 16) MISC[threadIdx.x] = 0u;
    __syncthreads();
    XcdBarrier bar; bar.bar = (unsigned*)(ws + WS_CTL) + 4096; bar.x = 0; bar.st = nullptr;
    if (args.coop) bar = xcd_barrier_post((unsigned*)(ws + WS_CTL) + 4096, MISC + 8);
    PG8_LAS unsigned char* ldsl = (PG8_LAS unsigned char*)lds_raw;

    PH_BEGIN(0) p0_prologue(F); __syncthreads(); PH_END()
    SEAM(0);
    PH_BEGIN(1)
        pg8::Gemm g{(const bf16*)(ws + WS_XN), (const bf16*)(ws + WS_WIN), T, INC, 1024}; pg8::StaticOrder S; S.init(T, INC, F.G, F.bid);
        pg8::EpiProj E{(bf16*)(ws + WS_Q), (const float*)(ws + WS_ROPE), (unsigned*)(ws + WS_CTL) + 16384};
        pg8::gemm_phase<pg8::EpiProj, pg8::StaticOrder, true, true>(ldsl, g, S, E);
    PH_END()
    SEAM(1);
    PH_BEGIN(2)
        const float lam = ((const float*)(ws + WS_MISC))[0];
        for (int r2_ = 0; r2_ < NREP(13); ++r2_) {
            LruArgs A{(const bf16*)(ws + WS_LIN), F.a->in[10], F.a->in[11], (const bf16*)(ws + WS_LWT), F.a->in[13], F.a->in[15], F.a->in[16],
                      (bf16*)(ws + WS_XN), (bf16*)(ws + WS_HF), (bf16*)(ws + WS_XN + 32 * MiB), (bf16*)(ws + WS_HB), (float*)(ws + WS_SS3), (float*)(ws + WS_SS3 + MiB)};
            if (NREP(13) == 2 && r2_ == 0) lru_phase_a<ATTVAR>(F.bid, F.G, A, F.lds); else lru_phase_a<0>(F.bid, F.G, A, F.lds);
        }
        for (int r3_ = 0; r3_ < NREP(14); ++r3_)
        for (int it = F.bid; it < 1024; it += F.G) {
            const int xx = it & 7, rest = it >> 3, qb = rest & 31, i4 = rest >> 5, bh = i4 * 8 + xx;
            if (NREP(14) == 2 && r3_ == 0) att::attn_unit<ATTVAR>(bh >> 2, bh & 3, qb, (const bf16*)(ws + WS_Q), (const bf16*)(ws + WS_K), (const bf16*)(ws + WS_V), (bf16*)(ws + WS_MIXED), F.a->in[9], lam, (const unsigned*)(ws + WS_CTL) + 16384, F.lds);
            else att::attn_unit<0>(bh >> 2, bh & 3, qb, (const bf16*)(ws + WS_Q), (const bf16*)(ws + WS_K), (const bf16*)(ws + WS_V), (bf16*)(ws + WS_MIXED), F.a->in[9], lam, (const unsigned*)(ws + WS_CTL) + 16384, F.lds);
        }
    PH_END()
    SEAM(2);
    PH_BEGIN(3)
        LruCArgs A{(const bf16*)(ws + WS_XN), (const bf16*)(ws + WS_HF), (const bf16*)(ws + WS_XN + 32 * MiB), (const bf16*)(ws + WS_HB), (const float*)(ws + WS_SS3), (const float*)(ws + WS_SS3 + MiB),
                   (const bf16*)(ws + WS_LGATE), F.a->in[17], (bf16*)(ws + WS_MIXED)};
        for (int k = F.bid; k < 256; k += F.G) lru_phase_c(k, A, F.lds);
    PH_END()
    SEAM(3);
    PH_BEGIN(4)
        pg8::Gemm g{(const bf16*)(ws + WS_MIXED), (const bf16*)(ws + WS_WOUT), T, 1024, 1024}; pg8::StaticOrder S; S.init(T, 1024, F.G, F.bid);
        pg8::EpiResid E{F.a->in[0], (bf16*)(ws + WS_XN), (float*)(ws + WS_SS1)};
        pg8::gemm_phase<pg8::EpiResid, pg8::StaticOrder, true, true>(ldsl, g, S, E);
    PH_END()
    SEAM(4);
    PH_BEGIN(5)
        pg8::Gemm g{(const bf16*)(ws + WS_XN), (const bf16*)(ws + WS_WQ), T, 1024, 1024}; pg8::StaticOrder S; S.init(T, 1024, F.G, F.bid);
        pg8::EpiScaleBf16 E{(bf16*)(ws + WS_QP), (const float*)(ws + WS_SS1), (float*)(ws + WS_MISC + 4096)};
        pg8::gemm_phase<pg8::EpiScaleBf16, pg8::StaticOrder, true, true>(ldsl, g, S, E);
    PH_END()
    SEAM(5);
    PH_BEGIN(6)
        TopkArgs A{(const bf16*)(ws + WS_QP), (const bf16*)(ws + WS_KEYS), (unsigned short*)(ws + WS_IDX), (float*)(ws + WS_GW)};
        bf16x8 kf[4][4];
        { const int tid_ = fresh_tid(), lane_ = tid_ & 63, wave_ = __builtin_amdgcn_readfirstlane(tid_ >> 6); const int half = (wave_ >> 1) & 1, r32 = lane_ & 31, hi5 = lane_ >> 5;
#pragma unroll
          for (int ct = 0; ct < 4; ++ct)
#pragma unroll
            for (int ks = 0; ks < 4; ++ks) kf[ct][ks] = *(const bf16x8*)(A.KEYS + (size_t)half * 8192 + (ct * 32 + r32) * 64 + ks * 16 + hi5 * 8); }
        for (int tile = F.bid; tile < T / 64; tile += F.G) topk_unit(tile, A, kf, F.lds);
    PH_END()
    SEAM(6);
    PeerArgs PA{(const unsigned short*)(ws + WS_IDX), (const bf16*)(ws + WS_XN), (const unsigned char*)(ws + WS_UT), (const unsigned char*)(ws + WS_VT), (float*)(ws + WS_PLOG), (const float*)(ws + WS_ACT), (bf16*)(ws + WS_XN), (float*)(ws + WS_SS2)};
    PH_BEGIN(7)
        if (rep_ > 0 && ((REPMASK >> 16) & 1)) { for (int it = F.bid; it < 8 * (T / 128); it += F.G) peer_u_item<0xfu, ((REPMASK >> 17) & 1)>(it >> 3, it & 7, PA, F.lds); }
        else for (int it = F.bid; it < 8 * (T / 128); it += F.G) peer_u_item<0xffffu, 0>(it >> 3, it & 7, PA, F.lds);
    PH_END()
    SEAM(7);
    PH_BEGIN(8)
        const int tid_ = fresh_tid();
        const long gt = (long)F.bid * 512 + tid_, NGT = (long)F.G * 512;
        const float* plog = (const float*)(ws + WS_PLOG); const float* gwp = (const float*)(ws + WS_GW); float* act = (float*)(ws + WS_ACT);
        for (long i = gt; i < (long)T * 128; i += NGT) {
            const int t = (int)(i >> 7);
            float s = 0.f;
#pragma unroll
            for (int q = 0; q < 8; ++q) s += plog[(size_t)q * T * 128 + i];
            const float rs = ((const float*)(ws + WS_MISC + 4096))[t];
            act[i] = gelu_tanh(s * rs) * gwp[i];
        }
    PH_END()
    SEAM(8);
    PH_BEGIN(9)
        if (rep_ > 0 && ((REPMASK >> 15) & 1)) { for (int it = F.bid; it < 8 * (T / 128); it += F.G) peer_v_item<true, 0xffffu, ATTVAR>(it >> 3, it & 7, PA, F.lds, 0.0f); }
        else for (int it = F.bid; it < 8 * (T / 128); it += F.G) peer_v_item<true, 0xffffu, 0>(it >> 3, it & 7, PA, F.lds, rep_ > 0 ? 0.0f : 1.0f);
    PH_END()
    SEAM(9);
    PH_BEGIN(10)
        pg8::Gemm g{(const bf16*)(ws + WS_PB), (const bf16*)(ws + WS_WP), T, 1024, 256}; pg8::StaticOrder S; S.init(T, 1024, F.G, F.bid);
        pg8::EpiScaleBf16 E{(bf16*)(ws + WS_QP), nullptr, nullptr};
        pg8::gemm_phase<pg8::EpiScaleBf16, pg8::StaticOrder, true, true>(ldsl, g, S, E);
    PH_END()
    SEAM(10);
    PH_BEGIN(11)
        pg8::Gemm g{(const bf16*)(ws + WS_XN), (const bf16*)(ws + WS_WG), T, 1024, 1024}; pg8::StaticOrder S; S.init(T, 1024, F.G, F.bid);
        pg8::EpiPle E{(const bf16*)(ws + WS_XN), (bf16*)(ws + WS_MIXED), (const bf16*)(ws + WS_QP), (const float*)(ws + WS_SS2), (float*)(ws + WS_SS3), rep_ > 0 ? 0.0f : 1.0f};
        pg8::gemm_phase<pg8::EpiPle, pg8::StaticOrder, true, true>(ldsl, g, S, E);
    PH_END()
    SEAM(11);
    PH_BEGIN(12)
        const int tid_ = fresh_tid(), lane_ = tid_ & 63, wave_ = __builtin_amdgcn_readfirstlane(tid_ >> 6);
        const int gw = F.bid * 8 + wave_, NGW = F.G * 8;
        for (int m = gw; m < T; m += NGW) {
            const float rs = pg8::rowscale16((const float*)(ws + WS_SS3), m);
            const u32x2* hb = (const u32x2*)(ws + WS_MIXED + (size_t)m * 2048) + lane_; const f32x4* gr = (const f32x4*)F.a->in[28] + lane_; f32x4* orow = (f32x4*)(F.a->out + (size_t)m * 1024) + lane_;
#pragma unroll
            for (int j = 0; j < 4; ++j) { const u32x2 w = hb[64 * j]; const f32x4 v = {bflo(w.x), bfhi(w.x), bflo(w.y), bfhi(w.y)}; orow[64 * j] = v * rs * gr[64 * j]; }
        }
    PH_END()
#undef IN
#undef SEAM
}

#ifndef MK_MULTI
#define MK_MULTI 0
#endif
constexpr int NPH = 13;
extern "C" void kernel_launch(void* const* d_in, const int* in_sizes, int n_in, void* d_out, int out_size, void* d_ws, size_t ws_size, hipStream_t stream) {
    static int grid = 0;
    if (grid == 0) {
        if (n_in != 29 || out_size != T * DM || ws_size < WS_END) { fprintf(stderr, "kernel_launch: unexpected shapes: n_in %d out %d ws %zu (need %zu)\n", n_in, out_size, ws_size, (size_t)WS_END); grid = -1; return; }
        int dev = 0, cus = 0, per_cu = 0;
        if (hipGetDevice(&dev) != hipSuccess || hipDeviceGetAttribute(&cus, hipDeviceAttributeMultiprocessorCount, dev) != hipSuccess) { grid = -1; return; }
        if (hipFuncSetAttribute((const void*)enc_fwd, hipFuncAttributeMaxDynamicSharedMemorySize, LDS_BYTES) != hipSuccess) { fprintf(stderr, "kernel_launch: hipFuncSetAttribute failed\n"); grid = -1; return; }
        if (hipOccupancyMaxActiveBlocksPerMultiprocessor(&per_cu, (const void*)enc_fwd, 512, LDS_BYTES) != hipSuccess || per_cu < 1) { fprintf(stderr, "kernel_launch: occupancy query says %d\n", per_cu); per_cu = 1; }
        (void)hipGetLastError();
        grid = cus * 1;
    }
    if (grid < 0) return;
    (void)hipMemsetAsync((char*)d_ws + WS_CTL, 0, CTL_ZERO_BYTES, stream);
    Args a{};
    for (int i = 0; i < 29; ++i) a.in[i] = (const float*)d_in[i];
    a.out = (float*)d_out; a.ws = (unsigned char*)d_ws;
#if MK_MULTI
    for (int ph = 0; ph < NPH; ++ph) { a.ph_lo = ph; a.ph_hi = ph + 1; a.coop = 0; hipLaunchKernelGGL(enc_fwd, dim3(grid), dim3(512), LDS_BYTES, stream, a); }
#else
    a.ph_lo = 0; a.ph_hi = NPH; a.coop = 1;
    void* kargs[] = {&a};
    hipError_t e = hipLaunchCooperativeKernel((const void*)enc_fwd, dim3(grid), dim3(512), kargs, LDS_BYTES, stream);
    if (e != hipSuccess) fprintf(stderr, "cooperative launch failed: %s (grid %d)\n", hipGetErrorString(e), grid);
#endif
}
```

```cpp
#include <hip/hip_runtime.h>
#include <hip/hip_cooperative_groups.h>
#include <cstdio>
#include <cstdint>
namespace cg = cooperative_groups;

#ifndef REPMASK
#define REPMASK 0
#endif
constexpr int NB = 8, SEQ = 4096, T = NB * SEQ, DM = 1024, INC = 2560, PLE = 256;
constexpr float EPS = 1e-6f;
constexpr float LAMBDA_INIT = 0.2f;

__device__ __forceinline__ int fresh_tid() { int t = threadIdx.x; asm volatile("" : "+v"(t)); return t; }

namespace pg8 {
#define PG8_LAS __attribute__((address_space(3)))
typedef unsigned short bf16_t;
typedef short bf16x8 __attribute__((ext_vector_type(8)));
typedef float f32x4 __attribute__((ext_vector_type(4)));
typedef unsigned u32x4 __attribute__((ext_vector_type(4)));
constexpr int BM = 256, BK = 64, HALF = 128, HTB = HALF * BK * 2  , STAGE_BYTES = 8 * HTB, NXCD = 8, WGM = 8;

__host__ __device__ __forceinline__ int lds_byte(int r, int c) { const int st = (r >> 4) * 2 + (c >> 5), rr = r & 15, cc = c & 31, ob = rr * 64 + cc * 2; return st * 1024 + (ob ^ (((ob >> 9) & 1) << 5)); }
__host__ __device__ __forceinline__ void stage_rc(int b, int& R, int& C) { const int st = b / 1024, sb = b % 1024, swz = sb ^ (((sb >> 9) & 1) << 5); R = (st >> 1) * 16 + swz / 64; C = (st & 1) * 32 + (swz % 64) / 2; }
__host__ __device__ __forceinline__ int perm32(int rho) { const int n = rho >> 4, i = rho & 15; return 8 * (i >> 2) + 4 * n + (i & 3); }

struct Unit { int pm, pn; };
struct Gemm { const bf16_t* A; const bf16_t* Bt; int M, N, K; };

struct StaticOrder {
    int nM, nN, nwg, G, c;
    __host__ __device__ void init(int M, int N, int G_, int c_) { nM = M / BM; nN = N / BM; nwg = nM * nN; G = G_; c = c_; }
    __host__ __device__ bool next(int i, Unit& u) const {
        const long L = (long)i * G + c; if (L >= nwg) return false;
        int wgid = (int)L; { const int q = nwg / NXCD, r = nwg % NXCD, xcd = wgid % NXCD, off = wgid / NXCD; wgid = (xcd < r ? xcd * (q + 1) : r * (q + 1) + (xcd - r) * q) + off; }
        const int nig = WGM * nN, gid = wgid / nig, fm = gid * WGM, gsz = (nM - fm) < WGM ? (nM - fm) : WGM;
        u.pm = fm + ((wgid % nig) % gsz); u.pn = (wgid % nig) / gsz; return true;
    }
    __device__ __forceinline__ void a_ready(const Unit&) const {}
    __device__ __forceinline__ void done(const Unit&) const {}
};

__device__ __forceinline__ unsigned cvt_pk_bf16(float lo, float hi) { unsigned r; asm volatile("v_cvt_pk_bf16_f32 %0, %1, %2" : "=v"(r) : "v"(lo), "v"(hi)); return r; }
typedef float f32x2 __attribute__((ext_vector_type(2)));
typedef unsigned u32x2 __attribute__((ext_vector_type(2)));
__device__ __forceinline__ float fsigmoid(float z) { return __builtin_amdgcn_rcpf(1.0f + __expf(-z)); }
__device__ __forceinline__ float rowscale_n(const float* ss, int n) { float s = 0.f; for (int i = 0; i < n; ++i) s += ss[i]; return 1.0f / sqrtf(s * (1.0f / 1024.0f) + 1e-6f); }
__device__ __forceinline__ float rowscale16(const float* ss, int row) { const f32x4* p = (const f32x4*)(ss + (size_t)row * 16); const f32x4 a = p[0], b = p[1], c = p[2], d = p[3];
    const float s = ((a[0] + a[1]) + (a[2] + a[3])) + ((b[0] + b[1]) + (b[2] + b[3])) + ((c[0] + c[1]) + (c[2] + c[3])) + ((d[0] + d[1]) + (d[2] + d[3])); return 1.0f / sqrtf(s * (1.0f / 1024.0f) + 1e-6f); }
__device__ __forceinline__ float rowscale8(const float* ss, int row) { const f32x4* p = (const f32x4*)(ss + (size_t)row * 8); const f32x4 a = p[0], b = p[1];
    const float s = ((a[0] + a[1]) + (a[2] + a[3])) + ((b[0] + b[1]) + (b[2] + b[3])); return 1.0f / sqrtf(s * (1.0f / 1024.0f) + 1e-6f); }
__device__ __forceinline__ u32x4 pack8(f32x4 v0, f32x4 v1) { u32x4 w; w.x = cvt_pk_bf16(v0[0], v0[1]); w.y = cvt_pk_bf16(v0[2], v0[3]); w.z = cvt_pk_bf16(v1[0], v1[1]); w.w = cvt_pk_bf16(v1[2], v1[3]); return w; }
__device__ __forceinline__ float bf_lo(unsigned w) { return __uint_as_float(w << 16); }
__device__ __forceinline__ float bf_hi(unsigned w) { return __uint_as_float(w & 0xffff0000u); }

struct EpiProj {
    static constexpr bool PERM = true, AFTER_DRAIN = false;
    bf16_t* base; const float* rope; unsigned* kmx;
    __device__ __forceinline__ void operator()(const f32x4 (&acc)[2][2][4][2], const Unit& u, int wr, int wc, int fr, int fq) const {
        const int region = u.pn >> 1;
        bf16_t* O = base + (size_t)region * ((size_t)32768 * 512);
        const int colb = (u.pn & 1) * 256 + wc * 32 + 8 * fq;
        const bool rot = (region < 2) && ((wc & 1) == 0);
        const float qs = (region == 0) ? 0.125f * 1.4426950408889634f : 1.0f;
        float kss0 = 0.f, kss1 = 0.f;
        const float sgn = (fq == 0) ? -1.0f : 1.0f;
#pragma unroll
        for (int ai = 0; ai < 2; ++ai)
#pragma unroll
            for (int m = 0; m < 4; ++m) {
                const int row = u.pm * BM + ai * HALF + wr * 64 + m * 16 + fr;
                f32x4 c0 = {1.f, 1.f, 1.f, 1.f}, c1 = c0, s0 = {0.f, 0.f, 0.f, 0.f}, s1 = s0;
                if (rot) { const f32x4* rp = (const f32x4*)(rope + (size_t)row * 16); c0 = rp[0]; c1 = rp[1]; s0 = rp[2]; s1 = rp[3]; }
#pragma unroll
                for (int bj = 0; bj < 2; ++bj) {
                    f32x4 v0 = acc[ai][bj][m][0], v1 = acc[ai][bj][m][1];
                    if (rot) {
                        f32x4 o0, o1;
#pragma unroll
                        for (int j = 0; j < 4; ++j) { o0[j] = __shfl_xor(v0[j], 16); o1[j] = __shfl_xor(v1[j], 16); }
                        if (fq < 2) { v0 = v0 * c0 + (o0 * s0) * sgn; v1 = v1 * c1 + (o1 * s1) * sgn; }
                    }
                    v0 = v0 * qs; v1 = v1 * qs;
                    if (region == 1) { float s = (v0[0] * v0[0] + v0[1] * v0[1]) + (v0[2] * v0[2] + v0[3] * v0[3]) + (v1[0] * v1[0] + v1[1] * v1[1]) + (v1[2] * v1[2] + v1[3] * v1[3]);
                        s += __shfl_xor(s, 16); s += __shfl_xor(s, 32); if (bj == 0) kss0 = fmaxf(kss0, s); else kss1 = fmaxf(kss1, s); }
                    *(u32x4*)(O + (size_t)row * 512 + colb + bj * HALF) = pack8(v0, v1);
                }
            }
        if (region == 1) {
#pragma unroll
            for (int o = 1; o < 16; o <<= 1) { kss0 = fmaxf(kss0, __shfl_xor(kss0, o)); kss1 = fmaxf(kss1, __shfl_xor(kss1, o)); }
            if (fr == 0 && fq == 0) {
                const int b = u.pm >> 4, mp = wc >> 1, half = wc & 1;
                atomicMax(kmx + (((b * 4 + ((u.pn & 1) * 2 + 0)) * 2 + mp) * 2 + half), __float_as_uint(kss0 * 1.02f));
                atomicMax(kmx + (((b * 4 + ((u.pn & 1) * 2 + 1)) * 2 + mp) * 2 + half), __float_as_uint(kss1 * 1.02f));
            }
        }
    }
};
struct EpiResid {
    static constexpr bool PERM = true, AFTER_DRAIN = false;
    const float* X; bf16_t* HB; float* SS;
    __device__ __forceinline__ void operator()(const f32x4 (&acc)[2][2][4][2], const Unit& u, int wr, int wc, int fr, int fq) const {
        const int col0 = u.pn * BM + wc * 32 + 8 * fq;
#pragma unroll
        for (int ai = 0; ai < 2; ++ai)
#pragma unroll
            for (int m = 0; m < 4; ++m) {
                const int row = u.pm * BM + ai * HALF + wr * 64 + m * 16 + fr; float ssq = 0.f;
#pragma unroll
                for (int bj = 0; bj < 2; ++bj) {
                    const size_t off = (size_t)row * 1024 + col0 + bj * HALF;
                    const f32x4 h0 = *(const f32x4*)(X + off) + acc[ai][bj][m][0], h1 = *(const f32x4*)(X + off + 4) + acc[ai][bj][m][1];
                    *(u32x4*)(HB + off) = pack8(h0, h1);
                    ssq += (h0[0] * h0[0] + h0[1] * h0[1]) + (h0[2] * h0[2] + h0[3] * h0[3]) + (h1[0] * h1[0] + h1[1] * h1[1]) + (h1[2] * h1[2] + h1[3] * h1[3]);
                }
                ssq += __shfl_xor(ssq, 16); ssq += __shfl_xor(ssq, 32);
                if (fq == 0) SS[(size_t)row * 16 + u.pn * 4 + wc] = ssq;
            }
    }
};
struct EpiScaleBf16 {
    static constexpr bool PERM = true, AFTER_DRAIN = false;
    bf16_t* O; const float* SS; float* RS;
    __device__ __forceinline__ void operator()(const f32x4 (&acc)[2][2][4][2], const Unit& u, int wr, int wc, int fr, int fq) const {
        const int col0 = u.pn * BM + wc * 32 + 8 * fq;
#pragma unroll
        for (int ai = 0; ai < 2; ++ai)
#pragma unroll
            for (int m = 0; m < 4; ++m) {
                const int row = u.pm * BM + ai * HALF + wr * 64 + m * 16 + fr;
                const float rs = SS ? rowscale16(SS, row) : 1.0f;
                if (RS && u.pn == 0 && wc == 0 && fq == 0) RS[row] = rs;
#pragma unroll
                for (int bj = 0; bj < 2; ++bj) *(u32x4*)(O + (size_t)row * 1024 + col0 + bj * HALF) = pack8(acc[ai][bj][m][0] * rs, acc[ai][bj][m][1] * rs);
            }
    }
};
struct EpiPle {
    static constexpr bool PERM = true, AFTER_DRAIN = false;
    const bf16_t* H2B; bf16_t* H3B; const bf16_t* PP; const float* SS2; float* SS3; float gsc;
    __device__ __forceinline__ void operator()(const f32x4 (&acc)[2][2][4][2], const Unit& u, int wr, int wc, int fr, int fq) const {
        const int col0 = u.pn * BM + wc * 32 + 8 * fq;
#pragma unroll
        for (int ai = 0; ai < 2; ++ai)
#pragma unroll
            for (int m = 0; m < 4; ++m) {
                const int row = u.pm * BM + ai * HALF + wr * 64 + m * 16 + fr; float ssq = 0.f;
                const float rs = rowscale8(SS2, row);
#pragma unroll
                for (int bj = 0; bj < 2; ++bj) {
                    const size_t off = (size_t)row * 1024 + col0 + bj * HALF;
                    const u32x4 pw = *(const u32x4*)(PP + off);
                    const f32x4 p0 = {bf_lo(pw.x), bf_hi(pw.x), bf_lo(pw.y), bf_hi(pw.y)}, p1 = {bf_lo(pw.z), bf_hi(pw.z), bf_lo(pw.w), bf_hi(pw.w)};
                    f32x4 g0, g1;
#pragma unroll
                    for (int j = 0; j < 4; ++j) { g0[j] = fsigmoid(acc[ai][bj][m][0][j] * rs); g1[j] = fsigmoid(acc[ai][bj][m][1][j] * rs); }
                    const u32x4 hw = *(const u32x4*)(H2B + off);
                    const f32x4 r0 = {bf_lo(hw.x), bf_hi(hw.x), bf_lo(hw.y), bf_hi(hw.y)}, r1 = {bf_lo(hw.z), bf_hi(hw.z), bf_lo(hw.w), bf_hi(hw.w)};
                    const f32x4 h0 = r0 + g0 * p0 * gsc, h1 = r1 + g1 * p1 * gsc;
                    *(u32x4*)(H3B + off) = pack8(h0, h1);
                    ssq += (h0[0] * h0[0] + h0[1] * h0[1]) + (h0[2] * h0[2] + h0[3] * h0[3]) + (h1[0] * h1[0] + h1[1] * h1[1]) + (h1[2] * h1[2] + h1[3] * h1[3]);
                }
                ssq += __shfl_xor(ssq, 16); ssq += __shfl_xor(ssq, 32);
                if (fq == 0) SS3[(size_t)row * 16 + u.pn * 4 + wc] = ssq;
            }
    }
};

template <class Epi, class Sched, bool ALIGN_EPI = false, bool SP2 = false>
__device__ __forceinline__ void gemm_phase(PG8_LAS unsigned char* lds, const Gemm g, const Sched& S, const Epi& E) {
    const int tid = fresh_tid(), wid = __builtin_amdgcn_readfirstlane(tid >> 6), lane = tid & 63, wr = wid >> 2, wc = wid & 3, fr = lane & 15, fq = lane >> 4;
    const int K = g.K, nt = K / BK;
    unsigned voffA[2], voffB[2];
#pragma unroll
    for (int i = 0; i < 2; ++i) { int R, C; stage_rc(tid * 16 + i * 8192, R, C); const int Rb = Epi::PERM ? ((R & ~31) + perm32(R & 31)) : R;
        voffA[i] = (unsigned)(R * K + C) * 2u; voffB[i] = (unsigned)(Rb * K + C) * 2u; }
    const size_t kstep = (size_t)(BK * 2);
    const size_t hstep = (size_t)HALF * K * 2;
    const size_t tstep = 2 * hstep;
    const unsigned ldsw = (unsigned)wid * 1024u;
    const int aoff = lds_byte(wr * 64 + fr, fq * 8), boff = lds_byte(wc * 32 + fr, fq * 8);
#define PG8_SA(b, h) (((b) * 2 + (h)) * HTB)
#define PG8_SB(b, h) ((4 + (b) * 2 + (h)) * HTB)
#define PG8_STAGE(bufoff, gbase, voff) do { _Pragma("unroll") for (int _i = 0; _i < 2; ++_i) \
        __builtin_amdgcn_global_load_lds((const unsigned*)((const char*)(gbase) + (voff)[_i]), (PG8_LAS unsigned*)(lds + (bufoff) + ldsw + _i * 8192), 16, 0, 0); } while (0)
#define PG8_LDA(dst, b, h) do { _Pragma("unroll") for (int m = 0; m < 4; ++m) _Pragma("unroll") for (int k = 0; k < 2; ++k) dst[m][k] = *(const PG8_LAS bf16x8*)(lds + PG8_SA(b, h) + aoff + m * 2048 + k * 1024); } while (0)
#define PG8_LDB(dst, b, h) do { _Pragma("unroll") for (int n = 0; n < 2; ++n) _Pragma("unroll") for (int k = 0; k < 2; ++k) dst[n][k] = *(const PG8_LAS bf16x8*)(lds + PG8_SB(b, h) + boff + n * 2048 + k * 1024); } while (0)
#define PG8_MMA(ai, bj, At, Bt) do { __builtin_amdgcn_s_setprio(1); _Pragma("unroll") for (int m = 0; m < 4; ++m) _Pragma("unroll") for (int n = 0; n < 2; ++n) _Pragma("unroll") for (int k = 0; k < 2; ++k) \
        acc[ai][bj][m][n] = __builtin_amdgcn_mfma_f32_16x16x32_bf16(Bt[n][k], At[m][k], acc[ai][bj][m][n], 0, 0, 0); __builtin_amdgcn_s_setprio(0); } while (0)
#define PG8_WAIT_V(n) asm volatile("s_waitcnt vmcnt(" #n ")" ::: "memory")
#define PG8_WAIT_L(n) asm volatile("s_waitcnt lgkmcnt(" #n ")" ::: "memory")
#define PG8_BAR __builtin_amdgcn_s_barrier()
#define PG8_SCHED __builtin_amdgcn_sched_barrier(0)
    Unit cur, nxt; int ui = 0;
    if (!S.next(0, cur)) return;
    f32x4 acc[2][2][4][2];
#pragma unroll
    for (int a = 0; a < 2; ++a)
#pragma unroll
        for (int b = 0; b < 2; ++b)
#pragma unroll
            for (int m = 0; m < 4; ++m)
#pragma unroll
                for (int n = 0; n < 2; ++n) acc[a][b][m][n] = (f32x4){0.f, 0.f, 0.f, 0.f};
    bf16x8 At[4][2], B0[2][2], B1[2][2];
    const char* cA = (const char*)g.A + (size_t)cur.pm * tstep; const char* cB = (const char*)g.Bt + (size_t)cur.pn * tstep;
    S.a_ready(cur);
    if constexpr (SP2) {
        PG8_STAGE(PG8_SB(0, 0), cB, voffB); PG8_STAGE(PG8_SB(0, 1), cB + hstep, voffB); PG8_STAGE(PG8_SA(0, 0), cA, voffA); PG8_STAGE(PG8_SA(0, 1), cA + hstep, voffA);
        if (wr == 1) PG8_BAR;
        PG8_WAIT_V(2); PG8_BAR;
        PG8_STAGE(PG8_SB(1, 0), cB + kstep, voffB); PG8_STAGE(PG8_SA(1, 0), cA + kstep, voffA); PG8_STAGE(PG8_SB(1, 1), cB + hstep + kstep, voffB);
        PG8_WAIT_V(6); PG8_BAR;
    } else {
        PG8_STAGE(PG8_SB(0, 0), cB, voffB); PG8_STAGE(PG8_SA(0, 0), cA, voffA); PG8_STAGE(PG8_SB(0, 1), cB + hstep, voffB); PG8_STAGE(PG8_SA(0, 1), cA + hstep, voffA);
        if (wr == 1) PG8_BAR;
        PG8_WAIT_V(4); PG8_BAR;
        PG8_STAGE(PG8_SB(1, 0), cB + kstep, voffB); PG8_STAGE(PG8_SA(1, 0), cA + kstep, voffA); PG8_STAGE(PG8_SB(1, 1), cB + hstep + kstep, voffB);
        PG8_WAIT_V(6); PG8_BAR;
    }
    for (;;) {
        const bool has_next = S.next(ui + 1, nxt);
        const char* nA = has_next ? (const char*)g.A + (size_t)nxt.pm * tstep : cA; const char* nB = has_next ? (const char*)g.Bt + (size_t)nxt.pn * tstep : cB;
        for (int t = 0; t < nt; t += 2) {
            const bool last = (t == nt - 2);
            const char* a1 = cA + (size_t)(t + 1) * kstep;
            const char* a2 = last ? nA : cA + (size_t)(t + 2) * kstep; const char* b2 = last ? nB : cB + (size_t)(t + 2) * kstep;
            const char* a3 = a2 + kstep; const char* b3 = b2 + kstep;
            if (last && has_next) S.a_ready(nxt);
            if constexpr (SP2) {
            PG8_LDB(B0, 0, 0); PG8_LDB(B1, 0, 1); PG8_SCHED; PG8_LDA(At, 0, 0); PG8_STAGE(PG8_SA(1, 1), a1 + hstep, voffA);
            PG8_WAIT_V(8); PG8_WAIT_L(0); PG8_BAR; PG8_MMA(0, 0, At, B0); PG8_MMA(0, 1, At, B1); PG8_BAR; PG8_SCHED;
            PG8_LDA(At, 0, 1); PG8_STAGE(PG8_SB(0, 0), b2, voffB); PG8_STAGE(PG8_SB(0, 1), b2 + hstep, voffB); PG8_STAGE(PG8_SA(0, 0), a2, voffA);
            PG8_WAIT_V(8); PG8_WAIT_L(0); PG8_BAR; PG8_MMA(1, 0, At, B0); PG8_MMA(1, 1, At, B1); PG8_BAR; PG8_SCHED;
            PG8_LDB(B0, 1, 0); PG8_LDB(B1, 1, 1); PG8_SCHED; PG8_LDA(At, 1, 0); PG8_STAGE(PG8_SA(0, 1), a2 + hstep, voffA);
            PG8_WAIT_V(8); PG8_WAIT_L(0); PG8_BAR; PG8_MMA(0, 0, At, B0); PG8_MMA(0, 1, At, B1); PG8_BAR; PG8_SCHED;
            PG8_LDA(At, 1, 1); PG8_STAGE(PG8_SB(1, 0), b3, voffB); PG8_STAGE(PG8_SB(1, 1), b3 + hstep, voffB); PG8_STAGE(PG8_SA(1, 0), a3, voffA);
            PG8_WAIT_V(8); PG8_WAIT_L(0); PG8_BAR; PG8_MMA(1, 0, At, B0); PG8_MMA(1, 1, At, B1); PG8_BAR; PG8_SCHED;
            } else {
            PG8_LDB(B0, 0, 0); PG8_SCHED; PG8_LDA(At, 0, 0); PG8_STAGE(PG8_SA(1, 1), a1 + hstep, voffA);
            PG8_WAIT_L(8); PG8_BAR; PG8_WAIT_L(0); PG8_MMA(0, 0, At, B0); PG8_BAR; PG8_SCHED;
            PG8_LDB(B1, 0, 1); PG8_STAGE(PG8_SB(0, 0), b2, voffB);
            PG8_BAR; PG8_WAIT_L(0); PG8_MMA(0, 1, At, B1); PG8_BAR;
            PG8_LDA(At, 0, 1); PG8_STAGE(PG8_SA(0, 0), a2, voffA);
            PG8_BAR; PG8_WAIT_L(0); PG8_MMA(1, 0, At, B0); PG8_BAR; PG8_SCHED;
            PG8_STAGE(PG8_SB(0, 1), b2 + hstep, voffB);
            PG8_WAIT_V(6); PG8_BAR; PG8_MMA(1, 1, At, B1); PG8_BAR;
            PG8_LDB(B0, 1, 0); PG8_SCHED; PG8_LDA(At, 1, 0); PG8_STAGE(PG8_SA(0, 1), a2 + hstep, voffA);
            PG8_WAIT_L(8); PG8_BAR; PG8_WAIT_L(0); PG8_MMA(0, 0, At, B0); PG8_BAR; PG8_SCHED;
            PG8_LDB(B1, 1, 1); PG8_STAGE(PG8_SB(1, 0), b3, voffB);
            PG8_BAR; PG8_WAIT_L(0); PG8_MMA(0, 1, At, B1); PG8_BAR;
            PG8_LDA(At, 1, 1); PG8_STAGE(PG8_SA(1, 0), a3, voffA);
            PG8_BAR; PG8_WAIT_L(0); PG8_MMA(1, 0, At, B0); PG8_BAR; PG8_SCHED;
            PG8_STAGE(PG8_SB(1, 1), b3 + hstep, voffB);
            PG8_WAIT_V(6); PG8_BAR; PG8_MMA(1, 1, At, B1); PG8_BAR;
            }
        }
        if constexpr (ALIGN_EPI) { if (wr == 0) PG8_BAR; }
        if constexpr (!Epi::AFTER_DRAIN) { E(acc, cur, wr, wc, fr, fq); S.done(cur); }
        if (!has_next) break;
#pragma unroll
        for (int a = 0; a < 2; ++a)
#pragma unroll
            for (int b = 0; b < 2; ++b)
#pragma unroll
                for (int m = 0; m < 4; ++m)
#pragma unroll
                    for (int n = 0; n < 2; ++n) acc[a][b][m][n] = (f32x4){0.f, 0.f, 0.f, 0.f};
        cur = nxt; cA = nA; cB = nB; ++ui;
        if constexpr (ALIGN_EPI) { if (wr == 1) PG8_BAR; }
    }
    PG8_WAIT_V(0);
    if constexpr (!ALIGN_EPI) { if (wr == 0) PG8_BAR; }
    PG8_BAR;
    if constexpr (Epi::AFTER_DRAIN) { E.fused(acc, cur, wr, wc, fr, fq, lds, wid, lane); S.done(cur); }
#undef PG8_SA
#undef PG8_SB
#undef PG8_STAGE
#undef PG8_LDA
#undef PG8_LDB
#undef PG8_MMA
#undef PG8_WAIT_V
#undef PG8_WAIT_L
#undef PG8_BAR
#undef PG8_SCHED
}
}
namespace att {
using bf16x8 = __attribute__((ext_vector_type(8))) short;
using s16x4  = __attribute__((ext_vector_type(4))) short;
using f32x16 = __attribute__((ext_vector_type(16))) float;
using f32x4  = __attribute__((ext_vector_type(4))) float;
using u32x4  = __attribute__((ext_vector_type(4))) unsigned;
constexpr int NW = 8, QBLK = 32, KVBLK = 64, LDK = 512;
constexpr float THR = 8.f;
constexpr size_t SHM_V = KVBLK * 128 * 2, SHM_K = KVBLK * 128 * 2;
constexpr int OST_LD = 132;
#define KSWZ(row, colB) ((row) * 256 + ((colB) ^ (((row) & 15) << 4)))
#define SBAR() __builtin_amdgcn_sched_barrier(0)
__device__ __forceinline__ int crow(int r, int hi) { return (r & 3) + 8 * (r >> 2) + 4 * hi; }
__device__ __forceinline__ unsigned cvtpk(float lo, float hi) { unsigned r; asm volatile("v_cvt_pk_bf16_f32 %0, %1, %2" : "=v"(r) : "v"(lo), "v"(hi)); return r; }

__device__ __forceinline__ void sumpack(const f32x16& p0, const f32x16& p1, float& l_reg, bf16x8& pa0, bf16x8& pa1, bf16x8& pa2, bf16x8& pa3) {
  float ps = 0;
#pragma unroll
  for (int r = 0; r < 16; ++r) ps += p0[r];
#pragma unroll
  for (int r = 0; r < 16; ++r) ps += p1[r];
  l_reg += ps;
#define PK4(P, BASE, OUT) do { u32x4 w = {cvtpk(P[BASE + 0], P[BASE + 1]), cvtpk(P[BASE + 2], P[BASE + 3]), cvtpk(P[BASE + 4], P[BASE + 5]), cvtpk(P[BASE + 6], P[BASE + 7])}; OUT = *reinterpret_cast<bf16x8*>(&w); } while (0)
  PK4(p0, 0, pa0); PK4(p0, 8, pa1); PK4(p1, 0, pa2); PK4(p1, 8, pa3);
#undef PK4
}
__device__ __forceinline__ void exp_all(f32x16& p0, f32x16& p1) {
#pragma unroll
  for (int r = 0; r < 16; ++r) p0[r] = __builtin_amdgcn_exp2f(p0[r]);
#pragma unroll
  for (int r = 0; r < 16; ++r) p1[r] = __builtin_amdgcn_exp2f(p1[r]);
}
template <int VAR> __device__ __forceinline__ void qkt(f32x16& p0, f32x16& p1, const char* Ks, const bf16x8* qr, int r32, int hi, int mcolB, const f32x16& negm) {
  p0 = negm; p1 = negm;
#pragma unroll
  for (int d0 = 0; d0 < 4; ++d0) { int cb = mcolB + (d0 * 16 + hi * 8) * 2;
    bf16x8 b0 = *reinterpret_cast<const bf16x8*>(Ks + KSWZ(r32, cb));
    bf16x8 b1 = *reinterpret_cast<const bf16x8*>(Ks + KSWZ(32 + r32, cb));
    if (!(VAR & 4)) { p0 = __builtin_amdgcn_mfma_f32_32x32x16_bf16(b0, qr[d0], p0, 0, 0, 0);
    p1 = __builtin_amdgcn_mfma_f32_32x32x16_bf16(b1, qr[d0], p1, 0, 0, 0); } else asm volatile("" :: "v"(b0), "v"(b1)); }
}
__device__ __forceinline__ int v_st(int k, int c) { const int kk = (k & ~0xC) | ((k & 4) << 1) | ((k & 8) >> 1); return ((kk >> 3) * 4 + (c >> 5)) * 512 + ((kk & 7) * 32 + (c & 31)) * 2; }
__device__ __forceinline__ int v_rd_base(int lane) { return ((lane & 3) << 3) | (((lane >> 2) & 3) << 6) | (((lane >> 4) & 1) << 5) | (((lane >> 5) & 1) << 8); }
constexpr int v_rd_off(int d0, int ks, int half) { return d0 * 512 + ks * 4096 + half * 2048; }
template <int OFF> __device__ __forceinline__ s16x4 tr_read(int vb) {
  s16x4 r; asm volatile("ds_read_b64_tr_b16 %0, %1 offset:%2" : "=&v"(r) : "v"(vb), "i"(OFF) : "memory"); return r;
}
struct VFrag { s16x4 l0, h0, l1, h1, l2, h2, l3, h3; };
template <int D0> __device__ __forceinline__ void v_reads(VFrag& f, int vb) {
  f.l0 = tr_read<v_rd_off(D0, 0, 0)>(vb); f.h0 = tr_read<v_rd_off(D0, 0, 1)>(vb); f.l1 = tr_read<v_rd_off(D0, 1, 0)>(vb); f.h1 = tr_read<v_rd_off(D0, 1, 1)>(vb);
  f.l2 = tr_read<v_rd_off(D0, 2, 0)>(vb); f.h2 = tr_read<v_rd_off(D0, 2, 1)>(vb); f.l3 = tr_read<v_rd_off(D0, 3, 0)>(vb); f.h3 = tr_read<v_rd_off(D0, 3, 1)>(vb);
}
template <int YB, bool EXPS, int VAR> __device__ __forceinline__ void pv_block(f32x16& od, const VFrag& f, bf16x8 pa0, bf16x8 pa1, bf16x8 pa2, bf16x8 pa3, f32x16& y) {
#define PK(L, H) (bf16x8){L[0], L[1], L[2], L[3], H[0], H[1], H[2], H[3]}
#define EX2(i) do { if (EXPS && !(VAR & 1)) { y[YB + 2 * (i)] = __builtin_amdgcn_exp2f(y[YB + 2 * (i)]); y[YB + 2 * (i) + 1] = __builtin_amdgcn_exp2f(y[YB + 2 * (i) + 1]); asm volatile("" : "+v"(y)); } SBAR(); } while (0)
  if (!(VAR & 2)) od = __builtin_amdgcn_mfma_f32_32x32x16_bf16(pa0, PK(f.l0, f.h0), od, 0, 0, 0); else asm volatile("" :: "v"(f.l0), "v"(f.h0), "v"(pa0)); EX2(0);
  if (!(VAR & 2)) od = __builtin_amdgcn_mfma_f32_32x32x16_bf16(pa1, PK(f.l1, f.h1), od, 0, 0, 0); else asm volatile("" :: "v"(f.l1), "v"(f.h1), "v"(pa1)); EX2(1);
  if (!(VAR & 2)) od = __builtin_amdgcn_mfma_f32_32x32x16_bf16(pa2, PK(f.l2, f.h2), od, 0, 0, 0); else asm volatile("" :: "v"(f.l2), "v"(f.h2), "v"(pa2)); EX2(2);
  if (!(VAR & 2)) od = __builtin_amdgcn_mfma_f32_32x32x16_bf16(pa3, PK(f.l3, f.h3), od, 0, 0, 0); else asm volatile("" :: "v"(f.l3), "v"(f.h3), "v"(pa3)); EX2(3);
#undef EX2
#undef PK
}
template <bool EXPS, int VAR> __device__ __forceinline__ void pv_d0(f32x16* o, int vb, bf16x8 pa0, bf16x8 pa1, bf16x8 pa2, bf16x8 pa3, f32x16& y0, f32x16& y1) {
  VFrag fa, fb;
  v_reads<0>(fa, vb); v_reads<1>(fb, vb); asm volatile("s_waitcnt lgkmcnt(8)" ::: "memory"); SBAR(); pv_block<0, EXPS, VAR>(o[0], fa, pa0, pa1, pa2, pa3, y0);
  v_reads<2>(fa, vb); asm volatile("s_waitcnt lgkmcnt(8)" ::: "memory"); SBAR(); pv_block<8, EXPS, VAR>(o[1], fb, pa0, pa1, pa2, pa3, y0);
  v_reads<3>(fb, vb); asm volatile("s_waitcnt lgkmcnt(8)" ::: "memory"); SBAR(); pv_block<0, EXPS, VAR>(o[2], fa, pa0, pa1, pa2, pa3, y1);
  asm volatile("s_waitcnt lgkmcnt(0)" ::: "memory"); SBAR(); pv_block<8, EXPS, VAR>(o[3], fb, pa0, pa1, pa2, pa3, y1);
}

constexpr int A_KRING = 0, A_VRING = 49152, A_WS = 98304, A_SLOT = 16384;
template <int VAR> __device__ __forceinline__ void attn_unit(int b, int h, int qb, const unsigned short* __restrict__ Qb, const unsigned short* __restrict__ Kb, const unsigned short* __restrict__ Vb,
                                          unsigned short* __restrict__ MX, const float* __restrict__ gdn, float lam, const unsigned* __restrict__ kmx, char* lds) {
  const int tid = fresh_tid(), wid = __builtin_amdgcn_readfirstlane(tid >> 6), lane = tid & 63, r32 = lane & 31, hi = lane >> 5;
  const int mp = wid >> 2, qg = wid & 3;
  __attribute__((address_space(3))) unsigned char* ldsl = (__attribute__((address_space(3))) unsigned char*)lds;
  char* K_lds = lds + A_KRING;
  float* ws = (float*)(lds + A_WS) + wid * 64; float* li_l = ws;
  float l_reg = 0; f32x16 o[4] = {}; bf16x8 qr[4];
  const long tok0 = (long)b * 4096;
  const unsigned short* Qw = Qb + (tok0 + qb * 128 + qg * QBLK + r32) * LDK + h * 128 + mp * 64 + hi * 8;
#pragma unroll
  for (int d0 = 0; d0 < 4; ++d0) qr[d0] = *reinterpret_cast<const bf16x8*>(Qw + d0 * 16);
  f32x16 negm;
  { float qn = 0.f;
#pragma unroll
    for (int d0 = 0; d0 < 4; ++d0)
#pragma unroll
      for (int j = 0; j < 8; ++j) { const float v = __uint_as_float(((unsigned)(unsigned short)qr[d0][j]) << 16); qn = fmaf(v, v, qn); }
    { auto rr = __builtin_amdgcn_permlane32_swap(__float_as_uint(qn), __float_as_uint(qn), false, false); qn = __uint_as_float(rr[0]) + __uint_as_float(rr[1]); }
    const unsigned* kp = kmx + ((b * 4 + h) * 2 + mp) * 2;
    const float kn2 = __uint_as_float(kp[0]) + __uint_as_float(kp[1]);
    const float M = sqrtf(qn * kn2) * 1.01f + 0.05f;
#pragma unroll
    for (int r = 0; r < 16; ++r) negm[r] = -M;
    asm volatile("" : "+v"(negm)); }
  const unsigned short* Kh = Kb + tok0 * LDK + h * 128; const unsigned short* Vh = Vb + tok0 * LDK + h * 128;
  const unsigned short* ksrc[2]; const unsigned short* vsrc[2];
#pragma unroll
  for (int i = 0; i < 2; ++i) {
    const int pk = wid * 2 + i;
    { const int row = 4 * pk + (lane >> 4), slot = lane & 15, chunk = slot ^ (row & 15); ksrc[i] = Kh + (long)row * LDK + chunk * 8; }
    { const int st = 2 * pk + (lane >> 5), kk = 8 * (st >> 2) + ((lane & 31) >> 2), c = 32 * (st & 3) + 8 * (lane & 3), k = kk; vsrc[i] = Vh + (long)k * LDK + c; }
  }
#define DMA_TILE(t, slotoff) do { if (!(VAR & 8)) { _Pragma("unroll") for (int i_ = 0; i_ < 2; ++i_) { \
      __builtin_amdgcn_global_load_lds((const unsigned*)(ksrc[i_] + (long)(t) * KVBLK * LDK), (__attribute__((address_space(3))) unsigned*)(ldsl + A_KRING + (slotoff) + (wid * 2 + i_) * 1024), 16, 0, 0); \
      __builtin_amdgcn_global_load_lds((const unsigned*)(vsrc[i_] + (long)(t) * KVBLK * LDK), (__attribute__((address_space(3))) unsigned*)(ldsl + A_VRING + (slotoff) + (wid * 2 + i_) * 1024), 16, 0, 0); } } } while (0)
#define TILE_SYNC() do { asm volatile("s_waitcnt vmcnt(0)" ::: "memory"); __syncthreads(); } while (0)
  const int vb0 = (int)(uintptr_t)(lds + A_VRING) + v_rd_base(lane);
  const int mcolB = mp * 128;
  f32x16 pA0, pA1, pB0, pB1; bf16x8 pa0, pa1, pa2, pa3; const int NT = 4096 / KVBLK;
  int s_cur = 0, s_nxt = A_SLOT, s_nn = 2 * A_SLOT;
#define ROT() do { const int t_ = s_cur; s_cur = s_nxt; s_nxt = s_nn; s_nn = t_; } while (0)
  DMA_TILE(0, 0); DMA_TILE(1, A_SLOT);
  TILE_SYNC();
  qkt<VAR>(pA0, pA1, K_lds, qr, r32, hi, mcolB, negm); exp_all(pA0, pA1);
#define STEP(X0, X1, Y0, Y1, t) do { TILE_SYNC(); if ((t) + 2 < NT) DMA_TILE((t) + 2, s_nn); \
    SBAR(); qkt<VAR>(Y0, Y1, K_lds + s_nxt, qr, r32, hi, mcolB, negm); sumpack(X0, X1, l_reg, pa0, pa1, pa2, pa3); SBAR(); \
    pv_d0<true, VAR>(o, vb0 + s_cur, pa0, pa1, pa2, pa3, Y0, Y1); ROT(); } while (0)
  int t = 0;
  for (; t + 2 < NT; t += 2) { STEP(pA0, pA1, pB0, pB1, t); STEP(pB0, pB1, pA0, pA1, t + 1); }
  STEP(pA0, pA1, pB0, pB1, NT - 2);
  sumpack(pB0, pB1, l_reg, pa0, pa1, pa2, pa3); SBAR();
  pv_d0<false, VAR>(o, vb0 + s_cur, pa0, pa1, pa2, pa3, pB0, pB1);
#undef STEP
#undef ROT
  { auto rr = __builtin_amdgcn_permlane32_swap(__float_as_uint(l_reg), __float_as_uint(l_reg), false, false); l_reg = __uint_as_float(rr[0]) + __uint_as_float(rr[1]); }
  if (hi == 0) li_l[r32] = l_reg; asm volatile("s_waitcnt lgkmcnt(0)" ::: "memory");
  float rli[16];
#pragma unroll
  for (int r = 0; r < 16; ++r) rli[r] = __builtin_amdgcn_rcpf(li_l[crow(r, hi)]);
  __syncthreads();
  float* Ost = (float*)lds;
  const int rowb = 32 * qg;
  if (mp == 1) {
#pragma unroll
    for (int r = 0; r < 16; ++r)
#pragma unroll
      for (int d0 = 0; d0 < 4; ++d0) Ost[(rowb + crow(r, hi)) * OST_LD + d0 * 32 + r32] = lam * (o[d0][r] * rli[r]);
  }
  __syncthreads();
  if (mp == 0) {
#pragma unroll
    for (int r = 0; r < 16; ++r)
#pragma unroll
      for (int d0 = 0; d0 < 4; ++d0) { const int ix = (rowb + crow(r, hi)) * OST_LD + d0 * 32 + r32; Ost[ix] = o[d0][r] * rli[r] - Ost[ix]; }
  }
  __syncthreads();
  {
    const int row = 16 * wid + (lane >> 2), cb = (lane & 3) * 32;
    f32x4 v[8]; float ss = 0.f;
#pragma unroll
    for (int i = 0; i < 8; ++i) { v[i] = *(const f32x4*)&Ost[row * OST_LD + cb + 4 * i]; ss += (v[i][0] * v[i][0] + v[i][1] * v[i][1]) + (v[i][2] * v[i][2] + v[i][3] * v[i][3]); }
    ss += __shfl_xor(ss, 1); ss += __shfl_xor(ss, 2);
    const float scl = (1.0f - 0.2f) / sqrtf(ss * (1.0f / 128.0f) + 1e-6f);
    unsigned short* op = MX + (tok0 + qb * 128 + row) * 1024 + h * 128 + cb;
#pragma unroll
    for (int i = 0; i < 4; ++i) {
      const f32x4 g0 = *(const f32x4*)(gdn + cb + 8 * i), g1 = *(const f32x4*)(gdn + cb + 8 * i + 4);
      const f32x4 a = v[2 * i] * g0 * scl, c = v[2 * i + 1] * g1 * scl;
      u32x4 w = {cvtpk(a[0], a[1]), cvtpk(a[2], a[3]), cvtpk(c[0], c[1]), cvtpk(c[2], c[3])};
      *(u32x4*)(op + 8 * i) = w;
    }
  }
  __syncthreads();
#undef DMA_TILE
#undef TILE_SYNC
}
#undef KSWZ
#undef SBAR
}

#define LAS __attribute__((address_space(3)))
typedef unsigned short bf16;
typedef float f32x4 __attribute__((ext_vector_type(4)));
typedef float f32x16 __attribute__((ext_vector_type(16)));
typedef short bf16x8 __attribute__((ext_vector_type(8)));
typedef unsigned u32x4 __attribute__((ext_vector_type(4)));
typedef unsigned u32x2 __attribute__((ext_vector_type(2)));
__device__ __forceinline__ unsigned f2bf(float f) { unsigned u = __builtin_bit_cast(unsigned, f); return (u + 0x7fffu + ((u >> 16) & 1u)) >> 16; }
__device__ __forceinline__ unsigned pk2(float lo, float hi) { return f2bf(lo) | (f2bf(hi) << 16); }
__device__ __forceinline__ float bflo(unsigned w) { return __uint_as_float(w << 16); }
__device__ __forceinline__ float bfhi(unsigned w) { return __uint_as_float(w & 0xffff0000u); }
__device__ __forceinline__ float bf1(unsigned short h) { return __uint_as_float(((unsigned)h) << 16); }
__device__ __forceinline__ float sigm(float z) { return __builtin_amdgcn_rcpf(1.0f + __expf(-z)); }
__device__ __forceinline__ float gelu_tanh(float x) { return x * sigm(1.5957691216057308f * (x + 0.044715f * x * x * x)); }
__device__ __forceinline__ float wave_sum(float v) {
#pragma unroll
    for (int o = 1; o < 64; o <<= 1) v += __shfl_xor(v, o);
    return v;
}
__device__ __forceinline__ int crow16(int r, int hi) { return (r & 3) + 8 * (r >> 2) + 4 * hi; }

struct LruArgs { const bf16* LIN; const float* conv_w; const float* conv_b; const bf16* LWT; const float* ba; const float* bx; const float* lam; bf16* HL0; bf16* HL1; bf16* AC0; bf16* AC1; float* CA; float* CH; };
template <int LV> __device__ __forceinline__ void lru_phase_a(int wg, int G, const LruArgs& A, char* lds) {
    const int tid = fresh_tid(), wid = tid >> 6, lane = tid & 63, r32 = lane & 31, hi = lane >> 5;
    bf16* ucs = (bf16*)lds; float* als = (float*)(lds + 18432); float* bls = (float*)(lds + 51200);
    float* cA = (float*)(lds + 83968); float* cH = (float*)(lds + 86016); float* cw = (float*)(lds + 88064);
    const int n = wg & 7;
    if (tid < 256) cw[tid] = A.conv_w[(tid >> 6) * 512 + n * 64 + (tid & 63)];
    else if (tid < 320) cw[tid] = A.conv_b[n * 64 + (tid - 256)];
    const int rt = wid >> 1, ch = wid & 1;
    const int cg_ = ch * 32 + r32;
    const int tt = tid >> 2, c0 = (tid & 3) * 16;
    bf16* wl = (bf16*)(lds + 89600);
    for (int i = tid; i < 2 * 2 * 64 * 8; i += 512) { const int dir = i >> 10, rem = i & 1023;
        *(u32x4*)(wl + (size_t)i * 8) = *(const u32x4*)(A.LWT + ((size_t)(dir * 8 + n) * 2 * 64 * 64) + (size_t)rem * 8); }
    const float bav0 = A.ba[n * 64 + cg_], bxv0 = A.bx[n * 64 + cg_], bav1 = A.ba[512 + n * 64 + cg_], bxv1 = A.bx[512 + n * 64 + cg_];
    const float spv0 = -8.0f * log1pf(__expf(-A.lam[n * 64 + cg_])), spv1 = -8.0f * log1pf(__expf(-A.lam[512 + n * 64 + cg_]));
    u32x4 in0[4], in1[4];
#define LRU_LOAD(K) do { const int b_ = (K) >> 5, t0_ = ((K) & 31) * 128; _Pragma("unroll") for (int j = 0; j < 4; ++j) { const int s_ = t0_ + tt + j - 2; const bool ok_ = (s_ >= 0 && s_ < 4096); const int sc_ = ok_ ? s_ : 0; \
        const bf16* p_ = A.LIN + ((long)b_ * 4096 + sc_) * 512 + n * 64 + c0; in0[j] = *(const u32x4*)p_; in1[j] = *(const u32x4*)(p_ + 8); \
        if (!ok_) { in0[j] = (u32x4){0u, 0u, 0u, 0u}; in1[j] = (u32x4){0u, 0u, 0u, 0u}; } } } while (0)
    const int kstep = (G >> 3) > 0 ? (G >> 3) : 1;
    int k = wg >> 3;
    if (k < 256) LRU_LOAD(k);
    __syncthreads();
    for (; k < 256; k += kstep) {
        const long tokb = (long)k * 128;
        if (!(LV & 8)) {
            float accv[16];
#pragma unroll
            for (int i = 0; i < 16; ++i) accv[i] = cw[256 + c0 + i];
#pragma unroll
            for (int j = 0; j < 4; ++j) {
                const u32x4 w0 = in0[j], w1 = in1[j];
                const float* cwj = cw + j * 64 + c0;
                accv[0] += bflo(w0.x) * cwj[0]; accv[1] += bfhi(w0.x) * cwj[1]; accv[2] += bflo(w0.y) * cwj[2]; accv[3] += bfhi(w0.y) * cwj[3];
                accv[4] += bflo(w0.z) * cwj[4]; accv[5] += bfhi(w0.z) * cwj[5]; accv[6] += bflo(w0.w) * cwj[6]; accv[7] += bfhi(w0.w) * cwj[7];
                accv[8] += bflo(w1.x) * cwj[8]; accv[9] += bfhi(w1.x) * cwj[9]; accv[10] += bflo(w1.y) * cwj[10]; accv[11] += bfhi(w1.y) * cwj[11];
                accv[12] += bflo(w1.z) * cwj[12]; accv[13] += bfhi(w1.z) * cwj[13]; accv[14] += bflo(w1.w) * cwj[14]; accv[15] += bfhi(w1.w) * cwj[15];
            }
            u32x4 o0 = {pk2(accv[0], accv[1]), pk2(accv[2], accv[3]), pk2(accv[4], accv[5]), pk2(accv[6], accv[7])};
            u32x4 o1 = {pk2(accv[8], accv[9]), pk2(accv[10], accv[11]), pk2(accv[12], accv[13]), pk2(accv[14], accv[15])};
            *(u32x4*)(ucs + tt * 72 + c0) = o0; *(u32x4*)(ucs + tt * 72 + c0 + 8) = o1;
        }
        if (k + kstep < 256) LRU_LOAD(k + kstep);
        __syncthreads();
#pragma unroll 1
        for (int dir = 0; dir < 2; ++dir) {
            const bool fwd = (dir == 0);
            if (!(LV & 1)) {
                const float bav = dir ? bav1 : bav0, bxv = dir ? bxv1 : bxv0, spv = dir ? spv1 : spv0;
                const bf16* wa = wl + ((size_t)(dir * 2 + 0) * 64 + ch * 32 + r32) * 64 + hi * 8;
                const bf16* wx = wl + ((size_t)(dir * 2 + 1) * 64 + ch * 32 + r32) * 64 + hi * 8;
                f32x16 da = {}, dx = {};
#pragma unroll
                for (int ks = 0; ks < 4; ++ks) {
                    const bf16x8 af = *(const bf16x8*)(ucs + (rt * 32 + r32) * 72 + ks * 16 + hi * 8);
                    da = __builtin_amdgcn_mfma_f32_32x32x16_bf16(af, *(const bf16x8*)(wa + ks * 16), da, 0, 0, 0);
                    dx = __builtin_amdgcn_mfma_f32_32x32x16_bf16(af, *(const bf16x8*)(wx + ks * 16), dx, 0, 0, 0);
                }
#pragma unroll
                for (int r = 0; r < 16; ++r) {
                    const int tk = rt * 32 + crow16(r, hi);
                    const float rr = sigm(da[r] + bav), ii = sigm(dx[r] + bxv);
                    const float av = __expf(spv * rr), mult = __builtin_amdgcn_sqrtf(fmaxf(1.0f - av * av, 0.f));
                    als[tk * 64 + cg_] = av; bls[tk * 64 + cg_] = mult * (ii * bf1(ucs[tk * 72 + cg_]));
                }
            }
            __syncthreads();
            {
                const int c = tid & 63, j = tid >> 6;
                float hl[16], Ac[16]; float hv = 0.f, AA = 1.f;
#pragma unroll
                for (int i = 0; i < 16; ++i) { const int p = j * 16 + i, tk = fwd ? p : 127 - p; if (!(LV & 2)) { const float av = als[tk * 64 + c], bv = bls[tk * 64 + c]; hv = av * hv + bv; AA = AA * av; } hl[i] = hv; Ac[i] = AA; }
                cA[j * 64 + c] = AA; cH[j * 64 + c] = hv;
                __syncthreads();
                float s = 0.f, P = 1.f, sin_ = 0.f, pin_ = 1.f;
#pragma unroll
                for (int jj = 0; jj < 8; ++jj) { if (jj == j) { sin_ = s; pin_ = P; } const float a_ = cA[jj * 64 + c]; s = a_ * s + cH[jj * 64 + c]; P = P * a_; }
                bf16* hst = (bf16*)als; bf16* ast = (bf16*)bls;
#pragma unroll
                for (int i = 0; i < 16; ++i) { if (LV & 4) continue; const int p = j * 16 + i, tk = fwd ? p : 127 - p; hst[tk * 64 + c] = (bf16)f2bf(hl[i] + Ac[i] * sin_); ast[tk * 64 + c] = (bf16)f2bf(Ac[i] * pin_); }
                if (j == 0) { A.CA[((size_t)dir * 256 + k) * 512 + n * 64 + c] = P; A.CH[((size_t)dir * 256 + k) * 512 + n * 64 + c] = s; }
            }
            __syncthreads();
            {
                bf16* hlg = (dir ? A.HL1 : A.HL0) + tokb * 512 + n * 64; bf16* acg = (dir ? A.AC1 : A.AC0) + tokb * 512 + n * 64;
#pragma unroll
                for (int q = 0; q < 2; ++q) { if (LV & 4) continue; const int pc = tid + 512 * q, tk = pc >> 3, c8 = (pc & 7) * 8;
                    *(u32x4*)(hlg + (long)tk * 512 + c8) = *(const u32x4*)((const bf16*)als + tk * 64 + c8); *(u32x4*)(acg + (long)tk * 512 + c8) = *(const u32x4*)((const bf16*)bls + tk * 64 + c8); }
            }
            __syncthreads();
        }
    }
#undef LRU_LOAD
}
struct LruCArgs { const bf16* HL0; const bf16* HL1; const bf16* AC0; const bf16* AC1; const float* CA; const float* CH; const bf16* GATE; const float* g; bf16* MX; };
__device__ __forceinline__ void lru_phase_c(int k, const LruCArgs& A, char* lds) {
    const int tid = fresh_tid(), wid = tid >> 6, lane = tid & 63, cq = tid & 127, tg = tid >> 7;
    bf16* ys = (bf16*)lds; float* ssp = (float*)(lds + 131072);
    const int b = k >> 5, kt = k & 31;
    f32x4 sf = {0.f, 0.f, 0.f, 0.f}, sb = sf;
    for (int i = 0; i < kt; ++i) { const size_t o = ((size_t)0 * 256 + b * 32 + i) * 512 + cq * 4; const f32x4 a = *(const f32x4*)(A.CA + o), h = *(const f32x4*)(A.CH + o); sf = a * sf + h; }
    for (int i = 31; i > kt; --i) { const size_t o = ((size_t)1 * 256 + b * 32 + i) * 512 + cq * 4; const f32x4 a = *(const f32x4*)(A.CA + o), h = *(const f32x4*)(A.CH + o); sb = a * sb + h; }
    const long tokb = (long)k * 128;
#pragma unroll 8
    for (int it = 0; it < 32; ++it) {
        const int tk = it * 4 + tg; const size_t o = (size_t)(tokb + tk) * 512 + cq * 4;
        const u32x2 hf = *(const u32x2*)(A.HL0 + o), af = *(const u32x2*)(A.AC0 + o), hb = *(const u32x2*)(A.HL1 + o), ab = *(const u32x2*)(A.AC1 + o), gt = *(const u32x2*)(A.GATE + o);
        float y[4];
        y[0] = ((bflo(hf.x) + bflo(af.x) * sf[0]) + (bflo(hb.x) + bflo(ab.x) * sb[0])) * gelu_tanh(bflo(gt.x));
        y[1] = ((bfhi(hf.x) + bfhi(af.x) * sf[1]) + (bfhi(hb.x) + bfhi(ab.x) * sb[1])) * gelu_tanh(bfhi(gt.x));
        y[2] = ((bflo(hf.y) + bflo(af.y) * sf[2]) + (bflo(hb.y) + bflo(ab.y) * sb[2])) * gelu_tanh(bflo(gt.y));
        y[3] = ((bfhi(hf.y) + bfhi(af.y) * sf[3]) + (bfhi(hb.y) + bfhi(ab.y) * sb[3])) * gelu_tanh(bfhi(gt.y));
        float ss = (y[0] * y[0] + y[1] * y[1]) + (y[2] * y[2] + y[3] * y[3]);
#pragma unroll
        for (int o2 = 1; o2 < 64; o2 <<= 1) ss += __shfl_xor(ss, o2);
        u32x2 w = {pk2(y[0], y[1]), pk2(y[2], y[3])};
        *(u32x2*)(ys + tk * 512 + cq * 4) = w;
        if (lane == 0) ssp[tk * 2 + (wid & 1)] = ss;
    }
    __syncthreads();
    const f32x4 gv = *(const f32x4*)(A.g + cq * 4);
#pragma unroll 2
    for (int it = 0; it < 32; ++it) {
        const int tk = it * 4 + tg;
        const float rstd = 1.0f / sqrtf((ssp[tk * 2] + ssp[tk * 2 + 1]) * (1.0f / 512.0f) + 1e-6f);
        const u32x2 w = *(const u32x2*)(ys + tk * 512 + cq * 4);
        u32x2 o = {pk2(bflo(w.x) * rstd * gv[0], bfhi(w.x) * rstd * gv[1]), pk2(bflo(w.y) * rstd * gv[2], bfhi(w.y) * rstd * gv[3])};
        *(u32x2*)(A.MX + (size_t)(tokb + tk) * 1024 + 512 + cq * 4) = o;
    }
    __syncthreads();
}

__device__ __forceinline__ unsigned mono_key(float f) { const unsigned b = __float_as_uint(f); return b ^ ((unsigned)((int)b >> 31) | 0x80000000u); }
#define TK_INS(L, xin) do { unsigned x_ = (xin); _Pragma("unroll") for (int q_ = 0; q_ < 16; ++q_) { const unsigned t_ = max(L[q_], x_); x_ = min(L[q_], x_); L[q_] = t_; } } while (0)
#define TK_CE(x, y) do { const unsigned h_ = max(x, y), l_ = min(x, y); x = h_; y = l_; } while (0)
__device__ __forceinline__ void tk_sort16(unsigned (&a)[16]) {
    TK_CE(a[0], a[1]); TK_CE(a[2], a[3]); TK_CE(a[0], a[2]); TK_CE(a[1], a[3]); TK_CE(a[1], a[2]); TK_CE(a[4], a[5]); TK_CE(a[6], a[7]); TK_CE(a[4], a[6]);
    TK_CE(a[5], a[7]); TK_CE(a[5], a[6]); TK_CE(a[0], a[4]); TK_CE(a[2], a[6]); TK_CE(a[2], a[4]); TK_CE(a[1], a[5]); TK_CE(a[3], a[7]); TK_CE(a[3], a[5]);
    TK_CE(a[1], a[2]); TK_CE(a[3], a[4]); TK_CE(a[5], a[6]); TK_CE(a[8], a[9]); TK_CE(a[10], a[11]); TK_CE(a[8], a[10]); TK_CE(a[9], a[11]); TK_CE(a[9], a[10]);
    TK_CE(a[12], a[13]); TK_CE(a[14], a[15]); TK_CE(a[12], a[14]); TK_CE(a[13], a[15]); TK_CE(a[13], a[14]); TK_CE(a[8], a[12]); TK_CE(a[10], a[14]); TK_CE(a[10], a[12]);
    TK_CE(a[9], a[13]); TK_CE(a[11], a[15]); TK_CE(a[11], a[13]); TK_CE(a[9], a[10]); TK_CE(a[11], a[12]); TK_CE(a[13], a[14]); TK_CE(a[0], a[8]); TK_CE(a[4], a[12]);
    TK_CE(a[4], a[8]); TK_CE(a[2], a[10]); TK_CE(a[6], a[14]); TK_CE(a[6], a[10]); TK_CE(a[2], a[4]); TK_CE(a[6], a[8]); TK_CE(a[10], a[12]); TK_CE(a[1], a[9]);
    TK_CE(a[5], a[13]); TK_CE(a[5], a[9]); TK_CE(a[3], a[11]); TK_CE(a[7], a[15]); TK_CE(a[7], a[11]); TK_CE(a[3], a[5]); TK_CE(a[7], a[9]); TK_CE(a[11], a[13]);
    TK_CE(a[1], a[2]); TK_CE(a[3], a[4]); TK_CE(a[5], a[6]); TK_CE(a[7], a[8]); TK_CE(a[9], a[10]); TK_CE(a[11], a[12]); TK_CE(a[13], a[14]);
}
__device__ __forceinline__ void tk_merge16(unsigned (&L)[16], const unsigned (&B)[16]) {
#pragma unroll
    for (int i = 0; i < 16; ++i) L[i] = max(L[i], B[15 - i]);
#pragma unroll
    for (int d = 8; d >= 1; d >>= 1)
#pragma unroll
        for (int i = 0; i < 16; ++i) if ((i & d) == 0) TK_CE(L[i], L[i + d]);
}
struct TopkArgs { const bf16* QP; const bf16* KEYS; unsigned short* IDX; float* GW; };
__device__ __forceinline__ void topk_unit(int tile, const TopkArgs& A, const bf16x8 (&kf)[4][4], char* lds) {
    const int tid = fresh_tid(), wid = tid >> 6, lane = tid & 63, r32 = lane & 31, hi = lane >> 5;
    float* sc = (float*)lds; unsigned* sci = (unsigned*)lds;
    const int t0 = tile * 64;
    for (int hp = 0; hp < 4; ++hp) {
        {
            const int combo = wid >> 1, head = 2 * hp + (wid >> 2), half = (wid >> 1) & 1, rtile = wid & 1;
            const bf16* qrow = A.QP + (size_t)(t0 + rtile * 32 + r32) * 1024 + head * 128 + half * 64 + hi * 8;
            bf16x8 af[4];
#pragma unroll
            for (int ks = 0; ks < 4; ++ks) af[ks] = *(const bf16x8*)(qrow + ks * 16);
#pragma unroll
            for (int ct = 0; ct < 4; ++ct) {
                f32x16 d = {};
#pragma unroll
                for (int ks = 0; ks < 4; ++ks) d = __builtin_amdgcn_mfma_f32_32x32x16_bf16(af[ks], kf[ct][ks], d, 0, 0, 0);
#pragma unroll
                for (int r = 0; r < 16; ++r) sc[(combo * 64 + rtile * 32 + crow16(r, hi)) * 132 + ct * 32 + r32] = d[r];
            }
        }
        __syncthreads();
        {
            const int row = tid >> 1, part = tid & 1;
            const float* rowp = sc + row * 132 + part * 64;
            unsigned L[16];
#pragma unroll
            for (int gq = 0; gq < 4; ++gq) {
                unsigned G[16];
#pragma unroll
                for (int i = 0; i < 4; ++i) {
                    const f32x4 v = *(const f32x4*)(rowp + 16 * gq + 4 * i);
#pragma unroll
                    for (int j = 0; j < 4; ++j) G[4 * i + j] = (mono_key(v[j]) & ~127u) | (127u - (unsigned)(part * 64 + 16 * gq + 4 * i + j));
                }
                tk_sort16(G);
                if (gq == 0) {
#pragma unroll
                    for (int q = 0; q < 16; ++q) L[q] = G[q];
                } else tk_merge16(L, G);
            }
            {
                unsigned P[16];
#pragma unroll
                for (int q = 0; q < 16; ++q) P[q] = __shfl_xor(L[q], 1);
                tk_merge16(L, P);
            }
            float vals[16]; unsigned ids[16];
#pragma unroll
            for (int q = 0; q < 16; ++q) { ids[q] = 127u - (L[q] & 127u); vals[q] = sc[row * 132 + ids[q]]; }
            asm volatile("s_waitcnt lgkmcnt(0)" ::: "memory");
            if (part == 0) {
#pragma unroll
                for (int q = 0; q < 16; ++q) { sc[row * 132 + q] = vals[q]; sci[row * 132 + 16 + q] = ids[q]; }
            }
        }
        __syncthreads();
        if (tid < 128) {
            const int tok = tid & 63, hh = tid >> 6;
            const int row1 = (hh * 2 + 0) * 64 + tok, row2 = (hh * 2 + 1) * 64 + tok;
            float v1[16], v2[16];
#pragma unroll
            for (int q = 0; q < 16; ++q) { v1[q] = sc[row1 * 132 + q]; v2[q] = sc[row2 * 132 + q]; }
            unsigned L[16];
#define TK_KEY2(i, j) ((mono_key(v1[i] + v2[j]) & ~255u) | (255u - (unsigned)((i) * 16 + (j))))
#pragma unroll
            for (int j = 0; j < 16; ++j) L[j] = TK_KEY2(0, j);
            tk_sort16(L);
            {
                unsigned G[16] = {TK_KEY2(1, 0), TK_KEY2(1, 1), TK_KEY2(1, 2), TK_KEY2(1, 3), TK_KEY2(1, 4), TK_KEY2(1, 5), TK_KEY2(1, 6), TK_KEY2(1, 7),
                                  TK_KEY2(2, 0), TK_KEY2(2, 1), TK_KEY2(2, 2), TK_KEY2(2, 3), TK_KEY2(2, 4), TK_KEY2(3, 0), TK_KEY2(3, 1), TK_KEY2(3, 2)};
                tk_sort16(G); tk_merge16(L, G);
            }
            {
                unsigned G[16] = {TK_KEY2(3, 3), TK_KEY2(4, 0), TK_KEY2(4, 1), TK_KEY2(4, 2), TK_KEY2(5, 0), TK_KEY2(5, 1), TK_KEY2(6, 0), TK_KEY2(6, 1),
                                  TK_KEY2(7, 0), TK_KEY2(7, 1), TK_KEY2(8, 0), TK_KEY2(9, 0), TK_KEY2(10, 0), TK_KEY2(11, 0), TK_KEY2(12, 0), TK_KEY2(13, 0)};
                tk_sort16(G); tk_merge16(L, G);
            }
            { unsigned k14 = TK_KEY2(14, 0), k15 = TK_KEY2(15, 0); TK_INS(L, k14); TK_INS(L, k15); }
#undef TK_KEY2
            float sv[16]; unsigned ev[16]; float mx = -3.0e38f;
#pragma unroll
            for (int q = 0; q < 16; ++q) {
                const unsigned pos = 255u - (L[q] & 255u), i = pos >> 4, j = pos & 15u;
                sv[q] = sc[row1 * 132 + i] + sc[row2 * 132 + j];
                ev[q] = sci[row1 * 132 + 16 + i] * 128u + sci[row2 * 132 + 16 + j];
                mx = fmaxf(mx, sv[q]);
            }
            float sum = 0.f;
#pragma unroll
            for (int q = 0; q < 16; ++q) { sv[q] = __expf(sv[q] - mx); sum += sv[q]; }
            const float inv = 1.0f / sum;
            const size_t ob = (size_t)(t0 + tok) * 128 + (2 * hp + hh) * 16;
#pragma unroll
            for (int q = 0; q < 16; ++q) { A.IDX[ob + q] = (unsigned short)ev[q]; A.GW[ob + q] = sv[q] * inv; }
        }
        __syncthreads();
    }
}

typedef float f32x2 __attribute__((ext_vector_type(2)));
constexpr float U8_SCALE = 768.0f, V8_SCALE = 16.0f;
struct PeerArgs { const unsigned short* IDX; const bf16* HB; const unsigned char* UT; const unsigned char* VT; bf16* PLOG; const unsigned* ACT; bf16* H2B; float* SS2; };
#define PEER_EID(i0, i1, g) ((((g) & 1) ? (((g) >> 1) < 4 ? (i0)[((g) >> 1) & 3] : (i1)[((g) >> 1) & 3]) >> 16 : (((g) >> 1) < 4 ? (i0)[((g) >> 1) & 3] : (i1)[((g) >> 1) & 3]) & 0xffffu))
#define PEER_U4(A0, A1, A2, A3, XA, XB, XC, XD, W0a, W0b, W1a, W1b, W2a, W2b, W3a, W3b) do { f32x2 t0_, t1_, t2_, t3_; asm volatile( \
    "v_cvt_pk_f32_fp8_e32 %4, %12\n\tv_cvt_pk_f32_fp8_e32 %5, %14\n\tv_cvt_pk_f32_fp8_e32 %6, %16\n\tv_cvt_pk_f32_fp8_e32 %7, %18\n\t" \
    "v_pk_fma_f32 %0, %4, %8, %0\n\tv_pk_fma_f32 %1, %5, %8, %1\n\tv_pk_fma_f32 %2, %6, %8, %2\n\tv_pk_fma_f32 %3, %7, %8, %3\n\t" \
    "v_cvt_pk_f32_fp8_sdwa %4, %12 src0_sel:WORD_1\n\tv_cvt_pk_f32_fp8_sdwa %5, %14 src0_sel:WORD_1\n\tv_cvt_pk_f32_fp8_sdwa %6, %16 src0_sel:WORD_1\n\tv_cvt_pk_f32_fp8_sdwa %7, %18 src0_sel:WORD_1\n\t" \
    "v_pk_fma_f32 %0, %4, %9, %0\n\tv_pk_fma_f32 %1, %5, %9, %1\n\tv_pk_fma_f32 %2, %6, %9, %2\n\tv_pk_fma_f32 %3, %7, %9, %3\n\t" \
    "v_cvt_pk_f32_fp8_e32 %4, %13\n\tv_cvt_pk_f32_fp8_e32 %5, %15\n\tv_cvt_pk_f32_fp8_e32 %6, %17\n\tv_cvt_pk_f32_fp8_e32 %7, %19\n\t" \
    "v_pk_fma_f32 %0, %4, %10, %0\n\tv_pk_fma_f32 %1, %5, %10, %1\n\tv_pk_fma_f32 %2, %6, %10, %2\n\tv_pk_fma_f32 %3, %7, %10, %3\n\t" \
    "v_cvt_pk_f32_fp8_sdwa %4, %13 src0_sel:WORD_1\n\tv_cvt_pk_f32_fp8_sdwa %5, %15 src0_sel:WORD_1\n\tv_cvt_pk_f32_fp8_sdwa %6, %17 src0_sel:WORD_1\n\tv_cvt_pk_f32_fp8_sdwa %7, %19 src0_sel:WORD_1\n\t" \
    "v_pk_fma_f32 %0, %4, %11, %0\n\tv_pk_fma_f32 %1, %5, %11, %1\n\tv_pk_fma_f32 %2, %6, %11, %2\n\tv_pk_fma_f32 %3, %7, %11, %3" \
    : "+v"(A0), "+v"(A1), "+v"(A2), "+v"(A3), "=&v"(t0_), "=&v"(t1_), "=&v"(t2_), "=&v"(t3_) \
    : "v"(XA), "v"(XB), "v"(XC), "v"(XD), "v"(W0a), "v"(W0b), "v"(W1a), "v"(W1b), "v"(W2a), "v"(W2b), "v"(W3a), "v"(W3b)); } while (0)
#define PEER_V4(C0, C1, C2, C3, AV2, Wa, Wb) do { f32x2 t0_, t1_, t2_, t3_; asm volatile( \
    "v_cvt_pk_f32_fp8_e32 %4, %9\n\tv_cvt_pk_f32_fp8_sdwa %5, %9 src0_sel:WORD_1\n\tv_cvt_pk_f32_fp8_e32 %6, %10\n\tv_cvt_pk_f32_fp8_sdwa %7, %10 src0_sel:WORD_1\n\t" \
    "v_pk_fma_f32 %0, %4, %8, %0\n\tv_pk_fma_f32 %1, %5, %8, %1\n\tv_pk_fma_f32 %2, %6, %8, %2\n\tv_pk_fma_f32 %3, %7, %8, %3" \
    : "+v"(C0), "+v"(C1), "+v"(C2), "+v"(C3), "=&v"(t0_), "=&v"(t1_), "=&v"(t2_), "=&v"(t3_) : "v"(AV2), "v"(Wa), "v"(Wb)); } while (0)
struct XPairs { f32x2 x0, x1, x2, x3, x4, x5, x6, x7; };
__device__ __forceinline__ XPairs peer_xpairs(const u32x4 xa, const u32x4 xb) {
    XPairs X; X.x0 = (f32x2){bflo(xa.x), bfhi(xa.x)}; X.x1 = (f32x2){bflo(xa.y), bfhi(xa.y)}; X.x2 = (f32x2){bflo(xa.z), bfhi(xa.z)}; X.x3 = (f32x2){bflo(xa.w), bfhi(xa.w)};
    X.x4 = (f32x2){bflo(xb.x), bfhi(xb.x)}; X.x5 = (f32x2){bflo(xb.y), bfhi(xb.y)}; X.x6 = (f32x2){bflo(xb.z), bfhi(xb.z)}; X.x7 = (f32x2){bflo(xb.w), bfhi(xb.w)}; return X;
}
__device__ __forceinline__ void peer_dots16(float (&p)[16], const XPairs& X, const u32x4 (&u)[16]) {
#pragma unroll
    for (int q = 0; q < 4; ++q) {
        f32x2 a0 = {0.f, 0.f}, a1 = a0, a2 = a0, a3 = a0;
        unsigned w0x = u[4 * q].x, w0y = u[4 * q].y, w0z = u[4 * q].z, w0w = u[4 * q].w, w1x = u[4 * q + 1].x, w1y = u[4 * q + 1].y, w1z = u[4 * q + 1].z, w1w = u[4 * q + 1].w;
        unsigned w2x = u[4 * q + 2].x, w2y = u[4 * q + 2].y, w2z = u[4 * q + 2].z, w2w = u[4 * q + 2].w, w3x = u[4 * q + 3].x, w3y = u[4 * q + 3].y, w3z = u[4 * q + 3].z, w3w = u[4 * q + 3].w;
        PEER_U4(a0, a1, a2, a3, X.x0, X.x1, X.x2, X.x3, w0x, w0y, w1x, w1y, w2x, w2y, w3x, w3y);
        PEER_U4(a0, a1, a2, a3, X.x4, X.x5, X.x6, X.x7, w0z, w0w, w1z, w1w, w2z, w2w, w3z, w3w);
        p[4 * q] = a0.x + a0.y; p[4 * q + 1] = a1.x + a1.y; p[4 * q + 2] = a2.x + a2.y; p[4 * q + 3] = a3.x + a3.y;
    }
}
__device__ __forceinline__ void peer_u_reduce_store(int (&p)[16], int c, bf16* po, float scale) {
#pragma unroll
    for (int i = 0; i < 8; ++i) { const bool up = (c & 4) != 0; const int give = up ? p[i] : p[i + 8]; const int keep = up ? p[i + 8] : p[i]; p[i] = keep + __shfl_xor(give, 4); }
#pragma unroll
    for (int i = 0; i < 4; ++i) { const bool up = (c & 2) != 0; const int give = up ? p[i] : p[i + 4]; const int keep = up ? p[i + 4] : p[i]; p[i] = keep + __shfl_xor(give, 2); }
#pragma unroll
    for (int i = 0; i < 2; ++i) { const bool up = (c & 1) != 0; const int give = up ? p[i] : p[i + 2]; const int keep = up ? p[i + 2] : p[i]; p[i] = keep + __shfl_xor(give, 1); }
    *(unsigned*)po = pk2((float)p[0] * scale, (float)p[1] * scale);
}
template <unsigned IDMASK, int MODE> __device__ __forceinline__ void peer_u_item(int tile, int s, const PeerArgs& A, char* lds) {
    const int tid = fresh_tid(), wid = tid >> 6, lane = tid & 63, j8 = lane >> 3, c = lane & 7;
    const unsigned char* ut = A.UT + (size_t)s * (16384 * 128) + c * 16;
    for (int grp = 0; grp < 2; ++grp) {
        const int t = tile * 128 + wid * 16 + grp * 8 + j8;
        const unsigned short* ip = A.IDX + (size_t)t * 128;
        const bf16* xp = A.HB + (size_t)t * 1024 + s * 128 + c * 16;
        bf16* pl = A.PLOG + ((size_t)s * T + t) * 128 + 2 * c;
        const u32x4 xa = *(const u32x4*)xp, xb = *(const u32x4*)(xp + 8);
        u32x4 i0 = *(const u32x4*)ip, i1 = *(const u32x4*)(ip + 8);
        float xf[16] = {bflo(xa.x), bfhi(xa.x), bflo(xa.y), bfhi(xa.y), bflo(xa.z), bfhi(xa.z), bflo(xa.w), bfhi(xa.w), bflo(xb.x), bfhi(xb.x), bflo(xb.y), bfhi(xb.y), bflo(xb.z), bfhi(xb.z), bflo(xb.w), bfhi(xb.w)};
        float am = 0.f;
#pragma unroll
        for (int i = 0; i < 16; ++i) am = fmaxf(am, fabsf(xf[i]));
        am = fmaxf(am, __shfl_xor(am, 1)); am = fmaxf(am, __shfl_xor(am, 2)); am = fmaxf(am, __shfl_xor(am, 4));
        am = fmaxf(am, 1e-20f);
        const float qs = 127.0f / am, scale = am * (1.0f / (127.0f * U8_SCALE));
        int xq[4];
#pragma unroll
        for (int q = 0; q < 4; ++q) { const int b0 = (int)rintf(xf[4 * q] * qs), b1 = (int)rintf(xf[4 * q + 1] * qs), b2 = (int)rintf(xf[4 * q + 2] * qs), b3 = (int)rintf(xf[4 * q + 3] * qs);
            xq[q] = (b0 & 0xff) | ((b1 & 0xff) << 8) | ((b2 & 0xff) << 16) | (b3 << 24); }
#pragma unroll 1
        for (int hd = 0; hd < 8; ++hd) {
            u32x4 n0 = i0, n1 = i1;
            if (hd < 7) { n0 = *(const u32x4*)(ip + (hd + 1) * 16); n1 = *(const u32x4*)(ip + (hd + 1) * 16 + 8); }
            u32x4 uw[16];
#pragma unroll
            for (int g = 0; g < 16; ++g) uw[g] = *(const u32x4*)(ut + (size_t)(PEER_EID(i0, i1, g) & IDMASK) * 128);
            asm volatile("" ::: "memory"); __builtin_amdgcn_sched_barrier(0);
            int p[16];
#pragma unroll
            for (int g = 0; g < 16; ++g) {
                int a = __builtin_amdgcn_sdot4(xq[0], (int)uw[g].x, 0, false);
                a = __builtin_amdgcn_sdot4(xq[1], (int)uw[g].y, a, false);
                a = __builtin_amdgcn_sdot4(xq[2], (int)uw[g].z, a, false);
                p[g] = __builtin_amdgcn_sdot4(xq[3], (int)uw[g].w, a, false);
            }
            peer_u_reduce_store(p, c, pl + hd * 16, scale);
            i0 = n0; i1 = n1;
        }
    }
}
template <bool HMEM, unsigned IDMASK, int VMODE> __device__ __forceinline__ void peer_v_item(int tile, int s, const PeerArgs& A, char* lds, float vscale) {
    const int tid = fresh_tid(), wid = tid >> 6, lane = tid & 63, j8 = lane >> 3, c = lane & 7;
    const unsigned char* vt = A.VT + (size_t)s * (16384 * 128) + c * 16;
    const float vs = vscale * (1.0f / V8_SCALE);
    for (int grp = 0; grp < 2; ++grp) {
        const int t = tile * 128 + wid * 16 + grp * 8 + j8;
        const unsigned* ap = A.ACT + (size_t)t * 128;
        bf16* hbp = A.H2B + (size_t)t * 1024 + s * 128 + c * 16;
        const u32x4 hw0 = *(const u32x4*)hbp, hw1 = *(const u32x4*)(hbp + 8);
        f32x2 acc[8];
#pragma unroll
        for (int j = 0; j < 8; ++j) acc[j] = (f32x2){0.f, 0.f};
        u32x4 a0 = *(const u32x4*)ap, a1 = *(const u32x4*)(ap + 4), a2 = *(const u32x4*)(ap + 8), a3 = *(const u32x4*)(ap + 12);
#pragma unroll 1
        for (int hd = 0; hd < 8; ++hd) {
            u32x4 n0 = a0, n1 = a1, n2 = a2, n3 = a3;
            if (hd < 7) { n0 = *(const u32x4*)(ap + (hd + 1) * 16); n1 = *(const u32x4*)(ap + (hd + 1) * 16 + 4); n2 = *(const u32x4*)(ap + (hd + 1) * 16 + 8); n3 = *(const u32x4*)(ap + (hd + 1) * 16 + 12); }
            u32x4 vw[16];
#pragma unroll
            for (int g = 0; g < 16; ++g) { const unsigned w_ = (g < 4) ? a0[g & 3] : (g < 8) ? a1[g & 3] : (g < 12) ? a2[g & 3] : a3[g & 3]; vw[g] = *(const u32x4*)(vt + (size_t)((w_ & 0xffffu) & IDMASK) * 128); }
            asm volatile("" ::: "memory"); __builtin_amdgcn_sched_barrier(0);
#pragma unroll
            for (int g = 0; g < 16; ++g) {
                const unsigned w_ = (g < 4) ? a0[g & 3] : (g < 8) ? a1[g & 3] : (g < 12) ? a2[g & 3] : a3[g & 3];
                const float av = __uint_as_float(w_ & 0xffff0000u);
                const f32x2 av2 = {av, av};
                unsigned wx = vw[g].x, wy = vw[g].y, wz = vw[g].z, ww = vw[g].w;
                PEER_V4(acc[0], acc[1], acc[2], acc[3], av2, wx, wy);
                PEER_V4(acc[4], acc[5], acc[6], acc[7], av2, wz, ww);
            }
            a0 = n0; a1 = n1; a2 = n2; a3 = n3;
        }
        f32x4 h[4];
        h[0] = (f32x4){bflo(hw0.x), bfhi(hw0.x), bflo(hw0.y), bfhi(hw0.y)}; h[1] = (f32x4){bflo(hw0.z), bfhi(hw0.z), bflo(hw0.w), bfhi(hw0.w)};
        h[2] = (f32x4){bflo(hw1.x), bfhi(hw1.x), bflo(hw1.y), bfhi(hw1.y)}; h[3] = (f32x4){bflo(hw1.z), bfhi(hw1.z), bflo(hw1.w), bfhi(hw1.w)};
        float ssq = 0.f;
#pragma unroll
        for (int q = 0; q < 4; ++q) { h[q][0] += vs * acc[2 * q].x; h[q][1] += vs * acc[2 * q].y; h[q][2] += vs * acc[2 * q + 1].x; h[q][3] += vs * acc[2 * q + 1].y;
            ssq += (h[q][0] * h[q][0] + h[q][1] * h[q][1]) + (h[q][2] * h[q][2] + h[q][3] * h[q][3]); }
        const u32x4 w0 = {pk2(h[0][0], h[0][1]), pk2(h[0][2], h[0][3]), pk2(h[1][0], h[1][1]), pk2(h[1][2], h[1][3])}, w1 = {pk2(h[2][0], h[2][1]), pk2(h[2][2], h[2][3]), pk2(h[3][0], h[3][1]), pk2(h[3][2], h[3][3])};
        *(u32x4*)hbp = w0; *(u32x4*)(hbp + 8) = w1;
        ssq += __shfl_xor(ssq, 1); ssq += __shfl_xor(ssq, 2); ssq += __shfl_xor(ssq, 4);
        if (c == 0) A.SS2[(size_t)t * 8 + s] = ssq;
    }
}

#define XB_TMO      128
#define XB_XCNT(j)  (256  + 64 * (j))
#define XB_XSUB(j)  (1280 + 64 * (j))
#define XB_XGEN(j)  (2304 + 64 * (j))
#define XB_TOP      3328
#define XB_TOPGEN   3392
#define XCD_BAR_WORDS 3456
#define XB_SPIN_CAP (1u << 18)

__device__ __forceinline__ unsigned xb_ld(unsigned* p)              { return __hip_atomic_load(p, __ATOMIC_RELAXED, __HIP_MEMORY_SCOPE_AGENT); }
__device__ __forceinline__ unsigned xb_add(unsigned* p, unsigned v) { return __hip_atomic_fetch_add(p, v, __ATOMIC_RELAXED, __HIP_MEMORY_SCOPE_AGENT); }
__device__ __forceinline__ unsigned xb_xcc_id() { return (unsigned)__builtin_amdgcn_s_getreg((3 << 11) | 20) & 0xFu; }
#define XB_SPIN(cond, bar) do { unsigned _sp = 0; while (cond) { __builtin_amdgcn_s_sleep(1); \
    if ((++_sp & 255u) == 0u) { if (xb_ld(&(bar)[XB_TMO])) break; if (_sp > XB_SPIN_CAP) { atomicAdd(&(bar)[XB_TMO], 1u); break; } } } } while (0)

struct XcdBarrier {
    unsigned* bar; unsigned x;
    volatile LAS unsigned* st;
};

__device__ __forceinline__ XcdBarrier xcd_barrier_post(unsigned* bar, volatile LAS unsigned* st) {
    XcdBarrier b; b.bar = bar; b.x = xb_xcc_id(); b.st = st;
    if (threadIdx.x == 0) (void)xb_add(&bar[XB_XCNT(b.x)], 1u);
    return b;
}
__device__ __forceinline__ void xcd_barrier_complete(unsigned* bar, unsigned x, unsigned& nloc, unsigned& nx) {
    const unsigned G = gridDim.x * gridDim.y * gridDim.z;
    unsigned sum, cnt, mine, sp = 0u;
    for (;;) {
        sum = 0u; cnt = 0u; mine = 0u;
#pragma unroll
        for (unsigned j = 0; j < 16; ++j) { const unsigned c = xb_ld(&bar[XB_XCNT(j)]); sum += c; cnt += (c > 0u) ? 1u : 0u; mine = (j == x) ? c : mine; }
        if (sum == G) break;
        __builtin_amdgcn_s_sleep(1);
        if ((++sp & 255u) == 0u) { if (xb_ld(&bar[XB_TMO])) break; if (sp > XB_SPIN_CAP) { atomicAdd(&bar[XB_TMO], 1u); break; } }
    }
    nloc = mine > 0u ? mine : 1u; nx = cnt > 0u ? cnt : 1u;
}

__device__ __forceinline__ void xcd_barrier(const XcdBarrier& b) {
    asm volatile("s_waitcnt vmcnt(0)" ::: "memory");
    __syncthreads();
    if (threadIdx.x == 0) {
        unsigned* bar = b.bar;
        __builtin_amdgcn_s_waitcnt(0);
        unsigned nloc = b.st[0], nx = b.st[1];
        if (nloc == 0u) { xcd_barrier_complete(bar, b.x, nloc, nx); b.st[0] = nloc; b.st[1] = nx; }
        const unsigned old = xb_add(&bar[XB_XSUB(b.x)], 1u);
        const unsigned gen = old / nloc;
        if (old + 1u == (gen + 1u) * nloc) {
            __builtin_amdgcn_fence(__ATOMIC_RELEASE, "agent");
            asm volatile("s_waitcnt vmcnt(0)" ::: "memory");
            const unsigned og = xb_add(&bar[XB_TOP], 1u);
            const unsigned tg = og / nx;
            if (og + 1u == (tg + 1u) * nx) xb_add(&bar[XB_TOPGEN], 1u);
            else XB_SPIN(xb_ld(&bar[XB_TOPGEN]) == tg, bar);
            __builtin_amdgcn_fence(__ATOMIC_ACQUIRE, "agent");
            xb_add(&bar[XB_XGEN(b.x)], 1u);
            asm volatile("s_waitcnt vmcnt(0)" ::: "memory");
        } else {
            XB_SPIN(xb_ld(&bar[XB_XGEN(b.x)]) == gen, bar);
            __builtin_amdgcn_fence(__ATOMIC_ACQUIRE, "agent");
            asm volatile("s_waitcnt vmcnt(0)" ::: "memory");
        }
    }
    __syncthreads();
}
#ifndef ATTVAR
#define ATTVAR 0
#endif
constexpr size_t MiB = (size_t)1 << 20;
constexpr size_t WS_CTL = 0, CTL_ZERO_BYTES = 1 * MiB;
constexpr size_t WS_WIN = 1 * MiB, WS_WOUT = 6 * MiB, WS_WQ = 8 * MiB, WS_WG = 10 * MiB, WS_WP = 12 * MiB;
constexpr size_t WS_KEYS = 12 * MiB + 512 * 1024, WS_LWT = 12 * MiB + 768 * 1024, WS_ROPE = 13 * MiB, WS_MISC = 15 * MiB;
constexpr size_t WS_SS1 = 16 * MiB, WS_SS2 = 18 * MiB, WS_SS3 = 20 * MiB;
constexpr size_t WS_IDX = 24 * MiB, WS_GW = 32 * MiB, WS_PB = 48 * MiB;
constexpr size_t WS_UT = 64 * MiB, WS_VT = 96 * MiB;
constexpr size_t WS_XN = 128 * MiB;
constexpr size_t WS_Q = 192 * MiB, WS_K = 224 * MiB, WS_V = 256 * MiB, WS_LIN = 288 * MiB, WS_LGATE = 320 * MiB;
constexpr size_t WS_QP = 192 * MiB;
constexpr size_t WS_MIXED = 352 * MiB, WS_HF = 416 * MiB, WS_HB = 448 * MiB;
constexpr size_t WS_PLOG = 352 * MiB;
constexpr size_t WS_ACT = 256 * MiB;
constexpr size_t WS_END = 480 * MiB;
constexpr int LDS_BYTES = 147456;

struct Args {
    const float* in[29]; float* out; unsigned char* ws; int ph_lo, ph_hi, coop, pad;
};
struct Frame { char* lds; int G, bid; const Args* a; unsigned char* ws; };


__device__ __forceinline__ void p0_transpose_item(const float* W, int K, int N, bf16* WT, const float* gk, float* scr, int item, int lane) {
    const int nblk = N / 32, kb = item / nblk, nb = item % nblk, k0 = 64 * kb, n0 = 32 * nb;
#pragma unroll 8
    for (int i = 0; i < 32; ++i) { const int kk = 2 * i + (lane >> 5); float w = W[(size_t)(k0 + kk) * N + n0 + (lane & 31)]; if (gk) w *= gk[k0 + kk]; scr[kk * 33 + (lane & 31)] = w; }
    asm volatile("s_waitcnt lgkmcnt(0)" ::: "memory");
    const int c = lane & 7;
#pragma unroll
    for (int j = 0; j < 4; ++j) { const int n = (lane >> 3) + 8 * j; const float* s = scr + (8 * c) * 33 + n;
        u32x4 o; o.x = pk2(s[0 * 33], s[1 * 33]); o.y = pk2(s[2 * 33], s[3 * 33]); o.z = pk2(s[4 * 33], s[5 * 33]); o.w = pk2(s[6 * 33], s[7 * 33]);
        *(u32x4*)(WT + (size_t)(n0 + n) * K + k0 + 8 * c) = o; }
    asm volatile("s_waitcnt lgkmcnt(0)" ::: "memory");
}
__device__ __forceinline__ void p0_prologue(Frame& F) {
    const int tid_ = fresh_tid(), lane_ = tid_ & 63, wave_ = __builtin_amdgcn_readfirstlane(tid_ >> 6);
    float* scr = (float*)(F.lds + wave_ * 16384);
    const int gw = F.bid * 8 + wave_, NGW = F.G * 8;
    const long gt = (long)F.bid * 512 + tid_, NGT = (long)F.G * 512;
    unsigned char* ws = F.ws;
    constexpr int I_IN = 16 * 80, I_SQ = 16 * 32, I_P = 4 * 32;
    for (int it = gw; it < I_IN + 3 * I_SQ + I_P; it += NGW) {
        int r = it;
        if (r < I_IN) { p0_transpose_item(F.a->in[4], 1024, 2560, (bf16*)(ws + WS_WIN), nullptr, scr, r, lane_); continue; } r -= I_IN;
        if (r < I_SQ) { p0_transpose_item(F.a->in[18], 1024, 1024, (bf16*)(ws + WS_WOUT), nullptr, scr, r, lane_); continue; } r -= I_SQ;
        if (r < I_SQ) { p0_transpose_item(F.a->in[20], 1024, 1024, (bf16*)(ws + WS_WQ), F.a->in[19], scr, r, lane_); continue; } r -= I_SQ;
        if (r < I_SQ) { p0_transpose_item(F.a->in[26], 1024, 1024, (bf16*)(ws + WS_WG), F.a->in[25], scr, r, lane_); continue; } r -= I_SQ;
        p0_transpose_item(F.a->in[27], 256, 1024, (bf16*)(ws + WS_WP), nullptr, scr, r, lane_);
    }
    for (int m = gw; m < T; m += 2 * NGW) {
        const int m2 = m + NGW;
        const f32x4* xr = (const f32x4*)(F.a->in[0] + (size_t)m * 1024) + lane_; const f32x4* xr2 = (const f32x4*)(F.a->in[0] + (size_t)m2 * 1024) + lane_; const f32x4* gr = (const f32x4*)F.a->in[3] + lane_;
        f32x4 v[4], v2[4]; float s = 0.f, s2 = 0.f;
#pragma unroll
        for (int j = 0; j < 4; ++j) { v[j] = xr[64 * j]; v2[j] = xr2[64 * j]; }
#pragma unroll
        for (int j = 0; j < 4; ++j) { s += (v[j][0] * v[j][0] + v[j][1] * v[j][1]) + (v[j][2] * v[j][2] + v[j][3] * v[j][3]); s2 += (v2[j][0] * v2[j][0] + v2[j][1] * v2[j][1]) + (v2[j][2] * v2[j][2] + v2[j][3] * v2[j][3]); }
        const float rstd = 1.0f / sqrtf(wave_sum(s) * (1.0f / 1024.0f) + EPS), rstd2 = 1.0f / sqrtf(wave_sum(s2) * (1.0f / 1024.0f) + EPS);
        u32x2* o8 = (u32x2*)(ws + WS_XN + (size_t)m * 2048) + lane_; u32x2* o82 = (u32x2*)(ws + WS_XN + (size_t)m2 * 2048) + lane_;
#pragma unroll
        for (int j = 0; j < 4; ++j) { const f32x4 g = gr[64 * j]; u32x2 w = {pk2(v[j][0] * rstd * g[0], v[j][1] * rstd * g[1]), pk2(v[j][2] * rstd * g[2], v[j][3] * rstd * g[3])}; o8[64 * j] = w;
            u32x2 w2 = {pk2(v2[j][0] * rstd2 * g[0], v2[j][1] * rstd2 * g[1]), pk2(v2[j][2] * rstd2 * g[2], v2[j][3] * rstd2 * g[3])}; o82[64 * j] = w2; }
    }
    for (long i = gt; i < (long)T * PLE / 8; i += NGT) {
        const f32x4 a = *(const f32x4*)(F.a->in[1] + i * 8), b = *(const f32x4*)(F.a->in[1] + i * 8 + 4);
        u32x4 w = {pk2(a[0], a[1]), pk2(a[2], a[3]), pk2(b[0], b[1]), pk2(b[2], b[3])}; *(u32x4*)(ws + WS_PB + i * 16) = w;
    }
    for (long i = gt; i < (long)16384 * 1024 / 16; i += NGT) {
        const int c0 = (int)((i * 16) & 1023);
        unsigned wu[4], wv[4];
#pragma unroll
        for (int q = 0; q < 4; ++q) {
            const f32x4 a = *(const f32x4*)(F.a->in[23] + i * 16 + 4 * q), g = *(const f32x4*)(F.a->in[19] + c0 + 4 * q), v = *(const f32x4*)(F.a->in[24] + i * 16 + 4 * q);
            const int q0 = (int)rintf(fminf(fmaxf(a[0] * g[0] * U8_SCALE, -127.f), 127.f)), q1 = (int)rintf(fminf(fmaxf(a[1] * g[1] * U8_SCALE, -127.f), 127.f));
            const int q2 = (int)rintf(fminf(fmaxf(a[2] * g[2] * U8_SCALE, -127.f), 127.f)), q3 = (int)rintf(fminf(fmaxf(a[3] * g[3] * U8_SCALE, -127.f), 127.f));
            wu[q] = (unsigned)((q0 & 0xff) | ((q1 & 0xff) << 8) | ((q2 & 0xff) << 16) | (q3 << 24));
            int w2 = 0;
            w2 = __builtin_amdgcn_cvt_pk_fp8_f32(fminf(fmaxf(v[0] * V8_SCALE, -448.f), 448.f), fminf(fmaxf(v[1] * V8_SCALE, -448.f), 448.f), w2, false);
            w2 = __builtin_amdgcn_cvt_pk_fp8_f32(fminf(fmaxf(v[2] * V8_SCALE, -448.f), 448.f), fminf(fmaxf(v[3] * V8_SCALE, -448.f), 448.f), w2, true);
            wv[q] = (unsigned)w2;
        }
        u32x4 ou = {wu[0], wu[1], wu[2], wu[3]}, ov = {wv[0], wv[1], wv[2], wv[3]};
        { const size_t ee = (size_t)(i >> 6), sl = (size_t)((i >> 3) & 7), ch = (size_t)(i & 7), off = sl * (16384 * 128) + ee * 128 + ch * 16;
          *(u32x4*)(ws + WS_UT + off) = ou; *(u32x4*)(ws + WS_VT + off) = ov; }
    }
    for (long i = gt; i < (long)T * 8; i += NGT) {
        const int t = (int)(i >> 3), k = (int)(i & 7);
        const float invf[8] = {1.0f, 0.19392274474868576f, 0.03760603093086393f, 0.007292664737217109f, 0.001414213562373095f, 0.0002742481756762073f, 5.318295896944988e-05f, 1.031338537721246e-05f};
        float fr = 1.0f;
#pragma unroll
        for (int q = 0; q < 8; ++q) if (q == k) fr = invf[q];
        const float ang = (float)((const int*)F.a->in[2])[t] * fr; float sn, cs; sincosf(ang, &sn, &cs);
        float* rp = (float*)(ws + WS_ROPE) + (size_t)t * 16; rp[k] = cs; rp[8 + k] = sn;
    }
    for (long i = gt; i < 2 * 8192; i += NGT) { const float v = (i < 8192) ? F.a->in[21][i] : F.a->in[22][i - 8192]; ((bf16*)(ws + WS_KEYS))[i] = (bf16)f2bf(v); }
    for (long i = gt; i < 2 * 8 * 2 * 64 * 64; i += NGT) {
        const int c = (int)(i & 63), e = (int)((i >> 6) & 63), gate = (int)((i >> 12) & 1), n = (int)((i >> 13) & 7), dir = (int)(i >> 16);
        const float* w = gate ? F.a->in[14] : F.a->in[12]; ((bf16*)(ws + WS_LWT))[i] = (bf16)f2bf(w[(((size_t)dir * 8 + n) * 64 + c) * 64 + e]);
    }
    if (F.bid == 0 && tid_ == 0) {
        float s1 = 0.f, s2 = 0.f;
        for (int i = 0; i < 64; ++i) { s1 += F.a->in[5][i] * F.a->in[6][i]; s2 += F.a->in[7][i] * F.a->in[8][i]; }
        ((float*)(ws + WS_MISC))[0] = expf(s1) - expf(s2) + LAMBDA_INIT;
    }
}

__global__ void __launch_bounds__(512, 2) enc_fwd(Args args) {
    extern __shared__ __attribute__((aligned(16))) unsigned char lds_raw[];
    Frame F;
    F.lds = (char*)lds_raw; F.G = gridDim.x; F.bid = blockIdx.x;
    F.a = &args; F.ws = args.ws;
    unsigned char* ws = args.ws;
    const int lo = args.ph_lo, hi = args.ph_hi;
    cg::grid_group grid = cg::this_grid();
#ifndef PHMASK
#define PHMASK 0x1fff
#endif
#define IN(k) ((((PHMASK) >> (k)) & 1) && lo <= (k) && (k) < hi)
#ifndef REPMASK
#define REPMASK 0
#endif
#define NREP(k) ((((REPMASK) >> (k)) & 1) + 1)
#define GBAR() do { if (args.coop == 1) xcd_barrier(bar); else if (args.coop == 2) grid.sync(); } while (0)
#define SEAM(k) do { if (IN(k) && IN((k) + 1)) { if (args.coop == 1) xcd_barrier(bar); else if (args.coop == 2) grid.sync(); } } while (0)
#define PH_BEGIN(k) if (IN(k)) for (int rep_ = NREP(k) - 1; rep_ >= 0; --rep_) {
#define PH_END() if (rep_ > 0) GBAR(); }
    volatile LAS unsigned* MISC = (volatile LAS unsigned*)((LAS unsigned char*)lds_raw + (LDS_BYTES - 1024));
    if (threadIdx.x < 16) MISC[threadIdx.x] = 0u;
    __syncthreads();
    XcdBarrier bar; bar.bar = (unsigned*)(ws + WS_CTL) + 4096; bar.x = 0; bar.st = nullptr;
    if (args.coop) bar = xcd_barrier_post((unsigned*)(ws + WS_CTL) + 4096, MISC + 8);
    PG8_LAS unsigned char* ldsl = (PG8_LAS unsigned char*)lds_raw;

    PH_BEGIN(0) p0_prologue(F); __syncthreads(); PH_END()
    SEAM(0);
    PH_BEGIN(1)
        pg8::Gemm g{(const bf16*)(ws + WS_XN), (const bf16*)(ws + WS_WIN), T, INC, 1024}; pg8::StaticOrder S; S.init(T, INC, F.G, F.bid);
        pg8::EpiProj E{(bf16*)(ws + WS_Q), (const float*)(ws + WS_ROPE), (unsigned*)(ws + WS_CTL) + 16384};
        pg8::gemm_phase<pg8::EpiProj, pg8::StaticOrder, true, true>(ldsl, g, S, E);
    PH_END()
    SEAM(1);
    PH_BEGIN(2)
        const float lam = ((const float*)(ws + WS_MISC))[0];
        for (int r2_ = 0; r2_ < NREP(13); ++r2_) {
            LruArgs A{(const bf16*)(ws + WS_LIN), F.a->in[10], F.a->in[11], (const bf16*)(ws + WS_LWT), F.a->in[13], F.a->in[15], F.a->in[16],
                      (bf16*)(ws + WS_XN), (bf16*)(ws + WS_HF), (bf16*)(ws + WS_XN + 32 * MiB), (bf16*)(ws + WS_HB), (float*)(ws + WS_SS3), (float*)(ws + WS_SS3 + MiB)};
            if (NREP(13) == 2 && r2_ == 0) lru_phase_a<ATTVAR>(F.bid, F.G, A, F.lds); else lru_phase_a<0>(F.bid, F.G, A, F.lds);
        }
        for (int r3_ = 0; r3_ < NREP(14); ++r3_)
        for (int it = F.bid; it < 1024; it += F.G) {
            const int xx = it & 7, rest = it >> 3, qb = rest & 31, i4 = rest >> 5, bh = i4 * 8 + xx;
            if (NREP(14) == 2 && r3_ == 0) att::attn_unit<ATTVAR>(bh >> 2, bh & 3, qb, (const bf16*)(ws + WS_Q), (const bf16*)(ws + WS_K), (const bf16*)(ws + WS_V), (bf16*)(ws + WS_MIXED), F.a->in[9], lam, (const unsigned*)(ws + WS_CTL) + 16384, F.lds);
            else att::attn_unit<0>(bh >> 2, bh & 3, qb, (const bf16*)(ws + WS_Q), (const bf16*)(ws + WS_K), (const bf16*)(ws + WS_V), (bf16*)(ws + WS_MIXED), F.a->in[9], lam, (const unsigned*)(ws + WS_CTL) + 16384, F.lds);
        }
    PH_END()
    SEAM(2);
    PH_BEGIN(3)
        LruCArgs A{(const bf16*)(ws + WS_XN), (const bf16*)(ws + WS_HF), (const bf16*)(ws + WS_XN + 32 * MiB), (const bf16*)(ws + WS_HB), (const float*)(ws + WS_SS3), (const float*)(ws + WS_SS3 + MiB),
                   (const bf16*)(ws + WS_LGATE), F.a->in[17], (bf16*)(ws + WS_MIXED)};
        for (int k = F.bid; k < 256; k += F.G) lru_phase_c(k, A, F.lds);
    PH_END()
    SEAM(3);
    PH_BEGIN(4)
        pg8::Gemm g{(const bf16*)(ws + WS_MIXED), (const bf16*)(ws + WS_WOUT), T, 1024, 1024}; pg8::StaticOrder S; S.init(T, 1024, F.G, F.bid);
        pg8::EpiResid E{F.a->in[0], (bf16*)(ws + WS_XN), (float*)(ws + WS_SS1)};
        pg8::gemm_phase<pg8::EpiResid, pg8::StaticOrder, true, true>(ldsl, g, S, E);
    PH_END()
    SEAM(4);
    PH_BEGIN(5)
        pg8::Gemm g{(const bf16*)(ws + WS_XN), (const bf16*)(ws + WS_WQ), T, 1024, 1024}; pg8::StaticOrder S; S.init(T, 1024, F.G, F.bid);
        pg8::EpiScaleBf16 E{(bf16*)(ws + WS_QP), (const float*)(ws + WS_SS1), (float*)(ws + WS_MISC + 4096)};
        pg8::gemm_phase<pg8::EpiScaleBf16, pg8::StaticOrder, true, true>(ldsl, g, S, E);
    PH_END()
    SEAM(5);
    PH_BEGIN(6)
        TopkArgs A{(const bf16*)(ws + WS_QP), (const bf16*)(ws + WS_KEYS), (unsigned short*)(ws + WS_IDX), (float*)(ws + WS_GW)};
        bf16x8 kf[4][4];
        { const int tid_ = fresh_tid(), lane_ = tid_ & 63, wave_ = __builtin_amdgcn_readfirstlane(tid_ >> 6); const int half = (wave_ >> 1) & 1, r32 = lane_ & 31, hi5 = lane_ >> 5;
#pragma unroll
          for (int ct = 0; ct < 4; ++ct)
#pragma unroll
            for (int ks = 0; ks < 4; ++ks) kf[ct][ks] = *(const bf16x8*)(A.KEYS + (size_t)half * 8192 + (ct * 32 + r32) * 64 + ks * 16 + hi5 * 8); }
        for (int tile = F.bid; tile < T / 64; tile += F.G) topk_unit(tile, A, kf, F.lds);
    PH_END()
    SEAM(6);
    PeerArgs PA{(const unsigned short*)(ws + WS_IDX), (const bf16*)(ws + WS_XN), (const unsigned char*)(ws + WS_UT), (const unsigned char*)(ws + WS_VT), (bf16*)(ws + WS_PLOG), (const unsigned*)(ws + WS_ACT), (bf16*)(ws + WS_XN), (float*)(ws + WS_SS2)};
    PH_BEGIN(7)
        if (rep_ > 0 && ((REPMASK >> 16) & 1)) { for (int it = F.bid; it < 8 * (T / 128); it += F.G) peer_u_item<0xfu, ((REPMASK >> 17) & 1)>(it >> 3, it & 7, PA, F.lds); }
        else for (int it = F.bid; it < 8 * (T / 128); it += F.G) peer_u_item<0xffffu, 0>(it >> 3, it & 7, PA, F.lds);
    PH_END()
    SEAM(7);
    PH_BEGIN(8)
        const int tid_ = fresh_tid();
        const long gt = (long)F.bid * 512 + tid_, NGT = (long)F.G * 512;
        const unsigned* plog = (const unsigned*)(ws + WS_PLOG); const float* gwp = (const float*)(ws + WS_GW); unsigned* act = (unsigned*)(ws + WS_ACT); const unsigned* idx2 = (const unsigned*)(ws + WS_IDX);
        for (long i = gt; i < (long)T * 64; i += NGT) {
            const int t = (int)(i >> 6);
            float s0 = 0.f, s1 = 0.f;
#pragma unroll
            for (int q = 0; q < 8; ++q) { const unsigned w = plog[(size_t)q * T * 64 + i]; s0 += bflo(w); s1 += bfhi(w); }
            const float rs = ((const float*)(ws + WS_MISC + 4096))[t];
            const f32x2 g2 = *(const f32x2*)(gwp + 2 * i);
            const unsigned ii = idx2[i];
            u32x2 o = {(f2bf(gelu_tanh(s0 * rs) * g2.x) << 16) | (ii & 0xffffu), (f2bf(gelu_tanh(s1 * rs) * g2.y) << 16) | (ii >> 16)};
            *(u32x2*)(act + 2 * i) = o;
        }
    PH_END()
    SEAM(8);
    PH_BEGIN(9)
        if (rep_ > 0 && ((REPMASK >> 15) & 1)) { for (int it = F.bid; it < 8 * (T / 128); it += F.G) peer_v_item<true, 0xffffu, ATTVAR>(it >> 3, it & 7, PA, F.lds, 0.0f); }
        else for (int it = F.bid; it < 8 * (T / 128); it += F.G) peer_v_item<true, 0xffffu, 0>(it >> 3, it & 7, PA, F.lds, rep_ > 0 ? 0.0f : 1.0f);
    PH_END()
    SEAM(9);
    PH_BEGIN(11)
        {
            pg8::Gemm g8{(const bf16*)(ws + WS_PB), (const bf16*)(ws + WS_WP), T, 1024, 256}; pg8::StaticOrder S8; S8.init(T, 1024, F.G, F.bid);
            pg8::EpiScaleBf16 E8{(bf16*)(ws + WS_QP), nullptr, nullptr};
            pg8::gemm_phase<pg8::EpiScaleBf16, pg8::StaticOrder, true, true>(ldsl, g8, S8, E8);
            asm volatile("s_waitcnt vmcnt(0)" ::: "memory"); __syncthreads();
        }
        pg8::Gemm g{(const bf16*)(ws + WS_XN), (const bf16*)(ws + WS_WG), T, 1024, 1024}; pg8::StaticOrder S; S.init(T, 1024, F.G, F.bid);
        pg8::EpiPle E{(const bf16*)(ws + WS_XN), (bf16*)(ws + WS_MIXED), (const bf16*)(ws + WS_QP), (const float*)(ws + WS_SS2), (float*)(ws + WS_SS3), rep_ > 0 ? 0.0f : 1.0f};
        pg8::gemm_phase<pg8::EpiPle, pg8::StaticOrder, true, true>(ldsl, g, S, E);
    PH_END()
    SEAM(11);
    PH_BEGIN(12)
        const int tid_ = fresh_tid(), lane_ = tid_ & 63, wave_ = __builtin_amdgcn_readfirstlane(tid_ >> 6);
        const int gw = F.bid * 8 + wave_, NGW = F.G * 8;
        for (int m = gw; m < T; m += NGW) {
            const float rs = pg8::rowscale16((const float*)(ws + WS_SS3), m);
            const u32x2* hb = (const u32x2*)(ws + WS_MIXED + (size_t)m * 2048) + lane_; const f32x4* gr = (const f32x4*)F.a->in[28] + lane_; f32x4* orow = (f32x4*)(F.a->out + (size_t)m * 1024) + lane_;
#pragma unroll
            for (int j = 0; j < 4; ++j) { const u32x2 w = hb[64 * j]; const f32x4 v = {bflo(w.x), bfhi(w.x), bflo(w.y), bfhi(w.y)}; orow[64 * j] = v * rs * gr[64 * j]; }
        }
    PH_END()
#undef IN
#undef SEAM
}

#ifndef MK_MULTI
#define MK_MULTI 0
#endif
constexpr int NPH = 13;
extern "C" void kernel_launch(void* const* d_in, const int* in_sizes, int n_in, void* d_out, int out_size, void* d_ws, size_t ws_size, hipStream_t stream) {
    static int grid = 0;
    if (grid == 0) {
        if (n_in != 29 || out_size != T * DM || ws_size < WS_END) { fprintf(stderr, "kernel_launch: unexpected shapes: n_in %d out %d ws %zu (need %zu)\n", n_in, out_size, ws_size, (size_t)WS_END); grid = -1; return; }
        int dev = 0, cus = 0, per_cu = 0;
        if (hipGetDevice(&dev) != hipSuccess || hipDeviceGetAttribute(&cus, hipDeviceAttributeMultiprocessorCount, dev) != hipSuccess) { grid = -1; return; }
        if (hipFuncSetAttribute((const void*)enc_fwd, hipFuncAttributeMaxDynamicSharedMemorySize, LDS_BYTES) != hipSuccess) { fprintf(stderr, "kernel_launch: hipFuncSetAttribute failed\n"); grid = -1; return; }
        if (hipOccupancyMaxActiveBlocksPerMultiprocessor(&per_cu, (const void*)enc_fwd, 512, LDS_BYTES) != hipSuccess || per_cu < 1) { fprintf(stderr, "kernel_launch: occupancy query says %d\n", per_cu); per_cu = 1; }
        (void)hipGetLastError();
        grid = cus * 1;
    }
    if (grid < 0) return;
    (void)hipMemsetAsync((char*)d_ws + WS_CTL, 0, CTL_ZERO_BYTES, stream);
    Args a{};
    for (int i = 0; i < 29; ++i) a.in[i] = (const float*)d_in[i];
    a.out = (float*)d_out; a.ws = (unsigned char*)d_ws;
#if MK_MULTI
    for (int ph = 0; ph < NPH; ++ph) { a.ph_lo = ph; a.ph_hi = ph + 1; a.coop = 0; hipLaunchKernelGGL(enc_fwd, dim3(grid), dim3(512), LDS_BYTES, stream, a); }
#else
    a.ph_lo = 0; a.ph_hi = NPH; a.coop = 1;
    void* kargs[] = {&a};
    hipError_t e = hipLaunchCooperativeKernel((const void*)enc_fwd, dim3(grid), dim3(512), kargs, LDS_BYTES, stream);
    if (e != hipSuccess) fprintf(stderr, "cooperative launch failed: %s (grid %d)\n", hipGetErrorString(e), grid);
#endif
}
```
